# Optimizing an MI355X kernel written in HIP

```python
import jax, jax.numpy as jnp
from jax import lax
import numpy as np

D_MODEL = 1024
BATCH = 8
SEQ = 2048
DEPTH = 1
DEC_BATCH = 128
DEC_SEQ = 4
PAST_LEN = 16384
PAGE_SIZE = 128

ML_HEADS = 4
ML_DK = 128
ML_DV = 128
GLA_HEADS = 4
GLA_DK = 64
GLA_DV = 128
GLA_RANK = 16
GLA_TAU = 16.0
MIX_WIDTH = ML_HEADS * ML_DV + GLA_HEADS * GLA_DV
CHUNK = 64
N_MEM = 256
XA_HEADS = 4
XA_DH = D_MODEL // XA_HEADS
D_FF = 2816
EPS = 1e-6
IN_SIZES = (ML_HEADS * ML_DK, ML_HEADS * ML_DK, ML_HEADS * ML_DV, ML_HEADS, ML_HEADS, ML_HEADS * ML_DV,
            GLA_HEADS * GLA_DK, GLA_HEADS * GLA_DK, GLA_HEADS * GLA_DV, GLA_RANK, GLA_HEADS * GLA_DV)
D_IN = sum(IN_SIZES)

kernel_name = 'hymba_mlstm_gla_macaron_memxattn_step'


def _rmsnorm(x, g):
    xf = x.astype(jnp.float32)
    y = xf * lax.rsqrt(jnp.mean(xf * xf, axis=-1, keepdims=True) + EPS)
    return (y * g.astype(jnp.float32)).astype(x.dtype)


def _head_rmsnorm(h, g):
    hf = h.astype(jnp.float32)
    y = hf * lax.rsqrt(jnp.mean(hf * hf, axis=-1, keepdims=True) + EPS)
    return y * g.astype(jnp.float32).reshape(h.shape[-2:])


def _swiglu(x, wg, wu, wd):
    return (jax.nn.silu(x @ wg) * (x @ wu)) @ wd


def _chunk_len(T):
    return CHUNK if T % CHUNK == 0 else T


def _to_chunks(a, L):
    B, T = a.shape[:2]
    return jnp.moveaxis(a.reshape((B, T // L, L) + a.shape[2:]), 1, 0)


def _from_chunks(a):
    a = jnp.moveaxis(a, 0, 1)
    return a.reshape((a.shape[0], a.shape[1] * a.shape[2]) + a.shape[3:])


def _mlstm(q, k, v, i_pre, logf, C0, n0, m0):
    L = _chunk_len(q.shape[1])
    mask = jnp.tril(jnp.ones((L, L), dtype=bool))[None, :, :, None]

    def step(carry, inp):
        C, n, m = carry
        qc, kc, vc, ic, fc = inp
        b = jnp.cumsum(fc, axis=1)
        a = b + m[:, None, :]
        Dm = jnp.where(mask, b[:, :, None, :] - b[:, None, :, :] + ic[:, None, :, :], -jnp.inf)
        mt = jnp.maximum(a, jnp.max(Dm, axis=2))
        w_inter = jnp.exp(a - mt)
        W = jnp.exp(Dm - mt[:, :, None, :])
        s = jnp.einsum('bthd,bshd->btsh', qc, kc) * W
        num = jnp.einsum('btsh,bshv->bthv', s, vc) + w_inter[..., None] * jnp.einsum('bthd,bhdv->bthv', qc, C)
        den = jnp.sum(s, axis=2) + w_inter * jnp.einsum('bthd,bhd->bth', qc, n)
        h = num / jnp.maximum(jnp.abs(den), jnp.exp(-mt))[..., None]
        wL = W[:, -1]
        iL = w_inter[:, -1]
        C_new = iL[..., None, None] * C + jnp.einsum('bsh,bshd,bshv->bhdv', wL, kc, vc)
        n_new = iL[..., None] * n + jnp.einsum('bsh,bshd->bhd', wL, kc)
        return (C_new, n_new, mt[:, -1]), h

    xs = (_to_chunks(q, L), _to_chunks(k, L), _to_chunks(v, L), _to_chunks(i_pre, L), _to_chunks(logf, L))
    init = (C0.astype(jnp.float32), n0.astype(jnp.float32), m0.astype(jnp.float32))
    (C, n, m), h = lax.scan(step, init, xs)
    return _from_chunks(h), C, n, m


def _gla(q, k, v, loga, S0):
    L = _chunk_len(q.shape[1])
    mask = jnp.tril(jnp.ones((L, L), dtype=bool))[None, :, :, None, None]

    def step(S, inp):
        qc, kc, vc, lc = inp
        Bc = jnp.cumsum(lc, axis=1)
        o_inter = jnp.einsum('bthd,bhdv->bthv', qc * jnp.exp(Bc), S)
        decay = jnp.exp(jnp.where(mask, Bc[:, :, None] - Bc[:, None, :], -jnp.inf))
        A = jnp.einsum('bthd,bshd,btshd->btsh', qc, kc, decay)
        o = o_inter + jnp.einsum('btsh,bshv->bthv', A, vc)
        BL = Bc[:, -1]
        S_new = jnp.exp(BL)[..., None] * S + jnp.einsum('bshd,bshv->bhdv', kc * jnp.exp(BL[:, None] - Bc), vc)
        return S_new, o

    xs = (_to_chunks(q, L), _to_chunks(k, L), _to_chunks(v, L), _to_chunks(loga, L))
    S, o = lax.scan(step, S0.astype(jnp.float32), xs)
    return _from_chunks(o), S


def _layer(x, mem_k, mem_v, C0, n0, m0, S0, w):
    Bsz, T, _ = x.shape
    f32 = jnp.float32
    x = x + 0.5 * _swiglu(_rmsnorm(x, w['ffn1_norm_g']), w['ffn1_w_gate'], w['ffn1_w_up'], w['ffn1_w_down'])
    z = _rmsnorm(x, w['mix_norm_g']) @ w['w_in']
    mq, mk, mv, mi, mf, mo, gq, gk, gv, ga, gg = jnp.split(z, np.cumsum(IN_SIZES)[:-1].tolist(), axis=-1)
    mq = mq.reshape(Bsz, T, ML_HEADS, ML_DK).astype(f32)
    mk = mk.reshape(Bsz, T, ML_HEADS, ML_DK).astype(f32) * (ML_DK ** -0.5)
    mv = mv.reshape(Bsz, T, ML_HEADS, ML_DV).astype(f32)
    i_pre = (mi + w['mlstm_b_i']).astype(f32)
    logf = jax.nn.log_sigmoid((mf + w['mlstm_b_f']).astype(f32))
    h_ml, C, n, m = _mlstm(mq, mk, mv, i_pre, logf, C0, n0, m0)
    y_ml = jax.nn.sigmoid(mo.astype(f32)) * _head_rmsnorm(h_ml, w['mlstm_out_g']).reshape(Bsz, T, ML_HEADS * ML_DV)
    gq = gq.reshape(Bsz, T, GLA_HEADS, GLA_DK).astype(f32) * (GLA_DK ** -0.5)
    gk = gk.reshape(Bsz, T, GLA_HEADS, GLA_DK).astype(f32)
    gv = gv.reshape(Bsz, T, GLA_HEADS, GLA_DV).astype(f32)
    loga = jax.nn.log_sigmoid((ga @ w['gla_w_a2'] + w['gla_b_a']).astype(f32)) / GLA_TAU
    loga = loga.reshape(Bsz, T, GLA_HEADS, GLA_DK)
    h_gla, S = _gla(gq, gk, gv, loga, S0)
    y_gla = jax.nn.silu(gg.astype(f32)) * _head_rmsnorm(h_gla, w['gla_out_g']).reshape(Bsz, T, GLA_HEADS * GLA_DV)
    y_mix = jnp.concatenate([y_ml, y_gla], axis=-1).astype(x.dtype)
    x = x + y_mix @ w['w_out']
    q = (_rmsnorm(x, w['xattn_norm_g']) @ w['xattn_w_q']).reshape(Bsz, T, XA_HEADS, XA_DH)
    s = jnp.einsum('bthd,bmhd->bhtm', q.astype(f32), mem_k.astype(f32)) * (XA_DH ** -0.5)
    p = jax.nn.softmax(s, axis=-1)
    o = jnp.einsum('bhtm,bmhd->bthd', p, mem_v.astype(f32)).reshape(Bsz, T, D_MODEL).astype(x.dtype)
    x = x + o @ w['xattn_w_o']
    x = x + 0.5 * _swiglu(_rmsnorm(x, w['ffn2_norm_g']), w['ffn2_w_gate'], w['ffn2_w_up'], w['ffn2_w_down'])
    return x, C.astype(C0.dtype), n.astype(n0.dtype), m.astype(m0.dtype), S.astype(S0.dtype)


def setup_inputs(seed: int = 0) -> dict:
    key = jax.random.key(seed)
    ks = list(jax.random.split(key, 40))
    ctr = [0]

    def nrm(shape, scale=1.0):
        k = ks[ctr[0]]
        ctr[0] += 1
        return scale * jax.random.normal(k, shape, jnp.float32)

    def gain(n):
        return 1.0 + 0.02 * nrm((DEPTH, n))

    d = {}
    d['x_prompt'] = nrm((BATCH, SEQ, D_MODEL))
    d['x_sample'] = nrm((DEC_BATCH, DEC_SEQ, D_MODEL))
    d['mem_prompt'] = nrm((BATCH, N_MEM, D_MODEL))
    d['cache_mem_k'] = nrm((DEPTH, DEC_BATCH, N_MEM, XA_HEADS, XA_DH))
    d['cache_mem_v'] = nrm((DEPTH, DEC_BATCH, N_MEM, XA_HEADS, XA_DH))
    d['state_mlstm_c'] = nrm((DEPTH, DEC_BATCH, ML_HEADS, ML_DK, ML_DV), 0.3)
    d['state_mlstm_n'] = nrm((DEPTH, DEC_BATCH, ML_HEADS, ML_DK), 0.3)
    d['state_mlstm_m'] = nrm((DEPTH, DEC_BATCH, ML_HEADS))
    d['state_gla_s'] = nrm((DEPTH, DEC_BATCH, GLA_HEADS, GLA_DK, GLA_DV), 0.3)
    d['ffn1_norm_g'] = gain(D_MODEL)
    d['ffn1_w_gate'] = nrm((DEPTH, D_MODEL, D_FF), D_MODEL ** -0.5)
    d['ffn1_w_up'] = nrm((DEPTH, D_MODEL, D_FF), D_MODEL ** -0.5)
    d['ffn1_w_down'] = nrm((DEPTH, D_FF, D_MODEL), D_FF ** -0.5)
    d['mix_norm_g'] = gain(D_MODEL)
    d['w_in'] = nrm((DEPTH, D_MODEL, D_IN), D_MODEL ** -0.5)
    d['mlstm_b_i'] = nrm((DEPTH, ML_HEADS), 0.1)
    d['mlstm_b_f'] = jnp.linspace(3.0, 6.0, ML_HEADS, dtype=jnp.float32)[None, :] + nrm((DEPTH, ML_HEADS), 0.1)
    d['mlstm_out_g'] = gain(ML_HEADS * ML_DV)
    d['gla_w_a2'] = nrm((DEPTH, GLA_RANK, GLA_HEADS * GLA_DK), GLA_RANK ** -0.5)
    d['gla_b_a'] = nrm((DEPTH, GLA_HEADS * GLA_DK), 0.1)
    d['gla_out_g'] = gain(GLA_HEADS * GLA_DV)
    d['w_out'] = nrm((DEPTH, MIX_WIDTH, D_MODEL), MIX_WIDTH ** -0.5)
    d['xattn_norm_g'] = gain(D_MODEL)
    d['mem_norm_g'] = gain(D_MODEL)
    d['xattn_w_q'] = nrm((DEPTH, D_MODEL, D_MODEL), D_MODEL ** -0.5)
    d['xattn_w_k'] = nrm((DEPTH, D_MODEL, D_MODEL), D_MODEL ** -0.5)
    d['xattn_w_v'] = nrm((DEPTH, D_MODEL, D_MODEL), D_MODEL ** -0.5)
    d['xattn_w_o'] = nrm((DEPTH, D_MODEL, D_MODEL), D_MODEL ** -0.5)
    d['ffn2_norm_g'] = gain(D_MODEL)
    d['ffn2_w_gate'] = nrm((DEPTH, D_MODEL, D_FF), D_MODEL ** -0.5)
    d['ffn2_w_up'] = nrm((DEPTH, D_MODEL, D_FF), D_MODEL ** -0.5)
    d['ffn2_w_down'] = nrm((DEPTH, D_FF, D_MODEL), D_FF ** -0.5)
    d['final_norm_g'] = 1.0 + 0.02 * nrm((D_MODEL,))
    return d


def reference(x_prompt, x_sample, mem_prompt, cache_mem_k, cache_mem_v, state_mlstm_c, state_mlstm_n,
              state_mlstm_m, state_gla_s, ffn1_norm_g, ffn1_w_gate, ffn1_w_up, ffn1_w_down, mix_norm_g, w_in,
              mlstm_b_i, mlstm_b_f, mlstm_out_g, gla_w_a2, gla_b_a, gla_out_g, w_out, xattn_norm_g, mem_norm_g,
              xattn_w_q, xattn_w_k, xattn_w_v, xattn_w_o, ffn2_norm_g, ffn2_w_gate, ffn2_w_up, ffn2_w_down,
              final_norm_g):
    layer_w = dict(ffn1_norm_g=ffn1_norm_g, ffn1_w_gate=ffn1_w_gate, ffn1_w_up=ffn1_w_up, ffn1_w_down=ffn1_w_down,
                   mix_norm_g=mix_norm_g, w_in=w_in, mlstm_b_i=mlstm_b_i, mlstm_b_f=mlstm_b_f,
                   mlstm_out_g=mlstm_out_g, gla_w_a2=gla_w_a2, gla_b_a=gla_b_a, gla_out_g=gla_out_g, w_out=w_out,
                   xattn_norm_g=xattn_norm_g, mem_norm_g=mem_norm_g, xattn_w_q=xattn_w_q, xattn_w_k=xattn_w_k,
                   xattn_w_v=xattn_w_v, xattn_w_o=xattn_w_o, ffn2_norm_g=ffn2_norm_g, ffn2_w_gate=ffn2_w_gate,
                   ffn2_w_up=ffn2_w_up, ffn2_w_down=ffn2_w_down)
    Bp = x_prompt.shape[0]
    dt = x_prompt.dtype
    xp, xs = x_prompt, x_sample
    mk_l, mv_l, cp_l, np_l, mp_l, sp_l, cs_l, ns_l, ms_l, ss_l = [], [], [], [], [], [], [], [], [], []
    for l in range(DEPTH):
        w = {name: arr[l] for name, arr in layer_w.items()}
        mem_n = _rmsnorm(mem_prompt, w['mem_norm_g'])
        mem_k_p = (mem_n @ w['xattn_w_k']).reshape(Bp, N_MEM, XA_HEADS, XA_DH)
        mem_v_p = (mem_n @ w['xattn_w_v']).reshape(Bp, N_MEM, XA_HEADS, XA_DH)
        c0 = jnp.zeros((Bp, ML_HEADS, ML_DK, ML_DV), dt)
        n0 = jnp.zeros((Bp, ML_HEADS, ML_DK), dt)
        m0 = jnp.zeros((Bp, ML_HEADS), dt)
        s0 = jnp.zeros((Bp, GLA_HEADS, GLA_DK, GLA_DV), dt)
        xp, c_p, n_p, m_p, s_p = _layer(xp, mem_k_p, mem_v_p, c0, n0, m0, s0, w)
        xs, c_s, n_s, m_s, s_s = _layer(xs, cache_mem_k[l], cache_mem_v[l], state_mlstm_c[l], state_mlstm_n[l],
                                        state_mlstm_m[l], state_gla_s[l], w)
        mk_l.append(mem_k_p)
        mv_l.append(mem_v_p)
        cp_l.append(c_p)
        np_l.append(n_p)
        mp_l.append(m_p)
        sp_l.append(s_p)
        cs_l.append(c_s)
        ns_l.append(n_s)
        ms_l.append(m_s)
        ss_l.append(s_s)
    y_prompt = _rmsnorm(xp, final_norm_g)
    y_sample = _rmsnorm(xs, final_norm_g)
    return (y_prompt, y_sample, jnp.stack(mk_l), jnp.stack(mv_l), jnp.stack(cp_l), jnp.stack(np_l),
            jnp.stack(mp_l), jnp.stack(sp_l), jnp.stack(cs_l), jnp.stack(ns_l), jnp.stack(ms_l), jnp.stack(ss_l))
```

```cpp
#include <hip/hip_runtime.h>
#include <cstdio>
#ifdef __HIPCC__
#define SHD __host__ __device__ __forceinline__
#else
#define SHD inline
#include <cmath>
#endif
namespace scf {
struct Dm { int D, B, T, SB, ST, MLH, DK, DV, GH, GDK, GDV, RANK, NMEM, XH, XDH, FF, DIN, pad; float eps, tau; };
SHD float log_sigmoidf(float x) { return x < 0.f ? x - log1pf(expf(x)) : -log1pf(expf(-x)); }
SHD float sigmoidf_(float x) { return 1.f / (1.f + expf(-x)); }
struct KRstd { const float* x; float* rs; int D; float eps;
  SHD void operator()(long r) const { const float* p = x + r * D; float s = 0.f; for (int k = 0; k < D; ++k) s += p[k] * p[k]; rs[r] = 1.f / sqrtf(s / D + eps); } };
struct KGemm { const float* A; const float* W; const float* g; const float* rs; const float* base; float* C; int K, N, ldc; float alpha;
  SHD void operator()(long i) const { const int n4 = N / 4; const long m = i / n4; const int n = (int)(i % n4) * 4; const float* a = A + m * K; const float* w = W + n;
    float c0 = 0.f, c1 = 0.f, c2 = 0.f, c3 = 0.f;
    for (int k = 0; k < K; ++k) { const float av = g ? a[k] * g[k] : a[k]; const float* wr = w + (long)k * N; c0 += av * wr[0]; c1 += av * wr[1]; c2 += av * wr[2]; c3 += av * wr[3]; }
    const float s = (rs ? rs[m] : 1.f) * alpha; float* o = C + m * ldc + n; const float* b = base ? base + m * ldc + n : nullptr;
    o[0] = (b ? b[0] : 0.f) + s * c0; o[1] = (b ? b[1] : 0.f) + s * c1; o[2] = (b ? b[2] : 0.f) + s * c2; o[3] = (b ? b[3] : 0.f) + s * c3; } };
struct KFfnUp { const float* A; const float* Wg; const float* Wu; const float* g; const float* rs; float* H; int K, N;
  SHD void operator()(long i) const { const int n2 = N / 2; const long m = i / n2; const int n = (int)(i % n2) * 2; const float* a = A + m * K;
    float g0 = 0.f, g1 = 0.f, u0 = 0.f, u1 = 0.f;
    for (int k = 0; k < K; ++k) { const float av = a[k] * g[k]; const float* wg = Wg + (long)k * N + n; const float* wu = Wu + (long)k * N + n; g0 += av * wg[0]; g1 += av * wg[1]; u0 += av * wu[0]; u1 += av * wu[1]; }
    const float s = rs[m]; g0 *= s; g1 *= s; u0 *= s; u1 *= s;
    H[m * N + n] = g0 * sigmoidf_(g0) * u0; H[m * N + n + 1] = g1 * sigmoidf_(g1) * u1; } };
struct ZOff { int mq, mk, mv, mi, mf, mo, gq, gk, gv, ga, gg; };
SHD ZOff zoff(const Dm& d) { ZOff o; int c = 0; o.mq = c; c += d.MLH * d.DK; o.mk = c; c += d.MLH * d.DK; o.mv = c; c += d.MLH * d.DV; o.mi = c; c += d.MLH; o.mf = c; c += d.MLH; o.mo = c; c += d.MLH * d.DV;
  o.gq = c; c += d.GH * d.GDK; o.gk = c; c += d.GH * d.GDK; o.gv = c; c += d.GH * d.GDV; o.ga = c; c += d.RANK; o.gg = c; return o; }
SHD void seq_info(const Dm& d, int s, long& row0, int& len, int& sb) { if (s < d.B) { row0 = (long)s * d.T; len = d.T; sb = -1; } else { sb = s - d.B; row0 = (long)d.B * d.T + (long)sb * d.ST; len = d.ST; } }
struct KMlGates { Dm d; const float* z; const float* b_i; const float* b_f; const float* m0s; float* FD; float* IW; float* MT; float* m_out_p; float* m_out_s;
  SHD void operator()(long i) const { const int h = (int)(i % d.MLH), s = (int)(i / d.MLH); long row0; int len, sb; seq_info(d, s, row0, len, sb); const ZOff zo = zoff(d);
    float m = sb >= 0 ? m0s[sb * d.MLH + h] : 0.f;
    for (int t = 0; t < len; ++t) { const long r = row0 + t; const float ip = z[r * d.DIN + zo.mi + h] + b_i[h]; const float lf = log_sigmoidf(z[r * d.DIN + zo.mf + h] + b_f[h]);
      const float mn = fmaxf(lf + m, ip); FD[r * d.MLH + h] = expf(lf + m - mn); IW[r * d.MLH + h] = expf(ip - mn); MT[r * d.MLH + h] = mn; m = mn; }
    if (sb >= 0) m_out_s[sb * d.MLH + h] = m; else m_out_p[s * d.MLH + h] = m; } };
struct KMlN { Dm d; const float* z; const float* n0s; const float* FD; const float* IW; float* PN; float* n_out_p; float* n_out_s;
  SHD void operator()(long i) const { const int dd = (int)(i % d.DK); const int h = (int)((i / d.DK) % d.MLH); const int s = (int)(i / ((long)d.DK * d.MLH)); long row0; int len, sb; seq_info(d, s, row0, len, sb); const ZOff zo = zoff(d);
    const float ks = 1.f / sqrtf((float)d.DK); float n = sb >= 0 ? n0s[((long)sb * d.MLH + h) * d.DK + dd] : 0.f;
    for (int t = 0; t < len; ++t) { const long r = row0 + t; const float k = z[r * d.DIN + zo.mk + h * d.DK + dd] * ks, q = z[r * d.DIN + zo.mq + h * d.DK + dd];
      n = FD[r * d.MLH + h] * n + IW[r * d.MLH + h] * k; PN[r * (d.MLH * d.DK) + h * d.DK + dd] = q * n; }
    if (sb >= 0) n_out_s[((long)sb * d.MLH + h) * d.DK + dd] = n; else n_out_p[((long)s * d.MLH + h) * d.DK + dd] = n; } };
template <int DKC> struct KMlC { Dm d; const float* z; const float* C0s; const float* FD; const float* IW; const float* MT; const float* PN; float* HR; long ldh; float* C_out_p; float* C_out_s;
  SHD void operator()(long i) const { const int v = (int)(i % d.DV); const int h = (int)((i / d.DV) % d.MLH); const int s = (int)(i / ((long)d.DV * d.MLH)); long row0; int len, sb; seq_info(d, s, row0, len, sb); const ZOff zo = zoff(d);
    const float ks = 1.f / sqrtf((float)DKC); float C[DKC];
#pragma unroll
    for (int dd = 0; dd < DKC; ++dd) C[dd] = sb >= 0 ? C0s[(((long)sb * d.MLH + h) * DKC + dd) * d.DV + v] : 0.f;
    for (int t = 0; t < len; ++t) { const long r = row0 + t; const float fd = FD[r * d.MLH + h], iwv = IW[r * d.MLH + h] * z[r * d.DIN + zo.mv + h * d.DV + v] * ks;
      const float* kp = z + r * d.DIN + zo.mk + h * DKC; const float* qp = z + r * d.DIN + zo.mq + h * DKC; const float* pn = PN + r * (d.MLH * DKC) + h * DKC; float num = 0.f, den = 0.f;
#pragma unroll
      for (int dd = 0; dd < DKC; ++dd) { C[dd] = fd * C[dd] + iwv * kp[dd]; num += qp[dd] * C[dd]; den += pn[dd]; }
      HR[r * ldh + h * d.DV + v] = num / fmaxf(fabsf(den), expf(-MT[r * d.MLH + h])); }
    float* Co = sb >= 0 ? C_out_s + (((long)sb * d.MLH + h) * DKC) * d.DV + v : C_out_p + (((long)s * d.MLH + h) * DKC) * d.DV + v;
#pragma unroll
    for (int dd = 0; dd < DKC; ++dd) Co[(long)dd * d.DV] = C[dd]; } };
struct KGlAlpha { Dm d; const float* z; const float* w_a2; const float* b_a; float* AL;
  SHD void operator()(long i) const { const int W = d.GH * d.GDK; const int c = (int)(i % W); const long r = i / W; const ZOff zo = zoff(d); float a = b_a[c];
    for (int j = 0; j < d.RANK; ++j) a += z[r * d.DIN + zo.ga + j] * w_a2[j * W + c];
    AL[r * W + c] = expf(log_sigmoidf(a) / d.tau); } };
template <int GDKC> struct KGlS { Dm d; const float* z; const float* S0s; const float* AL; float* HR; long ldh; float* S_out_p; float* S_out_s;
  SHD void operator()(long i) const { const int v = (int)(i % d.GDV); const int h = (int)((i / d.GDV) % d.GH); const int s = (int)(i / ((long)d.GDV * d.GH)); long row0; int len, sb; seq_info(d, s, row0, len, sb); const ZOff zo = zoff(d);
    const float qs = 1.f / sqrtf((float)GDKC); float S[GDKC];
#pragma unroll
    for (int dd = 0; dd < GDKC; ++dd) S[dd] = sb >= 0 ? S0s[(((long)sb * d.GH + h) * GDKC + dd) * d.GDV + v] : 0.f;
    for (int t = 0; t < len; ++t) { const long r = row0 + t; const float vv = z[r * d.DIN + zo.gv + h * d.GDV + v]; const float* kp = z + r * d.DIN + zo.gk + h * GDKC; const float* qp = z + r * d.DIN + zo.gq + h * GDKC; const float* al = AL + r * (d.GH * GDKC) + h * GDKC; float o = 0.f;
#pragma unroll
      for (int dd = 0; dd < GDKC; ++dd) { S[dd] = al[dd] * S[dd] + kp[dd] * vv; o += qp[dd] * S[dd]; }
      HR[r * ldh + d.MLH * d.DV + h * d.GDV + v] = o * qs; }
    float* So = sb >= 0 ? S_out_s + (((long)sb * d.GH + h) * GDKC) * d.GDV + v : S_out_p + (((long)s * d.GH + h) * GDKC) * d.GDV + v;
#pragma unroll
    for (int dd = 0; dd < GDKC; ++dd) So[(long)dd * d.GDV] = S[dd]; } };
struct KHeadNorm { Dm d; const float* z; const float* g_ml; const float* g_gla; float* Y; long ldy;
  SHD void operator()(long i) const { const int NH = d.MLH + d.GH; const int hh = (int)(i % NH); const long r = i / NH; const ZOff zo = zoff(d); const bool ml = hh < d.MLH; const int h = ml ? hh : hh - d.MLH; const int dv = ml ? d.DV : d.GDV;
    float* y = Y + r * ldy + (ml ? h * d.DV : d.MLH * d.DV + h * d.GDV); const float* gate = z + r * d.DIN + (ml ? zo.mo + h * d.DV : zo.gg + h * d.GDV); const float* g = ml ? g_ml + h * d.DV : g_gla + h * d.GDV;
    float s = 0.f; for (int v = 0; v < dv; ++v) s += y[v] * y[v]; const float rs = 1.f / sqrtf(s / dv + d.eps);
    for (int v = 0; v < dv; ++v) { const float gt = gate[v]; const float a = ml ? sigmoidf_(gt) : gt * sigmoidf_(gt); y[v] = a * y[v] * rs * g[v]; } } };
struct KScores { Dm d; const float* Q; const float* Kp; const float* Ks; float* S;
  SHD void operator()(long i) const { const int m = (int)(i % d.NMEM); const int h = (int)((i / d.NMEM) % d.XH); const long r = i / ((long)d.NMEM * d.XH); const long PR = (long)d.B * d.T;
    const float* kk = r < PR ? Kp + (((r / d.T) * d.NMEM + m) * d.XH + h) * d.XDH : Ks + ((((r - PR) / d.ST) * d.NMEM + m) * d.XH + h) * d.XDH; const float* q = Q + r * d.D + h * d.XDH;
    float s = 0.f; for (int k = 0; k < d.XDH; ++k) s += q[k] * kk[k]; S[i] = s / sqrtf((float)d.XDH); } };
struct KSoftStats { Dm d; const float* S; float* ST2;
  SHD void operator()(long i) const { const float* s = S + i * d.NMEM; float mx = s[0]; for (int m = 1; m < d.NMEM; ++m) mx = fmaxf(mx, s[m]); float sm = 0.f; for (int m = 0; m < d.NMEM; ++m) sm += expf(s[m] - mx); ST2[2 * i] = mx; ST2[2 * i + 1] = sm; } };
struct KPV { Dm d; const float* S; const float* ST2; const float* Vp; const float* Vs; float* O;
  SHD void operator()(long i) const { const int dd = (int)(i % d.XDH); const int h = (int)((i / d.XDH) % d.XH); const long r = i / ((long)d.XDH * d.XH); const long PR = (long)d.B * d.T; const long rh = r * d.XH + h;
    const float* s = S + rh * d.NMEM; const float mx = ST2[2 * rh], inv = 1.f / ST2[2 * rh + 1]; float o = 0.f;
    for (int m = 0; m < d.NMEM; ++m) { const float* vv = r < PR ? Vp + (((r / d.T) * d.NMEM + m) * d.XH + h) * d.XDH : Vs + ((((r - PR) / d.ST) * d.NMEM + m) * d.XH + h) * d.XDH; o += expf(s[m] - mx) * vv[dd]; }
    O[r * d.D + h * d.XDH + dd] = o * inv; } };
struct KFinal { const float* X; const float* rs; const float* g; float* Y; long D;
  SHD void operator()(long i) const { const long r = i / D; const int c = (int)(i % D); Y[i] = X[i] * rs[r] * g[c]; } };
}
namespace scf {
#ifdef __HIPCC__
template <class F> __global__ void __launch_bounds__(256) run_k(F f, long n) { for (long i = blockIdx.x * (long)blockDim.x + threadIdx.x; i < n; i += (long)gridDim.x * blockDim.x) f(i); }
template <class F> __global__ void __launch_bounds__(64) run_k64(F f, long n) { for (long i = blockIdx.x * (long)blockDim.x + threadIdx.x; i < n; i += (long)gridDim.x * blockDim.x) f(i); }
#define SCF_RUN(F, n) do { const long n_ = (n); long g_ = (n_ + 255) / 256; if (g_ > 65536) g_ = 65536; hipLaunchKernelGGL(run_k, dim3((unsigned)g_), dim3(256), 0, stream, F, n_); } while (0)
#define SCF_RUN64(F, n) do { const long n_ = (n); long g_ = (n_ + 63) / 64; hipLaunchKernelGGL(run_k64, dim3((unsigned)g_), dim3(64), 0, stream, F, n_); } while (0)
#define SCF_COPY(dst, src, nfloats) hipMemcpyAsync(dst, src, (size_t)(nfloats) * 4, hipMemcpyDeviceToDevice, stream)
#define SCF_STREAM_ARG , hipStream_t stream
#else

#define SCF_RUN(F, n) do { const long n_ = (n); for (long i_ = 0; i_ < n_; ++i_) F(i_); } while (0)
#define SCF_RUN64(F, n) SCF_RUN(F, n)
#define SCF_COPY(dst, src, nfloats) memcpy(dst, src, (size_t)(nfloats) * 4)
#define SCF_STREAM_ARG
#endif
struct OutOff { long yp, ys, mk, mv, cp, np, mp, sp, cs, ns, ms, ss, total; };
inline OutOff out_off(const Dm& d) { OutOff o; long c = 0; o.yp = c; c += (long)d.B * d.T * d.D; o.ys = c; c += (long)d.SB * d.ST * d.D; o.mk = c; c += (long)d.B * d.NMEM * d.D; o.mv = c; c += (long)d.B * d.NMEM * d.D;
  o.cp = c; c += (long)d.B * d.MLH * d.DK * d.DV; o.np = c; c += (long)d.B * d.MLH * d.DK; o.mp = c; c += (long)d.B * d.MLH; o.sp = c; c += (long)d.B * d.GH * d.GDK * d.GDV;
  o.cs = c; c += (long)d.SB * d.MLH * d.DK * d.DV; o.ns = c; c += (long)d.SB * d.MLH * d.DK; o.ms = c; c += (long)d.SB * d.MLH; o.ss = c; c += (long)d.SB * d.GH * d.GDK * d.GDV; o.total = c; return o; }
enum In { I_XP, I_XS, I_MEM, I_CK, I_CV, I_SC, I_SN, I_SM, I_SS, I_F1G, I_F1WG, I_F1WU, I_F1WD, I_MIXG, I_WIN, I_BI, I_BF, I_MLOG, I_WA2, I_BA, I_GLOG, I_WOUT, I_XG, I_MEMG, I_WQ, I_WK, I_WV, I_WO, I_F2G, I_F2WG, I_F2WU, I_F2WD, I_FING };
struct Scr { float *X, *RS, *BIG, *YM, *R4, *S, *FD, *IW, *MT, *ST2; };
inline Scr carve(const Dm& d, float* ws) { Scr s; const long M = (long)d.B * d.T + (long)d.SB * d.ST; long c = 0; auto al = [&](long n) { float* p = ws + c; c += (n + 63) / 64 * 64; return p; };
  s.X = al(M * d.D); s.RS = al(M > (long)d.B * d.NMEM ? M : (long)d.B * d.NMEM); const long big = d.FF > d.DIN ? d.FF : d.DIN; s.BIG = al(M * big); s.YM = al(M * d.D); s.R4 = al(M * d.D); s.S = al(M * d.XH * d.NMEM);
  s.FD = al(M * d.MLH); s.IW = al(M * d.MLH); s.MT = al(M * d.MLH); s.ST2 = al(M * d.XH * 2); return s; }
template <int DKC, int GDKC>
inline void run_mixer(const Dm& d, const float* const* in, float* out, const Scr& s, const float* z SCF_STREAM_ARG) {
  const long M = (long)d.B * d.T + (long)d.SB * d.ST; const OutOff oo = out_off(d); const int NS = d.B + d.SB;
  float* PN = s.R4; float* AL = s.R4;
  { KMlGates k{d, z, in[I_BI], in[I_BF], in[I_SM], s.FD, s.IW, s.MT, out + oo.mp, out + oo.ms}; SCF_RUN(k, (long)NS * d.MLH); }
  { KMlN k{d, z, in[I_SN], s.FD, s.IW, PN, out + oo.np, out + oo.ns}; SCF_RUN(k, (long)NS * d.MLH * d.DK); }
  { KMlC<DKC> k{d, z, in[I_SC], s.FD, s.IW, s.MT, PN, s.YM, d.D, out + oo.cp, out + oo.cs}; SCF_RUN64(k, (long)NS * d.MLH * d.DV); }
  { KGlAlpha k{d, z, in[I_WA2], in[I_BA], AL}; SCF_RUN(k, M * d.GH * d.GDK); }
  { KGlS<GDKC> k{d, z, in[I_SS], AL, s.YM, d.D, out + oo.sp, out + oo.ss}; SCF_RUN64(k, (long)NS * d.GH * d.GDV); }
  { KHeadNorm k{d, z, in[I_MLOG], in[I_GLOG], s.YM, d.D}; SCF_RUN(k, M * (d.MLH + d.GH)); }
}
template <int DKC, int GDKC>
inline void run_scaffold(const Dm& d, const float* const* in, float* out, float* ws SCF_STREAM_ARG) {
  const long M = (long)d.B * d.T + (long)d.SB * d.ST, PR = (long)d.B * d.T; const OutOff oo = out_off(d); const Scr s = carve(d, ws);
#ifdef __HIPCC__
#define SCF_S , stream
#else
#define SCF_S
#endif
  SCF_COPY(s.X, in[I_XP], PR * d.D); SCF_COPY(s.X + PR * d.D, in[I_XS], (M - PR) * d.D);
  { KRstd k{in[I_MEM], s.RS, d.D, d.eps}; SCF_RUN(k, (long)d.B * d.NMEM); }
  { KGemm k{in[I_MEM], in[I_WK], in[I_MEMG], s.RS, nullptr, out + oo.mk, d.D, d.D, d.D, 1.f}; SCF_RUN(k, (long)d.B * d.NMEM * d.D / 4); }
  { KGemm k{in[I_MEM], in[I_WV], in[I_MEMG], s.RS, nullptr, out + oo.mv, d.D, d.D, d.D, 1.f}; SCF_RUN(k, (long)d.B * d.NMEM * d.D / 4); }
  { KRstd k{s.X, s.RS, d.D, d.eps}; SCF_RUN(k, M); }
  { KFfnUp k{s.X, in[I_F1WG], in[I_F1WU], in[I_F1G], s.RS, s.BIG, d.D, d.FF}; SCF_RUN(k, M * d.FF / 2); }
  { KGemm k{s.BIG, in[I_F1WD], nullptr, nullptr, s.X, s.X, d.FF, d.D, d.D, 0.5f}; SCF_RUN(k, M * d.D / 4); }
  { KRstd k{s.X, s.RS, d.D, d.eps}; SCF_RUN(k, M); }
  { KGemm k{s.X, in[I_WIN], in[I_MIXG], s.RS, nullptr, s.BIG, d.D, d.DIN, d.DIN, 1.f}; SCF_RUN(k, M * d.DIN / 4); }
  run_mixer<DKC, GDKC>(d, in, out, s, s.BIG SCF_S);
  { KGemm k{s.YM, in[I_WOUT], nullptr, nullptr, s.X, s.X, d.D, d.D, d.D, 1.f}; SCF_RUN(k, M * d.D / 4); }
  { KRstd k{s.X, s.RS, d.D, d.eps}; SCF_RUN(k, M); }
  { KGemm k{s.X, in[I_WQ], in[I_XG], s.RS, nullptr, s.R4, d.D, d.D, d.D, 1.f}; SCF_RUN(k, M * d.D / 4); }
  { KScores k{d, s.R4, out + oo.mk, in[I_CK], s.S}; SCF_RUN(k, M * d.XH * d.NMEM); }
  { KSoftStats k{d, s.S, s.ST2}; SCF_RUN(k, M * d.XH); }
  { KPV k{d, s.S, s.ST2, out + oo.mv, in[I_CV], s.YM}; SCF_RUN(k, M * d.D); }
  { KGemm k{s.YM, in[I_WO], nullptr, nullptr, s.X, s.X, d.D, d.D, d.D, 1.f}; SCF_RUN(k, M * d.D / 4); }
  { KRstd k{s.X, s.RS, d.D, d.eps}; SCF_RUN(k, M); }
  { KFfnUp k{s.X, in[I_F2WG], in[I_F2WU], in[I_F2G], s.RS, s.BIG, d.D, d.FF}; SCF_RUN(k, M * d.FF / 2); }
  { KGemm k{s.BIG, in[I_F2WD], nullptr, nullptr, s.X, s.X, d.FF, d.D, d.D, 0.5f}; SCF_RUN(k, M * d.D / 4); }
  { KRstd k{s.X, s.RS, d.D, d.eps}; SCF_RUN(k, M); }
  { KFinal k{s.X, s.RS, in[I_FING], out + oo.yp, d.D}; SCF_RUN(k, M * d.D); }
}
}
static scf::Dm full_dims() { scf::Dm d{1024, 8, 2048, 128, 4, 4, 128, 128, 4, 64, 128, 16, 256, 4, 256, 2816, 3608, 0, 1e-6f, 16.f}; return d; }
extern "C" void kernel_launch(void* const* d_in, const int* in_sizes, int n_in, void* d_out, int out_size, void* d_ws, size_t ws_size, hipStream_t stream) {
  const scf::Dm d = full_dims();
  if (n_in != 33 || (long)out_size != scf::out_off(d).total) { fprintf(stderr, "kernel_launch: unexpected n_in %d / out_size %d\n", n_in, out_size); return; }
  if (ws_size < (size_t)540000000) { fprintf(stderr, "kernel_launch: ws_size %zu too small\n", ws_size); }
  const float* in[33]; for (int i = 0; i < 33; ++i) in[i] = (const float*)d_in[i];
  scf::run_scaffold<128, 64>(d, in, (float*)d_out, (float*)d_ws, stream);
}
```

```cpp
#include <hip/hip_runtime.h>
#include <cstdio>
#ifdef __HIPCC__
#define SHD __host__ __device__ __forceinline__
#else
#define SHD inline
#include <cmath>
#endif
namespace nv {
typedef unsigned short bf16_t;
SHD float bf2f(bf16_t v) { union { unsigned u; float f; } x; x.u = (unsigned)v << 16; return x.f; }
SHD bf16_t f2bf(float f) { union { unsigned u; float f; } x; x.f = f; return (bf16_t)((x.u + 0x7fffu + ((x.u >> 16) & 1u)) >> 16); }
struct Dm { int D, B, T, SB, ST, MLH, DK, DV, GH, GDK, GDV, RANK, NMEM, XH, XDH, FF, DIN, pad; float eps, tau; };
SHD long rows_of(const Dm& d) { return (long)d.B * d.T + (long)d.SB * d.ST; }
constexpr int ZGP = 32, NSSQ = 16;
struct Lay { int zq, zk, zv, zo, gq, gk, gv, gg, ZW, pad; };
SHD Lay lay_of(const Dm& d) { Lay l; int c = 0; l.zq = c; c += d.MLH * d.DK; l.zk = c; c += d.MLH * d.DK; l.zv = c; c += d.MLH * d.DV; l.zo = c; c += d.MLH * d.DV; l.gq = c; c += d.GH * d.GDK; l.gk = c; c += d.GH * d.GDK; l.gv = c; c += d.GH * d.GDV; l.gg = c; c += d.GH * d.GDV; l.ZW = c; l.pad = 0; return l; }
SHD void zmap(const Dm& d, int c, int& zc, int& gc, float& fold) { const Lay l = lay_of(d); zc = -1; gc = -1; fold = 1.f; int w;
  w = d.MLH * d.DK; if (c < w) { zc = l.zq + c; return; } c -= w;
  if (c < w) { zc = l.zk + c; fold = 1.f / sqrtf((float)d.DK); return; } c -= w;
  w = d.MLH * d.DV; if (c < w) { zc = l.zv + c; return; } c -= w;
  if (c < d.MLH) { gc = c; return; } c -= d.MLH;
  if (c < d.MLH) { gc = d.MLH + c; return; } c -= d.MLH;
  if (c < w) { zc = l.zo + c; return; } c -= w;
  w = d.GH * d.GDK; if (c < w) { zc = l.gq + c; fold = 1.f / sqrtf((float)d.GDK); return; } c -= w;
  if (c < w) { zc = l.gk + c; return; } c -= w;
  w = d.GH * d.GDV; if (c < w) { zc = l.gv + c; return; } c -= w;
  if (c < d.RANK) { gc = 2 * d.MLH + c; return; } c -= d.RANK;
  zc = l.gg + c; }
struct ZV { const bf16_t* Z; const float* ZG; Lay l; int pad0, pad1;
  SHD float z(long r, int col) const { return bf2f(Z[r * l.ZW + col]); }
  SHD float g(long r, int col) const { return ZG[r * ZGP + col]; } };
SHD float log_sigmoidf(float x) { return x < 0.f ? x - log1pf(expf(x)) : -log1pf(expf(-x)); }
SHD float sigmoidf_(float x) { return 1.f / (1.f + expf(-x)); }
SHD float rs_of(const float* SSQ, long r, int D, float eps) { float s = 0.f; for (int j = 0; j < NSSQ; ++j) s += SSQ[r * NSSQ + j]; return 1.f / sqrtf(s / D + eps); }
struct NProX { const float* xp; const float* xs; bf16_t* XB; float* SSQ; long PR; int D, nssq;
  SHD void operator()(long r) const { const float* p = r < PR ? xp + r * D : xs + (r - PR) * D; float s = 0.f; for (int k = 0; k < D; ++k) { s += p[k] * p[k]; XB[r * D + k] = f2bf(p[k]); }
    SSQ[r * nssq] = s; for (int j = 1; j < nssq; ++j) SSQ[r * nssq + j] = 0.f; } };
struct NSsq { const float* XF; float* SSQ; int D, pad;
  SHD void operator()(long r) const { const float* p = XF + r * D; float s = 0.f; for (int k = 0; k < D; ++k) s += p[k] * p[k]; SSQ[r * NSSQ] = s; for (int j = 1; j < NSSQ; ++j) SSQ[r * NSSQ + j] = 0.f; } };
struct NUp { const bf16_t* XB; const float* SSQ; const float* Wg; const float* Wu; const float* g; bf16_t* H; int K, N; float eps; int pad;
  SHD void operator()(long i) const { const int n2 = N / 2; const long m = i / n2; const int n = (int)(i % n2) * 2; const bf16_t* a = XB + m * K; float g0 = 0.f, g1 = 0.f, u0 = 0.f, u1 = 0.f;
    for (int k = 0; k < K; ++k) { const float av = bf2f(a[k]) * g[k]; const float* wg = Wg + (long)k * N + n; const float* wu = Wu + (long)k * N + n; g0 += av * wg[0]; g1 += av * wg[1]; u0 += av * wu[0]; u1 += av * wu[1]; }
    const float s = rs_of(SSQ, m, K, eps); g0 *= s; g1 *= s; u0 *= s; u1 *= s; H[m * N + n] = f2bf(g0 * sigmoidf_(g0) * u0); H[m * N + n + 1] = f2bf(g1 * sigmoidf_(g1) * u1); } };
struct NKV { Dm d; const bf16_t* MEMB; const float* MSSQ; const float* Wk; const float* Wv; const float* g; float* outk; float* outv; bf16_t* KB; bf16_t* VT;
  SHD void operator()(long i) const { const int n4 = 2 * d.D / 4; const long r = i / n4; const int n = (int)(i % n4) * 4; const bool isv = n >= d.D; const int nn = isv ? n - d.D : n; const float* W = (isv ? Wv : Wk) + nn; const bf16_t* a = MEMB + r * d.D;
    float c[4] = {0.f, 0.f, 0.f, 0.f}; for (int k = 0; k < d.D; ++k) { const float av = bf2f(a[k]) * g[k]; const float* wr = W + (long)k * d.D; c[0] += av * wr[0]; c[1] += av * wr[1]; c[2] += av * wr[2]; c[3] += av * wr[3]; }
    const float s = 1.f / sqrtf(MSSQ[r] / d.D + d.eps); const long b = r / d.NMEM; const int m = (int)(r % d.NMEM);
    for (int j = 0; j < 4; ++j) { const float v = c[j] * s; const int col = nn + j; if (!isv) { outk[r * d.D + col] = v; KB[r * d.D + col] = f2bf(v); } else { outv[r * d.D + col] = v; const int h = col / d.XDH, dd = col % d.XDH; VT[((b * d.XH + h) * d.XDH + dd) * d.NMEM + m] = f2bf(v); } } } };
struct NResid { const bf16_t* A; const float* W; const float* xp; const float* xs; float* XF; bf16_t* XB; long PR; int K, N; float alpha; int first;
  SHD void operator()(long i) const { const int n4 = N / 4; const long m = i / n4; const int n = (int)(i % n4) * 4; const bf16_t* a = A + m * K; const float* w = W + n; float c0 = 0.f, c1 = 0.f, c2 = 0.f, c3 = 0.f;
    for (int k = 0; k < K; ++k) { const float av = bf2f(a[k]); const float* wr = w + (long)k * N; c0 += av * wr[0]; c1 += av * wr[1]; c2 += av * wr[2]; c3 += av * wr[3]; }
    const float* b = first ? (m < PR ? xp + m * N + n : xs + (m - PR) * N + n) : XF + m * N + n; float o0 = b[0] + alpha * c0, o1 = b[1] + alpha * c1, o2 = b[2] + alpha * c2, o3 = b[3] + alpha * c3;
    float* o = XF + m * N + n; o[0] = o0; o[1] = o1; o[2] = o2; o[3] = o3; bf16_t* ob = XB + m * N + n; ob[0] = f2bf(o0); ob[1] = f2bf(o1); ob[2] = f2bf(o2); ob[3] = f2bf(o3); } };
struct NZ { Dm d; const bf16_t* XB; const float* SSQ; const float* W; const float* g; bf16_t* Z; float* ZG;
  SHD void operator()(long i) const { const long m = i / d.DIN; const int c = (int)(i % d.DIN); const bf16_t* a = XB + m * d.D; float acc = 0.f; for (int k = 0; k < d.D; ++k) acc += bf2f(a[k]) * g[k] * W[(long)k * d.DIN + c];
    acc *= rs_of(SSQ, m, d.D, d.eps); int zc, gc; float fold; zmap(d, c, zc, gc, fold); const Lay l = lay_of(d); if (zc >= 0) Z[m * l.ZW + zc] = f2bf(acc * fold); else ZG[m * ZGP + gc] = acc; } };
struct NZGpad { Dm d; float* ZG; SHD void operator()(long i) const { const long m = i / ZGP; const int c = (int)(i % ZGP); if (c >= 2 * d.MLH + d.RANK) ZG[m * ZGP + c] = 0.f; } };
struct NQ { Dm d; const bf16_t* XB; const float* SSQ; const float* W; const float* g; bf16_t* Q;
  SHD void operator()(long i) const { const int n4 = d.D / 4; const long m = i / n4; const int n = (int)(i % n4) * 4; const bf16_t* a = XB + m * d.D; float c[4] = {0.f, 0.f, 0.f, 0.f};
    for (int k = 0; k < d.D; ++k) { const float av = bf2f(a[k]) * g[k]; const float* wr = W + (long)k * d.D + n; c[0] += av * wr[0]; c[1] += av * wr[1]; c[2] += av * wr[2]; c[3] += av * wr[3]; }
    const float s = rs_of(SSQ, m, d.D, d.eps) / sqrtf((float)d.XDH); for (int j = 0; j < 4; ++j) Q[m * d.D + n + j] = f2bf(c[j] * s); } };
SHD void seq_info(const Dm& d, int s, long& row0, int& len, int& sb) { if (s < d.B) { row0 = (long)s * d.T; len = d.T; sb = -1; } else { sb = s - d.B; row0 = (long)d.B * d.T + (long)sb * d.ST; len = d.ST; } }
struct NMlGates { Dm d; ZV zv; const float* b_i; const float* b_f; const float* m0s; float* FD; float* IW; float* MT; float* m_out_p; float* m_out_s;
  SHD void operator()(long i) const { const int h = (int)(i % d.MLH), s = (int)(i / d.MLH); long row0; int len, sb; seq_info(d, s, row0, len, sb); float m = sb >= 0 ? m0s[sb * d.MLH + h] : 0.f;
    for (int t = 0; t < len; ++t) { const long r = row0 + t; const float ip = zv.g(r, h) + b_i[h]; const float lf = log_sigmoidf(zv.g(r, d.MLH + h) + b_f[h]); const float mn = fmaxf(lf + m, ip);
      FD[r * d.MLH + h] = expf(lf + m - mn); IW[r * d.MLH + h] = expf(ip - mn); MT[r * d.MLH + h] = mn; m = mn; }
    if (sb >= 0) m_out_s[sb * d.MLH + h] = m; else m_out_p[s * d.MLH + h] = m; } };
struct NMlN { Dm d; ZV zv; const float* n0s; const float* FD; const float* IW; float* PN; float* n_out_p; float* n_out_s;
  SHD void operator()(long i) const { const int dd = (int)(i % d.DK); const int h = (int)((i / d.DK) % d.MLH); const int s = (int)(i / ((long)d.DK * d.MLH)); long row0; int len, sb; seq_info(d, s, row0, len, sb);
    float n = sb >= 0 ? n0s[((long)sb * d.MLH + h) * d.DK + dd] : 0.f;
    for (int t = 0; t < len; ++t) { const long r = row0 + t; const float k = zv.z(r, zv.l.zk + h * d.DK + dd), q = zv.z(r, zv.l.zq + h * d.DK + dd); n = FD[r * d.MLH + h] * n + IW[r * d.MLH + h] * k; PN[r * (d.MLH * d.DK) + h * d.DK + dd] = q * n; }
    if (sb >= 0) n_out_s[((long)sb * d.MLH + h) * d.DK + dd] = n; else n_out_p[((long)s * d.MLH + h) * d.DK + dd] = n; } };
template <int DKC> struct NMlC { Dm d; ZV zv; const float* C0s; const float* FD; const float* IW; const float* MT; const float* PN; float* HR; float* C_out_p; float* C_out_s;
  SHD void operator()(long i) const { const int v = (int)(i % d.DV); const int h = (int)((i / d.DV) % d.MLH); const int s = (int)(i / ((long)d.DV * d.MLH)); long row0; int len, sb; seq_info(d, s, row0, len, sb); float C[DKC];
#pragma unroll
    for (int dd = 0; dd < DKC; ++dd) C[dd] = sb >= 0 ? C0s[(((long)sb * d.MLH + h) * DKC + dd) * d.DV + v] : 0.f;
    for (int t = 0; t < len; ++t) { const long r = row0 + t; const float fd = FD[r * d.MLH + h], iwv = IW[r * d.MLH + h] * zv.z(r, zv.l.zv + h * d.DV + v);
      const bf16_t* kp = zv.Z + r * zv.l.ZW + zv.l.zk + h * DKC; const bf16_t* qp = zv.Z + r * zv.l.ZW + zv.l.zq + h * DKC; const float* pn = PN + r * (d.MLH * DKC) + h * DKC; float num = 0.f, den = 0.f;
#pragma unroll
      for (int dd = 0; dd < DKC; ++dd) { C[dd] = fd * C[dd] + iwv * bf2f(kp[dd]); num += bf2f(qp[dd]) * C[dd]; den += pn[dd]; }
      HR[r * d.D + h * d.DV + v] = num / fmaxf(fabsf(den), expf(-MT[r * d.MLH + h])); }
    float* Co = sb >= 0 ? C_out_s + (((long)sb * d.MLH + h) * DKC) * d.DV + v : C_out_p + (((long)s * d.MLH + h) * DKC) * d.DV + v;
#pragma unroll
    for (int dd = 0; dd < DKC; ++dd) Co[(long)dd * d.DV] = C[dd]; } };
struct NGlAlpha { Dm d; ZV zv; const float* w_a2; const float* b_a; float* AL;
  SHD void operator()(long i) const { const int W = d.GH * d.GDK; const int c = (int)(i % W); const long r = i / W; float a = b_a[c]; for (int j = 0; j < d.RANK; ++j) a += zv.g(r, 2 * d.MLH + j) * w_a2[j * W + c]; AL[r * W + c] = expf(log_sigmoidf(a) / d.tau); } };
template <int GDKC> struct NGlS { Dm d; ZV zv; const float* S0s; const float* AL; float* HR; float* S_out_p; float* S_out_s;
  SHD void operator()(long i) const { const int v = (int)(i % d.GDV); const int h = (int)((i / d.GDV) % d.GH); const int s = (int)(i / ((long)d.GDV * d.GH)); long row0; int len, sb; seq_info(d, s, row0, len, sb); float S[GDKC];
#pragma unroll
    for (int dd = 0; dd < GDKC; ++dd) S[dd] = sb >= 0 ? S0s[(((long)sb * d.GH + h) * GDKC + dd) * d.GDV + v] : 0.f;
    for (int t = 0; t < len; ++t) { const long r = row0 + t; const float vv = zv.z(r, zv.l.gv + h * d.GDV + v); const bf16_t* kp = zv.Z + r * zv.l.ZW + zv.l.gk + h * GDKC; const bf16_t* qp = zv.Z + r * zv.l.ZW + zv.l.gq + h * GDKC; const float* al = AL + r * (d.GH * GDKC) + h * GDKC; float o = 0.f;
#pragma unroll
      for (int dd = 0; dd < GDKC; ++dd) { S[dd] = al[dd] * S[dd] + bf2f(kp[dd]) * vv; o += bf2f(qp[dd]) * S[dd]; }
      HR[r * d.D + d.MLH * d.DV + h * d.GDV + v] = o; }
    float* So = sb >= 0 ? S_out_s + (((long)sb * d.GH + h) * GDKC) * d.GDV + v : S_out_p + (((long)s * d.GH + h) * GDKC) * d.GDV + v;
#pragma unroll
    for (int dd = 0; dd < GDKC; ++dd) So[(long)dd * d.GDV] = S[dd]; } };
struct NHeadNorm { Dm d; ZV zv; const float* g_ml; const float* g_gla; const float* HR; bf16_t* Y;
  SHD void operator()(long i) const { const int NH = d.MLH + d.GH; const int hh = (int)(i % NH); const long r = i / NH; const bool ml = hh < d.MLH; const int h = ml ? hh : hh - d.MLH; const int dv = ml ? d.DV : d.GDV;
    const int yo = ml ? h * d.DV : d.MLH * d.DV + h * d.GDV; const int go = ml ? zv.l.zo + h * d.DV : zv.l.gg + h * d.GDV; const float* g = ml ? g_ml + h * d.DV : g_gla + h * d.GDV; const float* y = HR + r * d.D + yo;
    float s = 0.f; for (int v = 0; v < dv; ++v) s += y[v] * y[v]; const float rs = 1.f / sqrtf(s / dv + d.eps);
    for (int v = 0; v < dv; ++v) { const float gt = zv.z(r, go + v); const float a = ml ? sigmoidf_(gt) : gt * sigmoidf_(gt); Y[r * d.D + yo + v] = f2bf(a * y[v] * rs * g[v]); } } };
struct NScores { Dm d; const bf16_t* Q; const bf16_t* KB; const float* Ks; float* S;
  SHD void operator()(long i) const { const int m = (int)(i % d.NMEM); const int h = (int)((i / d.NMEM) % d.XH); const long r = i / ((long)d.NMEM * d.XH); const long PR = (long)d.B * d.T; const bf16_t* q = Q + r * d.D + h * d.XDH; float s = 0.f;
    if (r < PR) { const bf16_t* kk = KB + ((r / d.T) * d.NMEM + m) * d.D + h * d.XDH; for (int k = 0; k < d.XDH; ++k) s += bf2f(q[k]) * bf2f(kk[k]); }
    else { const float* kk = Ks + ((((r - PR) / d.ST) * d.NMEM + m) * d.XH + h) * d.XDH; for (int k = 0; k < d.XDH; ++k) s += bf2f(q[k]) * kk[k]; }
    S[i] = s; } };
struct NSoftStats { Dm d; const float* S; float* ST2;
  SHD void operator()(long i) const { const float* s = S + i * d.NMEM; float mx = s[0]; for (int m = 1; m < d.NMEM; ++m) mx = fmaxf(mx, s[m]); float sm = 0.f; for (int m = 0; m < d.NMEM; ++m) sm += expf(s[m] - mx); ST2[2 * i] = mx; ST2[2 * i + 1] = sm; } };
struct NPV { Dm d; const float* S; const float* ST2; const bf16_t* VT; const float* Vs; bf16_t* O;
  SHD void operator()(long i) const { const int dd = (int)(i % d.XDH); const int h = (int)((i / d.XDH) % d.XH); const long r = i / ((long)d.XDH * d.XH); const long PR = (long)d.B * d.T; const long rh = r * d.XH + h;
    const float* s = S + rh * d.NMEM; const float mx = ST2[2 * rh], inv = 1.f / ST2[2 * rh + 1]; float o = 0.f;
    if (r < PR) { const bf16_t* vt = VT + (((r / d.T) * d.XH + h) * d.XDH + dd) * d.NMEM; for (int m = 0; m < d.NMEM; ++m) o += expf(s[m] - mx) * bf2f(vt[m]); }
    else { for (int m = 0; m < d.NMEM; ++m) o += expf(s[m] - mx) * Vs[((((r - PR) / d.ST) * d.NMEM + m) * d.XH + h) * d.XDH + dd]; }
    O[r * d.D + h * d.XDH + dd] = f2bf(o * inv); } };
struct NFinal { const float* XF; const float* SSQ; const float* g; float* Y; int D; float eps;
  SHD void operator()(long i) const { const long r = i / D; const int c = (int)(i % D); Y[i] = XF[i] * rs_of(SSQ, r, D, eps) * g[c]; } };
}
namespace nv {
struct Ws {
  size_t ctl, wgu1, wd1, win, wout, wq, wkv, wo, wgu2, wd2, ssq, mssq, memb, kb, vt, xb, xf, zg, r1, r2, ymix, total;
  size_t q, o, hr, pn, al, fd, iw, mt, s, st2;
  size_t cloc, nloc, mloc, sloc, gdec, cst, nst, mst, sst;
};
constexpr int WIN_NPAD = 256;
inline Ws carve_ws(const Dm& d) { Ws w{}; const size_t M = (size_t)rows_of(d); size_t c = 0; auto al = [&](size_t bytes) { const size_t p = c; c += (bytes + 255) / 256 * 256; return p; };
  const Lay l = lay_of(d); const size_t D = d.D, FF = d.FF; const size_t winN = ((size_t)l.ZW + ZGP + WIN_NPAD - 1) / WIN_NPAD * WIN_NPAD;
  w.ctl = al(1 << 20); w.wgu1 = al(2 * FF * D * 2); w.wd1 = al(D * FF * 2); w.win = al(winN * D * 2); w.wout = al(D * D * 2); w.wq = al(D * D * 2); w.wkv = al(2 * D * D * 2); w.wo = al(D * D * 2); w.wgu2 = al(2 * FF * D * 2); w.wd2 = al(D * FF * 2);
  w.ssq = al(M * NSSQ * 4); w.mssq = al((size_t)d.B * d.NMEM * 4); w.memb = al((size_t)d.B * d.NMEM * D * 2); w.kb = al((size_t)d.B * d.NMEM * D * 2); w.vt = al((size_t)d.B * d.NMEM * D * 2);
  w.xb = al(M * D * 2); w.xf = al(M * D * 4); w.zg = al(M * ZGP * 4);
  size_t r1 = M * FF * 2; if (M * l.ZW * 2 > r1) r1 = M * l.ZW * 2; if (2 * M * D * 2 + 256 > r1) r1 = 2 * M * D * 2 + 256; w.r1 = al(r1); w.q = w.r1; w.o = w.r1 + (M * D * 2 + 255) / 256 * 256;
  const size_t NCH = (size_t)d.B * (d.T / 64 > 0 ? d.T / 64 : 1);
  const size_t r2s = c; w.r2 = c;
  w.cloc = al(NCH * d.MLH * d.DK * d.DV * 4); w.sloc = al(NCH * d.GH * d.GDK * d.GDV * 4); w.cst = al(NCH * d.MLH * d.DK * d.DV * 2); w.sst = al(NCH * d.GH * d.GDK * d.GDV * 2);
  w.nloc = al(NCH * d.MLH * d.DK * 4); w.mloc = al(NCH * d.MLH * 2 * 4); w.gdec = al(NCH * d.GH * d.GDK * 4); w.nst = al(NCH * d.MLH * d.DK * 4); w.mst = al(NCH * d.MLH * 4);
  const size_t opt_end = c;
  c = r2s; w.hr = al(M * D * 4); w.pn = al(M * d.MLH * d.DK * 4); w.al = al(M * d.GH * d.GDK * 4); w.fd = al(M * d.MLH * 4); w.iw = al(M * d.MLH * 4); w.mt = al(M * d.MLH * 4); const size_t nv1_end = c;
  c = r2s; w.s = al(M * d.XH * d.NMEM * 4); w.st2 = al(M * d.XH * 2 * 4); const size_t nv2_end = c;
  c = opt_end > nv1_end ? opt_end : nv1_end; if (nv2_end > c) c = nv2_end;
  w.ymix = al(M * D * 2); w.total = c; return w; }
#ifdef __HIPCC__
template <class F> __global__ void __launch_bounds__(256) run_k(F f, long n) { for (long i = blockIdx.x * (long)blockDim.x + threadIdx.x; i < n; i += (long)gridDim.x * blockDim.x) f(i); }
template <class F> __global__ void __launch_bounds__(64) run_k64(F f, long n) { for (long i = blockIdx.x * (long)blockDim.x + threadIdx.x; i < n; i += (long)gridDim.x * blockDim.x) f(i); }
#define NV_RUN(F, n) do { const long n_ = (n); long g_ = (n_ + 255) / 256; if (g_ > 65536) g_ = 65536; hipLaunchKernelGGL(nv::run_k, dim3((unsigned)g_), dim3(256), 0, stream, F, n_); } while (0)
#define NV_RUN64(F, n) do { const long n_ = (n); long g_ = (n_ + 63) / 64; hipLaunchKernelGGL(nv::run_k64, dim3((unsigned)g_), dim3(64), 0, stream, F, n_); } while (0)
#define NV_STREAM_ARG , hipStream_t stream
#define NV_S , stream
#else
#define NV_RUN(F, n) do { const long n_ = (n); for (long i_ = 0; i_ < n_; ++i_) F(i_); } while (0)
#define NV_RUN64(F, n) NV_RUN(F, n)
#define NV_STREAM_ARG
#define NV_S
#endif
struct OutOff { long yp, ys, mk, mv, cp, np, mp, sp, cs, ns, ms, ss, total; };
inline OutOff out_off(const Dm& d) { OutOff o; long c = 0; o.yp = c; c += (long)d.B * d.T * d.D; o.ys = c; c += (long)d.SB * d.ST * d.D; o.mk = c; c += (long)d.B * d.NMEM * d.D; o.mv = c; c += (long)d.B * d.NMEM * d.D;
  o.cp = c; c += (long)d.B * d.MLH * d.DK * d.DV; o.np = c; c += (long)d.B * d.MLH * d.DK; o.mp = c; c += (long)d.B * d.MLH; o.sp = c; c += (long)d.B * d.GH * d.GDK * d.GDV;
  o.cs = c; c += (long)d.SB * d.MLH * d.DK * d.DV; o.ns = c; c += (long)d.SB * d.MLH * d.DK; o.ms = c; c += (long)d.SB * d.MLH; o.ss = c; c += (long)d.SB * d.GH * d.GDK * d.GDV; o.total = c; return o; }
enum In { I_XP, I_XS, I_MEM, I_CK, I_CV, I_SC, I_SN, I_SM, I_SS, I_F1G, I_F1WG, I_F1WU, I_F1WD, I_MIXG, I_WIN, I_BI, I_BF, I_MLOG, I_WA2, I_BA, I_GLOG, I_WOUT, I_XG, I_MEMG, I_WQ, I_WK, I_WV, I_WO, I_F2G, I_F2WG, I_F2WU, I_F2WD, I_FING };
struct Ctx { Dm d; Ws w; OutOff oo; const float* const* in; float* out; unsigned char* ws;
  template <class T> T* p(size_t off) const { return (T*)(ws + off); } };
inline void nv_p0_rows(const Ctx& c NV_STREAM_ARG) { const Dm& d = c.d; const long M = rows_of(d), PR = (long)d.B * d.T;
  { NProX k{c.in[I_XP], c.in[I_XS], c.p<bf16_t>(c.w.xb), c.p<float>(c.w.ssq), PR, d.D, NSSQ}; NV_RUN(k, M); }
  { NProX k{c.in[I_MEM], c.in[I_MEM], c.p<bf16_t>(c.w.memb), c.p<float>(c.w.mssq), (long)d.B * d.NMEM, d.D, 1}; NV_RUN(k, (long)d.B * d.NMEM); } }
inline void nv_kv(const Ctx& c NV_STREAM_ARG) { const Dm& d = c.d; NKV k{d, c.p<bf16_t>(c.w.memb), c.p<float>(c.w.mssq), c.in[I_WK], c.in[I_WV], c.in[I_MEMG], c.out + c.oo.mk, c.out + c.oo.mv, c.p<bf16_t>(c.w.kb), c.p<bf16_t>(c.w.vt)}; NV_RUN(k, (long)d.B * d.NMEM * 2 * d.D / 4); }
inline void nv_up(const Ctx& c, int which NV_STREAM_ARG) { const Dm& d = c.d; NUp k{c.p<bf16_t>(c.w.xb), c.p<float>(c.w.ssq), c.in[which ? I_F2WG : I_F1WG], c.in[which ? I_F2WU : I_F1WU], c.in[which ? I_F2G : I_F1G], c.p<bf16_t>(c.w.r1), d.D, d.FF, d.eps, 0}; NV_RUN(k, rows_of(d) * d.FF / 2); }
inline void nv_resid(const Ctx& c, size_t a_off, int K, const float* W, float alpha, int first NV_STREAM_ARG) { const Dm& d = c.d; const long M = rows_of(d);
  { NResid k{c.p<bf16_t>(a_off), W, c.in[I_XP], c.in[I_XS], c.p<float>(c.w.xf), c.p<bf16_t>(c.w.xb), (long)d.B * d.T, K, d.D, alpha, first}; NV_RUN(k, M * d.D / 4); }
  { NSsq k{c.p<float>(c.w.xf), c.p<float>(c.w.ssq), d.D, 0}; NV_RUN(k, M); } }
inline void nv_win(const Ctx& c NV_STREAM_ARG) { const Dm& d = c.d; const long M = rows_of(d);
  { NZ k{d, c.p<bf16_t>(c.w.xb), c.p<float>(c.w.ssq), c.in[I_WIN], c.in[I_MIXG], c.p<bf16_t>(c.w.r1), c.p<float>(c.w.zg)}; NV_RUN(k, M * d.DIN); }
  { NZGpad k{d, c.p<float>(c.w.zg)}; NV_RUN(k, M * ZGP); } }
template <int DKC, int GDKC> inline void nv_mixer(const Ctx& c NV_STREAM_ARG) { const Dm& d = c.d; const long M = rows_of(d); const int NS = d.B + d.SB; const ZV zv{c.p<bf16_t>(c.w.r1), c.p<float>(c.w.zg), lay_of(d), 0, 0};
  float *FD = c.p<float>(c.w.fd), *IW = c.p<float>(c.w.iw), *MT = c.p<float>(c.w.mt), *PN = c.p<float>(c.w.pn), *AL = c.p<float>(c.w.al), *HR = c.p<float>(c.w.hr);
  { NMlGates k{d, zv, c.in[I_BI], c.in[I_BF], c.in[I_SM], FD, IW, MT, c.out + c.oo.mp, c.out + c.oo.ms}; NV_RUN(k, (long)NS * d.MLH); }
  { NMlN k{d, zv, c.in[I_SN], FD, IW, PN, c.out + c.oo.np, c.out + c.oo.ns}; NV_RUN(k, (long)NS * d.MLH * d.DK); }
  { NMlC<DKC> k{d, zv, c.in[I_SC], FD, IW, MT, PN, HR, c.out + c.oo.cp, c.out + c.oo.cs}; NV_RUN64(k, (long)NS * d.MLH * d.DV); }
  { NGlAlpha k{d, zv, c.in[I_WA2], c.in[I_BA], AL}; NV_RUN(k, M * d.GH * d.GDK); }
  { NGlS<GDKC> k{d, zv, c.in[I_SS], AL, HR, c.out + c.oo.sp, c.out + c.oo.ss}; NV_RUN64(k, (long)NS * d.GH * d.GDV); }
  { NHeadNorm k{d, zv, c.in[I_MLOG], c.in[I_GLOG], HR, c.p<bf16_t>(c.w.ymix)}; NV_RUN(k, M * (d.MLH + d.GH)); } }
inline void nv_q(const Ctx& c NV_STREAM_ARG) { const Dm& d = c.d; NQ k{d, c.p<bf16_t>(c.w.xb), c.p<float>(c.w.ssq), c.in[I_WQ], c.in[I_XG], c.p<bf16_t>(c.w.q)}; NV_RUN(k, rows_of(d) * d.D / 4); }
inline void nv_attn(const Ctx& c NV_STREAM_ARG) { const Dm& d = c.d; const long M = rows_of(d);
  { NScores k{d, c.p<bf16_t>(c.w.q), c.p<bf16_t>(c.w.kb), c.in[I_CK], c.p<float>(c.w.s)}; NV_RUN(k, M * d.XH * d.NMEM); }
  { NSoftStats k{d, c.p<float>(c.w.s), c.p<float>(c.w.st2)}; NV_RUN(k, M * d.XH); }
  { NPV k{d, c.p<float>(c.w.s), c.p<float>(c.w.st2), c.p<bf16_t>(c.w.vt), c.in[I_CV], c.p<bf16_t>(c.w.o)}; NV_RUN(k, M * d.D); } }
inline void nv_final(const Ctx& c NV_STREAM_ARG) { const Dm& d = c.d; NFinal k{c.p<float>(c.w.xf), c.p<float>(c.w.ssq), c.in[I_FING], c.out + c.oo.yp, d.D, d.eps}; NV_RUN(k, rows_of(d) * d.D); }
template <int DKC, int GDKC> inline void run_naive(const Ctx& c NV_STREAM_ARG) {
  nv_p0_rows(c NV_S); nv_kv(c NV_S);
  nv_up(c, 0 NV_S); nv_resid(c, c.w.r1, c.d.FF, c.in[I_F1WD], 0.5f, 1 NV_S);
  nv_win(c NV_S); nv_mixer<DKC, GDKC>(c NV_S);
  nv_resid(c, c.w.ymix, c.d.D, c.in[I_WOUT], 1.f, 0 NV_S);
  nv_q(c NV_S); nv_attn(c NV_S); nv_resid(c, c.w.o, c.d.D, c.in[I_WO], 1.f, 0 NV_S);
  nv_up(c, 1 NV_S); nv_resid(c, c.w.r1, c.d.FF, c.in[I_F2WD], 0.5f, 0 NV_S);
  nv_final(c NV_S);
}
}
static nv::Dm full_dims() { nv::Dm d{1024, 8, 2048, 128, 4, 4, 128, 128, 4, 64, 128, 16, 256, 4, 256, 2816, 3608, 0, 1e-6f, 16.f}; return d; }
extern "C" void kernel_launch(void* const* d_in, const int* in_sizes, int n_in, void* d_out, int out_size, void* d_ws, size_t ws_size, hipStream_t stream) {
  const nv::Dm d = full_dims();
  static const float* in[33];
  nv::Ctx c{d, nv::carve_ws(d), nv::out_off(d), in, (float*)d_out, (unsigned char*)d_ws};
  if (n_in != 33 || (long)out_size != c.oo.total || ws_size < c.w.total) { fprintf(stderr, "kernel_launch: unexpected n_in %d / out_size %d / ws %zu\n", n_in, out_size, ws_size); return; }
  for (int i = 0; i < 33; ++i) in[i] = (const float*)d_in[i];
  nv::run_naive<128, 64>(c, stream);
}
```

```cpp
#include <hip/hip_runtime.h>
#include <cstdio>
#include <cstdint>
#include <cstring>
#include <cmath>
#ifdef __HIPCC__
#define SHD __host__ __device__ __forceinline__
#else
#define SHD inline
#include <cmath>
#endif
namespace nv {
typedef unsigned short bf16_t;
SHD float bf2f(bf16_t v) { union { unsigned u; float f; } x; x.u = (unsigned)v << 16; return x.f; }
SHD bf16_t f2bf(float f) { union { unsigned u; float f; } x; x.f = f; return (bf16_t)((x.u + 0x7fffu + ((x.u >> 16) & 1u)) >> 16); }
struct Dm { int D, B, T, SB, ST, MLH, DK, DV, GH, GDK, GDV, RANK, NMEM, XH, XDH, FF, DIN, pad; float eps, tau; };
SHD long rows_of(const Dm& d) { return (long)d.B * d.T + (long)d.SB * d.ST; }
constexpr int ZGP = 32, NSSQ = 16;
}

namespace nv {
struct Ws {
  size_t ctl, wgu1, wd1, win, wout, wq, wkv, wo, wgu2, wd2, ssq, mssq, memb, kb, vt, xb, xf, zg, r1, r2, ymix, total;
  size_t q, o, hr, pn, al, fd, iw, mt, s, st2;
  size_t cloc, nloc, mloc, sloc, gdec, cst, nst, mst, sst;
};
constexpr int WIN_NPAD = 256;
struct Carver { size_t c; constexpr size_t al(size_t bytes) { const size_t p = c; c += (bytes + 255) / 256 * 256; return p; } };
constexpr Ws carve_ws(const Dm& d) { Ws w{}; const size_t M = (size_t)d.B * d.T + (size_t)d.SB * d.ST; Carver a{0};
  const size_t ZWc = (size_t)(2 * d.MLH * d.DK + 2 * d.MLH * d.DV + 2 * d.GH * d.GDK + 2 * d.GH * d.GDV); const size_t D = d.D, FF = d.FF; const size_t winN = (ZWc + ZGP + WIN_NPAD - 1) / WIN_NPAD * WIN_NPAD;
  w.ctl = a.al(1 << 20); w.wgu1 = a.al(2 * FF * D * 2); w.wd1 = a.al(D * FF * 2); w.win = a.al(winN * D * 2); w.wout = a.al(D * D * 2); w.wq = a.al(D * D * 2); w.wkv = a.al(2 * D * D * 2); w.wo = a.al(D * D * 2); w.wgu2 = a.al(2 * FF * D * 2); w.wd2 = a.al(D * FF * 2);
  w.ssq = a.al(M * NSSQ * 4); w.mssq = a.al((size_t)d.B * d.NMEM * 4); w.memb = a.al((size_t)d.B * d.NMEM * D * 2); w.kb = a.al((size_t)d.B * d.NMEM * D * 2); w.vt = a.al((size_t)d.B * d.NMEM * D * 2);
  w.xb = a.al(M * D * 2); w.xf = a.al(M * D * 4); w.zg = a.al(M * ZGP * 4);
  size_t r1 = M * FF * 2; if (M * ZWc * 2 > r1) r1 = M * ZWc * 2; if (2 * M * D * 2 + 256 > r1) r1 = 2 * M * D * 2 + 256; w.r1 = a.al(r1); w.q = w.r1; w.o = w.r1 + (M * D * 2 + 255) / 256 * 256;
  const size_t NCH = (size_t)d.B * (d.T / 64 > 0 ? d.T / 64 : 1);
  const size_t r2s = a.c; w.r2 = a.c;
  w.cloc = a.al(NCH * d.MLH * d.DK * d.DV * 4); w.sloc = a.al(NCH * d.GH * d.GDK * d.GDV * 4); w.cst = a.al(NCH * d.MLH * d.DK * d.DV * 2); w.sst = a.al(NCH * d.GH * d.GDK * d.GDV * 2);
  w.nloc = a.al(NCH * d.MLH * d.DK * 4); w.mloc = a.al(NCH * d.MLH * 2 * 4); w.gdec = a.al(NCH * d.GH * d.GDK * 4); w.nst = a.al(NCH * d.MLH * d.DK * 4); w.mst = a.al(NCH * d.MLH * 4);
  const size_t opt_end = a.c;
  a.c = r2s; w.hr = a.al(M * D * 4); w.pn = a.al(M * d.MLH * d.DK * 4); w.al = a.al(M * d.GH * d.GDK * 4); w.fd = a.al(M * d.MLH * 4); w.iw = a.al(M * d.MLH * 4); w.mt = a.al(M * d.MLH * 4); const size_t nv1_end = a.c;
  a.c = r2s; w.s = a.al(M * d.XH * d.NMEM * 4); w.st2 = a.al(M * d.XH * 2 * 4); const size_t nv2_end = a.c;
  a.c = opt_end > nv1_end ? opt_end : nv1_end; if (nv2_end > a.c) a.c = nv2_end;
  w.ymix = a.al(M * D * 2); w.total = a.c; return w; }
struct OutOff { long yp, ys, mk, mv, cp, np, mp, sp, cs, ns, ms, ss, total; };
constexpr OutOff out_off(const Dm& d) { OutOff o{}; long c = 0; o.yp = c; c += (long)d.B * d.T * d.D; o.ys = c; c += (long)d.SB * d.ST * d.D; o.mk = c; c += (long)d.B * d.NMEM * d.D; o.mv = c; c += (long)d.B * d.NMEM * d.D;
  o.cp = c; c += (long)d.B * d.MLH * d.DK * d.DV; o.np = c; c += (long)d.B * d.MLH * d.DK; o.mp = c; c += (long)d.B * d.MLH; o.sp = c; c += (long)d.B * d.GH * d.GDK * d.GDV;
  o.cs = c; c += (long)d.SB * d.MLH * d.DK * d.DV; o.ns = c; c += (long)d.SB * d.MLH * d.DK; o.ms = c; c += (long)d.SB * d.MLH; o.ss = c; c += (long)d.SB * d.GH * d.GDK * d.GDV; o.total = c; return o; }
enum In { I_XP, I_XS, I_MEM, I_CK, I_CV, I_SC, I_SN, I_SM, I_SS, I_F1G, I_F1WG, I_F1WU, I_F1WD, I_MIXG, I_WIN, I_BI, I_BF, I_MLOG, I_WA2, I_BA, I_GLOG, I_WOUT, I_XG, I_MEMG, I_WQ, I_WK, I_WV, I_WO, I_F2G, I_F2WG, I_F2WU, I_F2WD, I_FING };
}
__device__ __forceinline__ int my_lane() { int l = (int)__builtin_amdgcn_mbcnt_hi(~0u, __builtin_amdgcn_mbcnt_lo(~0u, 0u)); asm volatile("" : "+v"(l)); return l; }
__device__ __forceinline__ float shx(float v, int mask) { return __builtin_bit_cast(float, __builtin_amdgcn_ds_bpermute((my_lane() ^ mask) << 2, __builtin_bit_cast(int, v))); }
__device__ __forceinline__ float shl(float v, int src) { return __builtin_bit_cast(float, __builtin_amdgcn_ds_bpermute(src << 2, __builtin_bit_cast(int, v))); }
namespace pg8 {
#define PG8_LAS __attribute__((address_space(3)))
typedef unsigned short bf16_t;
typedef short bf16x8 __attribute__((ext_vector_type(8)));
typedef float f32x4 __attribute__((ext_vector_type(4)));
typedef unsigned u32x4 __attribute__((ext_vector_type(4)));
constexpr int BM = 256, BK = 64, HALF = 128, HTB = HALF * BK * 2  , STAGE_BYTES = 8 * HTB, NXCD = 8, WGM = 8;

__host__ __device__ __forceinline__ int lds_byte(int r, int c) { const int st = (r >> 4) * 2 + (c >> 5), rr = r & 15, cc = c & 31, ob = rr * 64 + cc * 2; return st * 1024 + (ob ^ (((ob >> 9) & 1) << 5)); }
__host__ __device__ __forceinline__ void stage_rc(int b, int& R, int& C) { const int st = b / 1024, sb = b % 1024, swz = sb ^ (((sb >> 9) & 1) << 5); R = (st >> 1) * 16 + swz / 64; C = (st & 1) * 32 + (swz % 64) / 2; }
__host__ __device__ __forceinline__ int perm32(int rho) { const int n = rho >> 4, i = rho & 15; return 8 * (i >> 2) + 4 * n + (i & 3); }

struct Unit { int pm, pn, idx; };
struct Gemm { const bf16_t* A; const bf16_t* Bt; int M, N, K; };

struct StaticOrder {
    int nM, nN, nwg, G, c;
    __host__ __device__ void init(int M, int N, int G_, int c_) { nM = M / BM; nN = N / BM; nwg = nM * nN; G = G_; c = c_; }
    __host__ __device__ bool next(int i, Unit& u) const {
        const long L = (long)i * G + c; if (L >= nwg) return false;
        int wgid = (int)L; { const int q = nwg / NXCD, r = nwg % NXCD, xcd = wgid % NXCD, off = wgid / NXCD; wgid = (xcd < r ? xcd * (q + 1) : r * (q + 1) + (xcd - r) * q) + off; }
        const int nig = WGM * nN, gid = wgid / nig, fm = gid * WGM, gsz = (nM - fm) < WGM ? (nM - fm) : WGM;
        u.pm = fm + ((wgid % nig) % gsz); u.pn = (wgid % nig) / gsz; u.idx = i; return true;
    }
    __device__ __forceinline__ void a_ready(const Unit&) const {}
    __device__ __forceinline__ void done(const Unit&) const {}
};

__device__ __forceinline__ unsigned cvt_pk_bf16(float lo, float hi) { unsigned r; asm volatile("v_cvt_pk_bf16_f32 %0, %1, %2" : "=v"(r) : "v"(lo), "v"(hi)); return r; }
template <class Epi, class Sched, bool ALIGN_EPI = false, bool SP2 = false>
__device__ __forceinline__ void gemm_phase(PG8_LAS unsigned char* lds, const Gemm g, const Sched& S, const Epi& E, const int tid) {
    const int wid = __builtin_amdgcn_readfirstlane(tid >> 6), lane = tid & 63, wr = wid >> 2, wc = wid & 3, fr = lane & 15, fq = lane >> 4;
    const int K = g.K, nt = K / BK;
    unsigned voffA[2], voffB[2];
#pragma unroll
    for (int i = 0; i < 2; ++i) { int R, C; stage_rc(tid * 16 + i * 8192, R, C); const int Rb = Epi::PERM ? ((R & ~31) + perm32(R & 31)) : R;
        voffA[i] = (unsigned)(R * K + C) * 2u; voffB[i] = (unsigned)(Rb * K + C) * 2u; }
    const size_t kstep = (size_t)(BK * 2);
    const size_t hstep = (size_t)HALF * K * 2;
    const size_t tstep = 2 * hstep;
    const unsigned ldsw = (unsigned)wid * 1024u;
    const int aoff = lds_byte(wr * 64 + fr, fq * 8), boff = lds_byte(wc * 32 + fr, fq * 8);
#define PG8_SA(b, h) (((b) * 2 + (h)) * HTB)
#define PG8_SB(b, h) ((4 + (b) * 2 + (h)) * HTB)
#define PG8_STAGE(bufoff, gbase, voff) do { _Pragma("unroll") for (int _i = 0; _i < 2; ++_i) \
        __builtin_amdgcn_global_load_lds((const unsigned*)((const char*)(gbase) + (voff)[_i]), (PG8_LAS unsigned*)(lds + (bufoff) + ldsw + _i * 8192), 16, 0, 0); } while (0)
#define PG8_LDA(dst, b, h) do { _Pragma("unroll") for (int m = 0; m < 4; ++m) _Pragma("unroll") for (int k = 0; k < 2; ++k) dst[m][k] = *(const PG8_LAS bf16x8*)(lds + PG8_SA(b, h) + aoff + m * 2048 + k * 1024); } while (0)
#define PG8_LDB(dst, b, h) do { _Pragma("unroll") for (int n = 0; n < 2; ++n) _Pragma("unroll") for (int k = 0; k < 2; ++k) dst[n][k] = *(const PG8_LAS bf16x8*)(lds + PG8_SB(b, h) + boff + n * 2048 + k * 1024); } while (0)
#define PG8_MMA(ai, bj, At, Bt) do { __builtin_amdgcn_s_setprio(1); _Pragma("unroll") for (int m = 0; m < 4; ++m) _Pragma("unroll") for (int n = 0; n < 2; ++n) _Pragma("unroll") for (int k = 0; k < 2; ++k) \
        acc[ai][bj][m][n] = __builtin_amdgcn_mfma_f32_16x16x32_bf16(Bt[n][k], At[m][k], acc[ai][bj][m][n], 0, 0, 0); __builtin_amdgcn_s_setprio(0); } while (0)
#define PG8_WAIT_V(n) asm volatile("s_waitcnt vmcnt(" #n ")" ::: "memory")
#define PG8_WAIT_L(n) asm volatile("s_waitcnt lgkmcnt(" #n ")" ::: "memory")
#define PG8_BAR __builtin_amdgcn_s_barrier()
#define PG8_SCHED __builtin_amdgcn_sched_barrier(0)
    Unit cur, nxt; int ui = 0;
    if (!S.next(0, cur)) return;
    f32x4 acc[2][2][4][2];
#pragma unroll
    for (int a = 0; a < 2; ++a)
#pragma unroll
        for (int b = 0; b < 2; ++b)
#pragma unroll
            for (int m = 0; m < 4; ++m)
#pragma unroll
                for (int n = 0; n < 2; ++n) acc[a][b][m][n] = (f32x4){0.f, 0.f, 0.f, 0.f};
    bf16x8 At[4][2], B0[2][2], B1[2][2];
    const char* cA = (const char*)g.A + (size_t)cur.pm * tstep; const char* cB = (const char*)g.Bt + (size_t)cur.pn * tstep;
    S.a_ready(cur);
    if constexpr (SP2) {
        PG8_STAGE(PG8_SB(0, 0), cB, voffB); PG8_STAGE(PG8_SB(0, 1), cB + hstep, voffB); PG8_STAGE(PG8_SA(0, 0), cA, voffA); PG8_STAGE(PG8_SA(0, 1), cA + hstep, voffA);
        if (wr == 1) PG8_BAR;
        PG8_WAIT_V(2); PG8_BAR;
        PG8_STAGE(PG8_SB(1, 0), cB + kstep, voffB); PG8_STAGE(PG8_SA(1, 0), cA + kstep, voffA); PG8_STAGE(PG8_SB(1, 1), cB + hstep + kstep, voffB);
        PG8_WAIT_V(6); PG8_BAR;
    } else {
        PG8_STAGE(PG8_SB(0, 0), cB, voffB); PG8_STAGE(PG8_SA(0, 0), cA, voffA); PG8_STAGE(PG8_SB(0, 1), cB + hstep, voffB); PG8_STAGE(PG8_SA(0, 1), cA + hstep, voffA);
        if (wr == 1) PG8_BAR;
        PG8_WAIT_V(4); PG8_BAR;
        PG8_STAGE(PG8_SB(1, 0), cB + kstep, voffB); PG8_STAGE(PG8_SA(1, 0), cA + kstep, voffA); PG8_STAGE(PG8_SB(1, 1), cB + hstep + kstep, voffB);
        PG8_WAIT_V(6); PG8_BAR;
    }
    for (;;) {
        const bool has_next = S.next(ui + 1, nxt);
        const char* nA = has_next ? (const char*)g.A + (size_t)nxt.pm * tstep : cA; const char* nB = has_next ? (const char*)g.Bt + (size_t)nxt.pn * tstep : cB;
        for (int t = 0; t < nt; t += 2) {
            const bool last = (t == nt - 2);
            const char* a1 = cA + (size_t)(t + 1) * kstep;
            const char* a2 = last ? nA : cA + (size_t)(t + 2) * kstep; const char* b2 = last ? nB : cB + (size_t)(t + 2) * kstep;
            const char* a3 = a2 + kstep; const char* b3 = b2 + kstep;
            if (last && has_next) S.a_ready(nxt);
            if constexpr (SP2) {
            PG8_LDB(B0, 0, 0); PG8_LDB(B1, 0, 1); PG8_SCHED; PG8_LDA(At, 0, 0); PG8_STAGE(PG8_SA(1, 1), a1 + hstep, voffA);
            PG8_WAIT_V(8); PG8_WAIT_L(0); PG8_BAR; PG8_MMA(0, 0, At, B0); PG8_MMA(0, 1, At, B1); PG8_BAR; PG8_SCHED;
            PG8_LDA(At, 0, 1); PG8_STAGE(PG8_SB(0, 0), b2, voffB); PG8_STAGE(PG8_SB(0, 1), b2 + hstep, voffB); PG8_STAGE(PG8_SA(0, 0), a2, voffA);
            PG8_WAIT_V(8); PG8_WAIT_L(0); PG8_BAR; PG8_MMA(1, 0, At, B0); PG8_MMA(1, 1, At, B1); PG8_BAR; PG8_SCHED;
            PG8_LDB(B0, 1, 0); PG8_LDB(B1, 1, 1); PG8_SCHED; PG8_LDA(At, 1, 0); PG8_STAGE(PG8_SA(0, 1), a2 + hstep, voffA);
            PG8_WAIT_V(8); PG8_WAIT_L(0); PG8_BAR; PG8_MMA(0, 0, At, B0); PG8_MMA(0, 1, At, B1); PG8_BAR; PG8_SCHED;
            PG8_LDA(At, 1, 1); PG8_STAGE(PG8_SB(1, 0), b3, voffB); PG8_STAGE(PG8_SB(1, 1), b3 + hstep, voffB); PG8_STAGE(PG8_SA(1, 0), a3, voffA);
            PG8_WAIT_V(8); PG8_WAIT_L(0); PG8_BAR; PG8_MMA(1, 0, At, B0); PG8_MMA(1, 1, At, B1); PG8_BAR; PG8_SCHED;
            } else {
            PG8_LDB(B0, 0, 0); PG8_SCHED; PG8_LDA(At, 0, 0); PG8_STAGE(PG8_SA(1, 1), a1 + hstep, voffA);
            PG8_WAIT_L(8); PG8_BAR; PG8_WAIT_L(0); PG8_MMA(0, 0, At, B0); PG8_BAR; PG8_SCHED;
            PG8_LDB(B1, 0, 1); PG8_STAGE(PG8_SB(0, 0), b2, voffB);
            PG8_BAR; PG8_WAIT_L(0); PG8_MMA(0, 1, At, B1); PG8_BAR;
            PG8_LDA(At, 0, 1); PG8_STAGE(PG8_SA(0, 0), a2, voffA);
            PG8_BAR; PG8_WAIT_L(0); PG8_MMA(1, 0, At, B0); PG8_BAR; PG8_SCHED;
            PG8_STAGE(PG8_SB(0, 1), b2 + hstep, voffB);
            PG8_WAIT_V(6); PG8_BAR; PG8_MMA(1, 1, At, B1); PG8_BAR;
            PG8_LDB(B0, 1, 0); PG8_SCHED; PG8_LDA(At, 1, 0); PG8_STAGE(PG8_SA(0, 1), a2 + hstep, voffA);
            PG8_WAIT_L(8); PG8_BAR; PG8_WAIT_L(0); PG8_MMA(0, 0, At, B0); PG8_BAR; PG8_SCHED;
            PG8_LDB(B1, 1, 1); PG8_STAGE(PG8_SB(1, 0), b3, voffB);
            PG8_BAR; PG8_WAIT_L(0); PG8_MMA(0, 1, At, B1); PG8_BAR;
            PG8_LDA(At, 1, 1); PG8_STAGE(PG8_SA(1, 0), a3, voffA);
            PG8_BAR; PG8_WAIT_L(0); PG8_MMA(1, 0, At, B0); PG8_BAR; PG8_SCHED;
            PG8_STAGE(PG8_SB(1, 1), b3 + hstep, voffB);
            PG8_WAIT_V(6); PG8_BAR; PG8_MMA(1, 1, At, B1); PG8_BAR;
            }
        }
        if constexpr (ALIGN_EPI) { if (wr == 0) PG8_BAR; }
        if constexpr (!Epi::AFTER_DRAIN) { E(acc, cur, wr, wc, fr, fq); S.done(cur); }
        if (!has_next) break;
#pragma unroll
        for (int a = 0; a < 2; ++a)
#pragma unroll
            for (int b = 0; b < 2; ++b)
#pragma unroll
                for (int m = 0; m < 4; ++m)
#pragma unroll
                    for (int n = 0; n < 2; ++n) acc[a][b][m][n] = (f32x4){0.f, 0.f, 0.f, 0.f};
        cur = nxt; cA = nA; cB = nB; ++ui;
        if constexpr (ALIGN_EPI) { if (wr == 1) PG8_BAR; }
    }
    PG8_WAIT_V(0);
    if constexpr (!ALIGN_EPI) { if (wr == 0) PG8_BAR; }
    PG8_BAR;
    if constexpr (Epi::AFTER_DRAIN) { E.fused(acc, cur, wr, wc, fr, fq, lds, wid, lane); S.done(cur); }
#undef PG8_SA
#undef PG8_SB
#undef PG8_STAGE
#undef PG8_LDA
#undef PG8_LDB
#undef PG8_MMA
#undef PG8_WAIT_V
#undef PG8_WAIT_L
#undef PG8_BAR
#undef PG8_SCHED
}
}
namespace pg8 {
typedef unsigned u32x2 __attribute__((ext_vector_type(2)));
constexpr int DMODEL = 1024, NSSQ = 16;
constexpr float RMS_EPS = 1e-6f;
__device__ __forceinline__ float row_rstd(const float* ssq, int row, int fq) {
    const f32x4 v = *(const f32x4*)(ssq + (size_t)row * NSSQ + 4 * fq); float s = (v[0] + v[1]) + (v[2] + v[3]); s += shx(s, 16); s += shx(s, 32);
    return rsqrtf(s * (1.0f / DMODEL) + RMS_EPS); }
__device__ __forceinline__ float silu_f(float g) { return g * __builtin_amdgcn_rcpf(1.0f + __expf(-g)); }
struct EpiSwiglu { static constexpr bool PERM = false, AFTER_DRAIN = false;
    bf16_t* H; const float* ssq; int ldh, pad;
    __device__ __forceinline__ void operator()(const f32x4 (&acc)[2][2][4][2], const Unit& u, int wr, int wc, int fr, int fq) const {
#pragma unroll
        for (int ai = 0; ai < 2; ++ai)
#pragma unroll
            for (int m = 0; m < 4; ++m) { const int row = u.pm * BM + ai * HALF + wr * 64 + m * 16 + fr; const float rs = row_rstd(ssq, row, fq);
#pragma unroll
                for (int bj = 0; bj < 2; ++bj) { const f32x4 g = acc[ai][bj][m][0] * rs, up = acc[ai][bj][m][1] * rs; u32x2 w;
                    w.x = cvt_pk_bf16(silu_f(g[0]) * up[0], silu_f(g[1]) * up[1]); w.y = cvt_pk_bf16(silu_f(g[2]) * up[2], silu_f(g[3]) * up[3]);
                    *(u32x2*)(H + (size_t)row * ldh + u.pn * 128 + bj * 64 + wc * 16 + 4 * fq) = w; } asm volatile("" ::: "memory"); }
    }
};
struct EpiResid { static constexpr bool PERM = false, AFTER_DRAIN = false;
    const float* xp; const float* xs; float* XF; bf16_t* XB; float* ssq; float alpha; int first;
    __device__ __forceinline__ void operator()(const f32x4 (&acc)[2][2][4][2], const Unit& u, int wr, int wc, int fr, int fq) const {
#pragma unroll
        for (int ai = 0; ai < 2; ++ai) { u32x2 bw[4][2][2];
#pragma unroll
            for (int m = 0; m < 4; ++m)
#pragma unroll
                for (int bj = 0; bj < 2; ++bj)
#pragma unroll
                    for (int n = 0; n < 2; ++n) bw[m][bj][n] = *(const u32x2*)(XB + (size_t)(u.pm * BM + ai * HALF + wr * 64 + m * 16 + fr) * DMODEL + u.pn * BM + bj * HALF + wc * 32 + n * 16 + 4 * fq);
#pragma unroll
            for (int m = 0; m < 4; ++m) { const int row = u.pm * BM + ai * HALF + wr * 64 + m * 16 + fr; float q = 0.f;
#pragma unroll
                for (int bj = 0; bj < 2; ++bj)
#pragma unroll
                    for (int n = 0; n < 2; ++n) { const int col = u.pn * BM + bj * HALF + wc * 32 + n * 16 + 4 * fq; const u32x2 w0 = bw[m][bj][n];
                        const f32x4 b = {__uint_as_float(w0.x << 16), __uint_as_float(w0.x & 0xffff0000u), __uint_as_float(w0.y << 16), __uint_as_float(w0.y & 0xffff0000u)};
                        const f32x4 o = b + acc[ai][bj][m][n] * alpha;
                        u32x2 w; w.x = cvt_pk_bf16(o[0], o[1]); w.y = cvt_pk_bf16(o[2], o[3]); *(u32x2*)(XB + (size_t)row * DMODEL + col) = w;
                        q += (o[0] * o[0] + o[1] * o[1]) + (o[2] * o[2] + o[3] * o[3]); }
                q += shx(q, 16); q += shx(q, 32);
                if (fq == 0) ssq[(size_t)row * NSSQ + u.pn * 4 + wc] = q; }
            asm volatile("" ::: "memory"); }
    }
};
struct EpiZ { static constexpr bool PERM = true, AFTER_DRAIN = false;
    bf16_t* Z; float* ZG; const float* ssq;
    __device__ __forceinline__ void operator()(const f32x4 (&acc)[2][2][4][2], const Unit& u, int wr, int wc, int fr, int fq) const {
        constexpr int ZW = 3584, ZGP = 32;
#pragma unroll
        for (int ai = 0; ai < 2; ++ai)
#pragma unroll
            for (int m = 0; m < 4; ++m) { const int row = u.pm * BM + ai * HALF + wr * 64 + m * 16 + fr; const float rs = row_rstd(ssq, row, fq);
                if (u.pn < ZW / BM) {
#pragma unroll
                    for (int bj = 0; bj < 2; ++bj) { const f32x4 v0 = acc[ai][bj][m][0] * rs, v1 = acc[ai][bj][m][1] * rs; u32x4 w; w.x = cvt_pk_bf16(v0[0], v0[1]); w.y = cvt_pk_bf16(v0[2], v0[3]); w.z = cvt_pk_bf16(v1[0], v1[1]); w.w = cvt_pk_bf16(v1[2], v1[3]);
                        *(u32x4*)(Z + (size_t)row * ZW + u.pn * BM + bj * HALF + wc * 32 + 8 * fq) = w; }
                } else if (wc == 0) { *(f32x4*)(ZG + (size_t)row * ZGP + 8 * fq) = acc[ai][0][m][0] * rs; *(f32x4*)(ZG + (size_t)row * ZGP + 8 * fq + 4) = acc[ai][0][m][1] * rs; } asm volatile("" ::: "memory"); }
    }
};
struct EpiQ { static constexpr bool PERM = true, AFTER_DRAIN = false;
    bf16_t* Q; const float* ssq;
    __device__ __forceinline__ void operator()(const f32x4 (&acc)[2][2][4][2], const Unit& u, int wr, int wc, int fr, int fq) const {
#pragma unroll
        for (int ai = 0; ai < 2; ++ai)
#pragma unroll
            for (int m = 0; m < 4; ++m) { const int row = u.pm * BM + ai * HALF + wr * 64 + m * 16 + fr; const float rs = row_rstd(ssq, row, fq);
#pragma unroll
                for (int bj = 0; bj < 2; ++bj) { const f32x4 v0 = acc[ai][bj][m][0] * rs, v1 = acc[ai][bj][m][1] * rs; u32x4 w; w.x = cvt_pk_bf16(v0[0], v0[1]); w.y = cvt_pk_bf16(v0[2], v0[3]); w.z = cvt_pk_bf16(v1[0], v1[1]); w.w = cvt_pk_bf16(v1[2], v1[3]);
                    *(u32x4*)(Q + (size_t)row * DMODEL + u.pn * BM + bj * HALF + wc * 32 + 8 * fq) = w; } asm volatile("" ::: "memory"); }
    }
};
struct EpiKV { static constexpr bool PERM = false, AFTER_DRAIN = false;
    float* outk; float* outv; bf16_t* KB; bf16_t* VT; const float* mssq;
    __device__ __forceinline__ void operator()(const f32x4 (&acc)[2][2][4][2], const Unit& u, int wr, int wc, int fr, int fq) const {
#pragma unroll
        for (int ai = 0; ai < 2; ++ai)
#pragma unroll
            for (int m = 0; m < 4; ++m) { const int row = u.pm * BM + ai * HALF + wr * 64 + m * 16 + fr; const float rs = rsqrtf(mssq[row] * (1.0f / DMODEL) + RMS_EPS);
#pragma unroll
                for (int bj = 0; bj < 2; ++bj)
#pragma unroll
                    for (int n = 0; n < 2; ++n) { const int cl = bj * HALF + wc * 32 + n * 16 + 4 * fq; const f32x4 o = acc[ai][bj][m][n] * rs;
                        if (u.pn < 4) { const int col = u.pn * BM + cl; __builtin_nontemporal_store(o, (f32x4*)(outk + (size_t)row * DMODEL + col)); u32x2 w; w.x = cvt_pk_bf16(o[0], o[1]); w.y = cvt_pk_bf16(o[2], o[3]); *(u32x2*)(KB + (size_t)row * DMODEL + col) = w; }
                        else { const int h = u.pn - 4, col = h * BM + cl; __builtin_nontemporal_store(o, (f32x4*)(outv + (size_t)row * DMODEL + col)); const int b = row >> 8, mm = row & 255; bf16_t* vt = VT + ((size_t)(b * 4 + h) * 256 + cl) * 256 + mm;
                            const unsigned w0 = cvt_pk_bf16(o[0], o[1]), w1 = cvt_pk_bf16(o[2], o[3]); vt[0] = (bf16_t)(w0 & 0xffffu); vt[256] = (bf16_t)(w0 >> 16); vt[512] = (bf16_t)(w1 & 0xffffu); vt[768] = (bf16_t)(w1 >> 16); } } asm volatile("" ::: "memory"); }
    }
};
template <class Sched> __device__ __forceinline__ void rstd_to_lds(PG8_LAS float* rsl, const float* ssq, const Sched& S, int tid) {
    Unit u;
    for (int i = 0; i < 8; ++i) { if (!S.next(i, u)) break;
        if (tid < 256) { const int row = u.pm * BM + tid; const f32x4* sp = (const f32x4*)(ssq + (size_t)row * NSSQ); const f32x4 s0 = sp[0], s1 = sp[1], s2 = sp[2], s3 = sp[3];
            const float ss = ((s0[0] + s0[1]) + (s0[2] + s0[3])) + ((s1[0] + s1[1]) + (s1[2] + s1[3])) + ((s2[0] + s2[1]) + (s2[2] + s2[3])) + ((s3[0] + s3[1]) + (s3[2] + s3[3]));
            rsl[i * 256 + tid] = rsqrtf(ss * (1.0f / DMODEL) + RMS_EPS); } }
    __syncthreads();
}
struct EpiSwigluL { static constexpr bool PERM = false, AFTER_DRAIN = false;
    bf16_t* H; const PG8_LAS float* rsl; int ldh, pad;
    __device__ __forceinline__ void operator()(const f32x4 (&acc)[2][2][4][2], const Unit& u, int wr, int wc, int fr, int fq) const {
#pragma unroll
        for (int ai = 0; ai < 2; ++ai)
#pragma unroll
            for (int m = 0; m < 4; ++m) { const int lr = ai * HALF + wr * 64 + m * 16 + fr, row = u.pm * BM + lr; const float rs = rsl[u.idx * 256 + lr];
#pragma unroll
                for (int bj = 0; bj < 2; ++bj) { const f32x4 g = acc[ai][bj][m][0] * rs, up = acc[ai][bj][m][1] * rs; u32x2 w;
                    w.x = cvt_pk_bf16(silu_f(g[0]) * up[0], silu_f(g[1]) * up[1]); w.y = cvt_pk_bf16(silu_f(g[2]) * up[2], silu_f(g[3]) * up[3]);
                    *(u32x2*)(H + (size_t)row * ldh + u.pn * 128 + bj * 64 + wc * 16 + 4 * fq) = w; } }
    }
};
struct EpiZL { static constexpr bool PERM = true, AFTER_DRAIN = false;
    bf16_t* Z; float* ZG; const PG8_LAS float* rsl;
    __device__ __forceinline__ void operator()(const f32x4 (&acc)[2][2][4][2], const Unit& u, int wr, int wc, int fr, int fq) const {
        constexpr int ZW = 3584, ZGP = 32;
#pragma unroll
        for (int ai = 0; ai < 2; ++ai)
#pragma unroll
            for (int m = 0; m < 4; ++m) { const int lr = ai * HALF + wr * 64 + m * 16 + fr, row = u.pm * BM + lr; const float rs = rsl[u.idx * 256 + lr];
                if (u.pn < ZW / BM) {
#pragma unroll
                    for (int bj = 0; bj < 2; ++bj) { const f32x4 v0 = acc[ai][bj][m][0] * rs, v1 = acc[ai][bj][m][1] * rs; u32x4 w; w.x = cvt_pk_bf16(v0[0], v0[1]); w.y = cvt_pk_bf16(v0[2], v0[3]); w.z = cvt_pk_bf16(v1[0], v1[1]); w.w = cvt_pk_bf16(v1[2], v1[3]);
                        *(u32x4*)(Z + (size_t)row * ZW + u.pn * BM + bj * HALF + wc * 32 + 8 * fq) = w; }
                } else if (wc == 0) { *(f32x4*)(ZG + (size_t)row * ZGP + 8 * fq) = acc[ai][0][m][0] * rs; *(f32x4*)(ZG + (size_t)row * ZGP + 8 * fq + 4) = acc[ai][0][m][1] * rs; } }
    }
};
constexpr int CW_PANEL = 65536;
__device__ __forceinline__ void panel_wait(unsigned* cnt, unsigned want, int wid, int lane) {
    if (wid == 0) { unsigned spins = 0;
        while ((unsigned)__builtin_amdgcn_readfirstlane(__hip_atomic_load(cnt, __ATOMIC_RELAXED, __HIP_MEMORY_SCOPE_AGENT)) < want) { __builtin_amdgcn_s_sleep(2); if (++spins > (1u << 22)) break; }
        __builtin_amdgcn_fence(__ATOMIC_ACQUIRE, "agent"); }
    asm volatile("s_waitcnt vmcnt(0) lgkmcnt(0)" ::: "memory"); __builtin_amdgcn_s_barrier(); asm volatile("" ::: "memory");
}
__device__ __forceinline__ float row_rstd_sc1(const float* ssq, int row, int fq) {
    const unsigned long long* p = (const unsigned long long*)(ssq + (size_t)row * NSSQ + 4 * fq); const unsigned long long a = __hip_atomic_load(p, __ATOMIC_RELAXED, __HIP_MEMORY_SCOPE_AGENT), b = __hip_atomic_load(p + 1, __ATOMIC_RELAXED, __HIP_MEMORY_SCOPE_AGENT);
    float s = (__uint_as_float((unsigned)a) + __uint_as_float((unsigned)(a >> 32))) + (__uint_as_float((unsigned)b) + __uint_as_float((unsigned)(b >> 32))); s += shx(s, 16); s += shx(s, 32);
    return rsqrtf(s * (1.0f / DMODEL) + RMS_EPS); }
struct EpiResidFinal { static constexpr bool PERM = false, AFTER_DRAIN = true;
    const bf16_t* XB; float* ssq; float* Y; const float* gfin; unsigned* cnt; float alpha; int pad;
    __device__ __forceinline__ void fused(f32x4 (&acc)[2][2][4][2], const Unit& u, int wr, int wc, int fr, int fq, PG8_LAS unsigned char* lds, int wid, int lane) const {
#pragma unroll
        for (int ai = 0; ai < 2; ++ai) { u32x2 bw[4][2][2];
#pragma unroll
            for (int m = 0; m < 4; ++m)
#pragma unroll
                for (int bj = 0; bj < 2; ++bj)
#pragma unroll
                    for (int n = 0; n < 2; ++n) bw[m][bj][n] = *(const u32x2*)(XB + (size_t)(u.pm * BM + ai * HALF + wr * 64 + m * 16 + fr) * DMODEL + u.pn * BM + bj * HALF + wc * 32 + n * 16 + 4 * fq);
#pragma unroll
            for (int m = 0; m < 4; ++m) { const int row = u.pm * BM + ai * HALF + wr * 64 + m * 16 + fr; float q = 0.f;
#pragma unroll
                for (int bj = 0; bj < 2; ++bj)
#pragma unroll
                    for (int n = 0; n < 2; ++n) { const u32x2 w0 = bw[m][bj][n]; const f32x4 b = {__uint_as_float(w0.x << 16), __uint_as_float(w0.x & 0xffff0000u), __uint_as_float(w0.y << 16), __uint_as_float(w0.y & 0xffff0000u)};
                        const f32x4 o = b + acc[ai][bj][m][n] * alpha; q += (o[0] * o[0] + o[1] * o[1]) + (o[2] * o[2] + o[3] * o[3]);
#ifdef MK_DBG_XB
                        { u32x2 w; w.x = cvt_pk_bf16(o[0], o[1]); w.y = cvt_pk_bf16(o[2], o[3]); *(u32x2*)(const_cast<bf16_t*>(XB) + (size_t)row * DMODEL + u.pn * BM + bj * HALF + wc * 32 + n * 16 + 4 * fq) = w; }
#endif
                        }
                q += shx(q, 16); q += shx(q, 32);
                if (fq == 0) __hip_atomic_store((unsigned*)(ssq + (size_t)row * NSSQ + u.pn * 4 + wc), __float_as_uint(q), __ATOMIC_RELAXED, __HIP_MEMORY_SCOPE_AGENT); }
            asm volatile("" ::: "memory"); }
        asm volatile("s_waitcnt vmcnt(0)" ::: "memory");
        if (lane == 0) __hip_atomic_fetch_add(cnt + 64 * u.pm, 1u, __ATOMIC_RELAXED, __HIP_MEMORY_SCOPE_AGENT);
        panel_wait(cnt + 64 * u.pm, 32u, wid, lane);
        f32x4 gv[2][2];
#pragma unroll
        for (int bj = 0; bj < 2; ++bj)
#pragma unroll
            for (int n = 0; n < 2; ++n) gv[bj][n] = *(const f32x4*)(gfin + u.pn * BM + bj * HALF + wc * 32 + n * 16 + 4 * fq);
#pragma unroll
        for (int ai = 0; ai < 2; ++ai) { u32x2 bw[4][2][2]; float rs[4];
#pragma unroll
            for (int m = 0; m < 4; ++m) { const int row = u.pm * BM + ai * HALF + wr * 64 + m * 16 + fr; rs[m] = row_rstd_sc1(ssq, row, fq);
#pragma unroll
                for (int bj = 0; bj < 2; ++bj)
#pragma unroll
                    for (int n = 0; n < 2; ++n) bw[m][bj][n] = *(const u32x2*)(XB + (size_t)row * DMODEL + u.pn * BM + bj * HALF + wc * 32 + n * 16 + 4 * fq); }
#pragma unroll
            for (int m = 0; m < 4; ++m) { const int row = u.pm * BM + ai * HALF + wr * 64 + m * 16 + fr;
#pragma unroll
                for (int bj = 0; bj < 2; ++bj)
#pragma unroll
                    for (int n = 0; n < 2; ++n) { const u32x2 w0 = bw[m][bj][n]; const f32x4 b = {__uint_as_float(w0.x << 16), __uint_as_float(w0.x & 0xffff0000u), __uint_as_float(w0.y << 16), __uint_as_float(w0.y & 0xffff0000u)};
                        const f32x4 o = b + acc[ai][bj][m][n] * alpha; *(f32x4*)(Y + (size_t)row * DMODEL + u.pn * BM + bj * HALF + wc * 32 + n * 16 + 4 * fq) = o * rs[m] * gv[bj][n]; } }
            asm volatile("" ::: "memory"); }
    }
};
}
#define GAS __attribute__((address_space(1)))
#define LAS __attribute__((address_space(3)))
typedef unsigned short bf16;
typedef unsigned v4u __attribute__((ext_vector_type(4)));
typedef float f32x4 __attribute__((ext_vector_type(4)));
typedef short bf16x8 __attribute__((ext_vector_type(8)));
typedef GAS unsigned gu32;
typedef GAS unsigned long long gu64;
#define RLX_AGENT __ATOMIC_RELAXED, __HIP_MEMORY_SCOPE_AGENT
#define LDS_WAIT() asm volatile("s_waitcnt lgkmcnt(0)" ::: "memory")
#define VM_WAIT() asm volatile("s_waitcnt vmcnt(0)" ::: "memory")
__device__ __forceinline__ unsigned long long rt() { return __builtin_amdgcn_s_memrealtime(); }
__device__ __forceinline__ unsigned f2bf(float f) { unsigned u = __builtin_bit_cast(unsigned, f); return (u + 0x7fffu + ((u >> 16) & 1u)) >> 16; }
__device__ __forceinline__ unsigned pk2(float lo, float hi) { return f2bf(lo) | (f2bf(hi) << 16); }

#define XB_TMO      128
#define XB_XCNT(j)  (256  + 64 * (j))
#define XB_XSUB(j)  (1280 + 64 * (j))
#define XB_XGEN(j)  (2304 + 64 * (j))
#define XB_TOP      3328
#define XB_TOPGEN   3392
#define XCD_BAR_WORDS 3456
#define XB_SPIN_CAP (1u << 18)

__device__ __forceinline__ unsigned xb_ld(unsigned* p)              { return __hip_atomic_load(p, __ATOMIC_RELAXED, __HIP_MEMORY_SCOPE_AGENT); }
__device__ __forceinline__ unsigned xb_add(unsigned* p, unsigned v) { return __hip_atomic_fetch_add(p, v, __ATOMIC_RELAXED, __HIP_MEMORY_SCOPE_AGENT); }
__device__ __forceinline__ unsigned xb_xcc_id() { return (unsigned)__builtin_amdgcn_s_getreg((3 << 11) | 20) & 0xFu; }
#define XB_SPIN(cond, bar) do { unsigned _sp = 0; while (cond) { __builtin_amdgcn_s_sleep(1); \
    if ((++_sp & 255u) == 0u) { if (xb_ld(&(bar)[XB_TMO])) break; if (_sp > XB_SPIN_CAP) { atomicAdd(&(bar)[XB_TMO], 1u); break; } } } } while (0)

struct XcdBarrier {
    unsigned* bar; unsigned x;
    volatile LAS unsigned* st;
};

__device__ __forceinline__ XcdBarrier xcd_barrier_post(unsigned* bar, volatile LAS unsigned* st) {
    XcdBarrier b; b.bar = bar; b.x = xb_xcc_id(); b.st = st;
    if (threadIdx.x == 0) (void)xb_add(&bar[XB_XCNT(b.x)], 1u);
    return b;
}
__device__ __forceinline__ void xcd_barrier_complete(unsigned* bar, unsigned x, unsigned& nloc, unsigned& nx) {
    const unsigned G = gridDim.x * gridDim.y * gridDim.z;
    unsigned sum, cnt, mine, sp = 0u;
    for (;;) {
        sum = 0u; cnt = 0u; mine = 0u;
#pragma unroll
        for (unsigned j = 0; j < 16; ++j) { const unsigned c = xb_ld(&bar[XB_XCNT(j)]); sum += c; cnt += (c > 0u) ? 1u : 0u; mine = (j == x) ? c : mine; }
        if (sum == G) break;
        __builtin_amdgcn_s_sleep(1);
        if ((++sp & 255u) == 0u) { if (xb_ld(&bar[XB_TMO])) break; if (sp > XB_SPIN_CAP) { atomicAdd(&bar[XB_TMO], 1u); break; } }
    }
    nloc = mine > 0u ? mine : 1u; nx = cnt > 0u ? cnt : 1u;
}

__device__ __forceinline__ void xcd_barrier(const XcdBarrier& b) {
    asm volatile("s_waitcnt vmcnt(0)" ::: "memory");
    __syncthreads();
    if (threadIdx.x == 0) {
        unsigned* bar = b.bar;
        __builtin_amdgcn_s_waitcnt(0);
        unsigned nloc = b.st[0], nx = b.st[1];
        if (nloc == 0u) { xcd_barrier_complete(bar, b.x, nloc, nx); b.st[0] = nloc; b.st[1] = nx; }
        const unsigned old = xb_add(&bar[XB_XSUB(b.x)], 1u);
        const unsigned gen = old / nloc;
        if (old + 1u == (gen + 1u) * nloc) {
            __builtin_amdgcn_fence(__ATOMIC_RELEASE, "agent");
            asm volatile("s_waitcnt vmcnt(0)" ::: "memory");
            const unsigned og = xb_add(&bar[XB_TOP], 1u);
            const unsigned tg = og / nx;
            if (og + 1u == (tg + 1u) * nx) xb_add(&bar[XB_TOPGEN], 1u);
            else XB_SPIN(xb_ld(&bar[XB_TOPGEN]) == tg, bar);
            __builtin_amdgcn_fence(__ATOMIC_ACQUIRE, "agent");
            xb_add(&bar[XB_XGEN(b.x)], 1u);
            asm volatile("s_waitcnt vmcnt(0)" ::: "memory");
        } else {
            XB_SPIN(xb_ld(&bar[XB_XGEN(b.x)]) == gen, bar);
            __builtin_amdgcn_fence(__ATOMIC_ACQUIRE, "agent");
            asm volatile("s_waitcnt vmcnt(0)" ::: "memory");
        }
    }
    __syncthreads();
}
constexpr int NWAVES = 8;
constexpr int RING_OFF = 0, RING_BYTES = 131072;
constexpr int LDSCTL_OFF = RING_BYTES, MISC_OFF = LDSCTL_OFF + 320;
constexpr int LDS_BYTES = 147456;
constexpr int RSL_OFF = MISC_OFF + 128;
static_assert(RSL_OFF + 8 * 256 * 4 <= LDS_BYTES, "LDS map");
constexpr int CW_TMO = 0, CW_CODE = 1, CW_BAR = 4096, MAX_LAUNCHES = 16;
constexpr size_t CTL_ZERO_BYTES = 1u << 20;
static_assert((CW_BAR + MAX_LAUNCHES * XCD_BAR_WORDS) * 4 <= (int)CTL_ZERO_BYTES, "barrier regions inside the memset region");
constexpr int MROWS = 16896, PROWS = 16384, DM = 1024, DFF = 2816, ZW = 3584, WIN_N = 3840, MEMROWS = 2048;
enum Phase { PH_PROLOGUE = 0, PH_UP1, PH_DOWN1, PH_WIN, PH_MIX_LOCAL, PH_MIX_SCAN, PH_MIX_OUT, PH_WOUT, PH_Q, PH_ATTN, PH_WO, PH_UP2, PH_DOWN2, PH_FINAL, PH_COUNT };

constexpr nv::Dm FULL_DIMS{1024, 8, 2048, 128, 4, 4, 128, 128, 4, 64, 128, 16, 256, 4, 256, 2816, 3608, 0, 1e-6f, 16.f};
constexpr nv::Ws WSO = nv::carve_ws(FULL_DIMS);
constexpr nv::OutOff OUTO = nv::out_off(FULL_DIMS);
struct Args { const float* in[33]; float* out; unsigned char* ws; int ph_lo, ph_hi, li, pad; };

__device__ __forceinline__ float wave_sum(float v) {
#pragma unroll
    for (int o = 1; o < 64; o <<= 1) v += shx(v, o);
    return v;
}
struct WSrc { const float* W; const float* gain; int col, pitch; float scale; int zero; };
__device__ __forceinline__ WSrc wsrc(int mat, int np, const float* const* in) {
    WSrc s; s.gain = nullptr; s.scale = 1.f; s.zero = 0; s.col = np; s.pitch = DM; s.W = nullptr;
    switch (mat) {
    case 0: case 7: { const int g = np >> 5, i = np & 31; const bool up = i >= 16; s.W = in[mat == 0 ? (up ? nv::I_F1WU : nv::I_F1WG) : (up ? nv::I_F2WU : nv::I_F2WG)]; s.col = 16 * g + (i & 15); s.pitch = DFF; s.gain = in[mat == 0 ? nv::I_F1G : nv::I_F2G]; break; }
    case 1: case 8: s.W = in[mat == 1 ? nv::I_F1WD : nv::I_F2WD]; break;
    case 2: { s.W = in[nv::I_WIN]; s.pitch = 3608; s.gain = in[nv::I_MIXG];
        if (np < 1536) { s.col = np; if (np >= 512 && np < 1024) s.scale = 0.08838834764831845f; }
        else if (np < 3072) { s.col = np + 8; if (np >= 2048 && np < 2304) s.scale = 0.125f; }
        else if (np < 3584) s.col = np + 24;
        else if (np < 3592) s.col = 1536 + (np - 3584);
        else if (np < 3608) s.col = 3080 + (np - 3592);
        else { s.zero = 1; s.col = 0; }
        break; }
    case 3: s.W = in[nv::I_WOUT]; break;
    case 4: s.W = in[nv::I_WQ]; s.gain = in[nv::I_XG]; s.scale = 0.0625f; break;
    case 5: s.W = in[np < DM ? nv::I_WK : nv::I_WV]; s.col = np & (DM - 1); s.gain = in[nv::I_MEMG]; break;
    default: s.W = in[nv::I_WO]; break;
    }
    return s;
}
struct WItem { int mat, K, kb, nb; size_t off; };
__device__ __forceinline__ WItem witem(int g) {
    WItem w; int nnb;
    if (g < 2816) { w.mat = 0; w.K = DM; nnb = 88; w.off = WSO.wgu1; }
    else if ((g -= 2816) < 1408) { w.mat = 1; w.K = DFF; nnb = 16; w.off = WSO.wd1; }
    else if ((g -= 1408) < 1920) { w.mat = 2; w.K = DM; nnb = 60; w.off = WSO.win; }
    else if ((g -= 1920) < 512) { w.mat = 3; w.K = DM; nnb = 16; w.off = WSO.wout; }
    else if ((g -= 512) < 512) { w.mat = 4; w.K = DM; nnb = 16; w.off = WSO.wq; }
    else if ((g -= 512) < 1024) { w.mat = 5; w.K = DM; nnb = 32; w.off = WSO.wkv; }
    else if ((g -= 1024) < 512) { w.mat = 6; w.K = DM; nnb = 16; w.off = WSO.wo; }
    else if ((g -= 512) < 2816) { w.mat = 7; w.K = DM; nnb = 88; w.off = WSO.wgu2; }
    else { g -= 2816; w.mat = 8; w.K = DFF; nnb = 16; w.off = WSO.wd2; }
    w.kb = g / nnb; w.nb = g % nnb; return w; }
constexpr int W_ITEMS = 2816 + 1408 + 1920 + 512 + 512 + 1024 + 512 + 2816 + 1408;
struct WRegs { f32x4 v[8]; };
__device__ __forceinline__ void witem_load(WRegs& R, const float* const* in, int g, int lane) { const WItem w = witem(g); const int k0 = 32 * w.kb, n0 = 64 * w.nb, n4 = lane & 15, kq = lane >> 4; const WSrc s = wsrc(w.mat, n0 + 4 * n4, in);
#pragma unroll
    for (int i = 0; i < 8; ++i) { const int kk = kq + 4 * i; R.v[i] = (f32x4){0.f, 0.f, 0.f, 0.f}; if (!s.zero) R.v[i] = __builtin_nontemporal_load((const GAS f32x4*)(s.W + (size_t)(k0 + kk) * s.pitch + s.col)); } }
__device__ __forceinline__ void witem_store(const WRegs& R, const float* const* in, unsigned char* ws, LAS float* scr, int g, int lane) { const WItem w = witem(g); const int k0 = 32 * w.kb, n0 = 64 * w.nb, n4 = lane & 15, kq = lane >> 4; bf16* WT = (bf16*)(ws + w.off); const WSrc s = wsrc(w.mat, n0 + 4 * n4, in);
#pragma unroll
    for (int i = 0; i < 8; ++i) { const int kk = kq + 4 * i; *(LAS f32x4*)(scr + kk * 68 + 4 * n4) = R.v[i] * (s.gain ? s.gain[k0 + kk] * s.scale : s.scale); }
    LDS_WAIT(); asm volatile("" ::: "memory");
    const int c = lane & 3;
#pragma unroll
    for (int j = 0; j < 4; ++j) { const int n = (lane >> 2) + 16 * j; const LAS float* p = scr + (8 * c) * 68 + n;
        v4u o; o.x = pk2(p[0 * 68], p[1 * 68]); o.y = pk2(p[2 * 68], p[3 * 68]); o.z = pk2(p[4 * 68], p[5 * 68]); o.w = pk2(p[6 * 68], p[7 * 68]);
        *(GAS v4u*)(WT + (size_t)(n0 + n) * w.K + k0 + 8 * c) = o; }
    LDS_WAIT(); asm volatile("" ::: "memory");
}
__device__ __forceinline__ float row_to_bf16(const float* xrow, bf16* orow, int lane) {
    const GAS f32x4* xr = (const GAS f32x4*)xrow + lane; f32x4 v[4]; float s = 0.f;
#pragma unroll
    for (int j = 0; j < 4; ++j) { v[j] = __builtin_nontemporal_load(xr + 64 * j); s += (v[j].x * v[j].x + v[j].y * v[j].y) + (v[j].z * v[j].z + v[j].w * v[j].w); }
    GAS unsigned long long* o8 = (GAS unsigned long long*)orow + lane;
#pragma unroll
    for (int j = 0; j < 4; ++j) o8[64 * j] = (unsigned long long)pk2(v[j].x, v[j].y) | ((unsigned long long)pk2(v[j].z, v[j].w) << 32);
    return wave_sum(s);
}
struct Frame { LAS unsigned char* lds; int tid, lane, wave, vcu, G; };
__device__ __forceinline__ void p0_prologue(const Frame& F, const float* const* in, unsigned char* ws) {
    LAS float* scr = (LAS float*)(F.lds + RING_OFF + F.wave * 16384);
    const int gw = F.vcu * NWAVES + F.wave, NGW = F.G * NWAVES;
    for (int g = gw; g < W_ITEMS; g += 2 * NGW) { WRegs A, B; const bool two = g + NGW < W_ITEMS; witem_load(A, in, g, F.lane); if (two) witem_load(B, in, g + NGW, F.lane);
        witem_store(A, in, ws, scr, g, F.lane); if (two) witem_store(B, in, ws, scr, g + NGW, F.lane); }
    bf16* XB = (bf16*)(ws + WSO.xb); float* SSQ = (float*)(ws + WSO.ssq);
    for (int m0 = gw; m0 < MROWS; m0 += 2 * NGW) { const int m1 = m0 + NGW;
        const float* s0p = m0 < PROWS ? in[nv::I_XP] + (size_t)m0 * DM : in[nv::I_XS] + (size_t)(m0 - PROWS) * DM; const bool two = m1 < MROWS; const int m1c = two ? m1 : m0;
        const float* s1p = m1c < PROWS ? in[nv::I_XP] + (size_t)m1c * DM : in[nv::I_XS] + (size_t)(m1c - PROWS) * DM;
        f32x4 va[4], vb[4];
#pragma unroll
        for (int j = 0; j < 4; ++j) { va[j] = __builtin_nontemporal_load((const GAS f32x4*)s0p + F.lane + 64 * j); vb[j] = __builtin_nontemporal_load((const GAS f32x4*)s1p + F.lane + 64 * j); }
        float sa = 0.f, sb = 0.f; GAS unsigned long long* oa = (GAS unsigned long long*)(XB + (size_t)m0 * DM) + F.lane; GAS unsigned long long* ob = (GAS unsigned long long*)(XB + (size_t)m1c * DM) + F.lane;
#pragma unroll
        for (int j = 0; j < 4; ++j) { sa += (va[j].x * va[j].x + va[j].y * va[j].y) + (va[j].z * va[j].z + va[j].w * va[j].w); sb += (vb[j].x * vb[j].x + vb[j].y * vb[j].y) + (vb[j].z * vb[j].z + vb[j].w * vb[j].w);
            oa[64 * j] = (unsigned long long)pk2(va[j].x, va[j].y) | ((unsigned long long)pk2(va[j].z, va[j].w) << 32); if (two) ob[64 * j] = (unsigned long long)pk2(vb[j].x, vb[j].y) | ((unsigned long long)pk2(vb[j].z, vb[j].w) << 32); }
        sa = wave_sum(sa); sb = wave_sum(sb);
        if (F.lane < 16) { SSQ[(size_t)m0 * 16 + F.lane] = F.lane == 0 ? sa : 0.f; if (two) SSQ[(size_t)m1 * 16 + F.lane] = F.lane == 0 ? sb : 0.f; } }
    bf16* MEMB = (bf16*)(ws + WSO.memb); float* MSSQ = (float*)(ws + WSO.mssq);
    for (int m = gw; m < MEMROWS; m += NGW) { const float s = row_to_bf16(in[nv::I_MEM] + (size_t)m * DM, MEMB + (size_t)m * DM, F.lane); if (F.lane == 0) MSSQ[m] = s; }
}
__device__ __forceinline__ void p_final(const Frame& F, const float* const* in, float* out, unsigned char* ws) {
    const int gw = F.vcu * NWAVES + F.wave, NGW = F.G * NWAVES; const bf16* XB = (const bf16*)(ws + WSO.xb); const float* SSQ = (const float*)(ws + WSO.ssq); const float* g = in[nv::I_FING];
    f32x4 gv[4];
#pragma unroll
    for (int j = 0; j < 4; ++j) gv[j] = ((const GAS f32x4*)g)[F.lane + 64 * j];
    for (int m0 = gw; m0 < MROWS; m0 += 2 * NGW) { const int m1 = m0 + NGW < MROWS ? m0 + NGW : m0; unsigned long long xw[2][4]; f32x4 sv[2][4];
#pragma unroll
        for (int q = 0; q < 2; ++q) { const int m = q ? m1 : m0; const GAS f32x4* sp = (const GAS f32x4*)(SSQ + (size_t)m * 16); const GAS unsigned long long* xr = (const GAS unsigned long long*)(XB + (size_t)m * DM) + F.lane;
#pragma unroll
            for (int j = 0; j < 4; ++j) { sv[q][j] = sp[j]; xw[q][j] = __builtin_nontemporal_load(xr + 64 * j); } }
#pragma unroll
        for (int q = 0; q < 2; ++q) { const int m = q ? m1 : m0; if (q == 1 && m1 == m0) break;
        const f32x4 s0 = sv[q][0], s1 = sv[q][1], s2 = sv[q][2], s3 = sv[q][3];
        const float ss = ((s0.x + s0.y) + (s0.z + s0.w)) + ((s1.x + s1.y) + (s1.z + s1.w)) + ((s2.x + s2.y) + (s2.z + s2.w)) + ((s3.x + s3.y) + (s3.z + s3.w));
        const float rs = rsqrtf(ss * (1.0f / DM) + 1e-6f); GAS f32x4* yo = (GAS f32x4*)(out + OUTO.yp + (size_t)m * DM) + F.lane;
#pragma unroll
        for (int j = 0; j < 4; ++j) { const unsigned long long w = xw[q][j]; const unsigned lo = (unsigned)w, hi = (unsigned)(w >> 32);
            const f32x4 x = {__uint_as_float(lo << 16), __uint_as_float(lo & 0xffff0000u), __uint_as_float(hi << 16), __uint_as_float(hi & 0xffff0000u)}; __builtin_nontemporal_store(x * rs * gv[j], yo + 64 * j); } } }
}
namespace mx {
typedef short bf16x8 __attribute__((ext_vector_type(8)));
typedef short s16x4 __attribute__((ext_vector_type(4)));
typedef float f32x4 __attribute__((ext_vector_type(4)));
typedef unsigned u32x4 __attribute__((ext_vector_type(4)));
typedef unsigned u32x2 __attribute__((ext_vector_type(2)));
typedef LAS unsigned char* ldsp;
constexpr int ZQ = 0, ZK = 512, ZV = 1024, ZO = 1536, GQ = 2048, GK = 2304, GV = 2560, GG = 3072, ZWD = 3584, ZGP = 32;
constexpr int KP = 272, VP = 304, GP = 144, HP = 132;
constexpr int NITEM = 1024;
__device__ __forceinline__ float bf2f(unsigned short v) { return __uint_as_float((unsigned)v << 16); }
__device__ __forceinline__ float lsig(float x) { return fminf(x, 0.f) - __logf(1.f + __expf(-fabsf(x))); }
template <int CTRL, int ROW_MASK> __device__ __forceinline__ float dpp_get(float old, float x) { return __builtin_bit_cast(float, __builtin_amdgcn_update_dpp(__builtin_bit_cast(int, old), __builtin_bit_cast(int, x), CTRL, ROW_MASK, 0xF, false)); }
__device__ __forceinline__ float wscan_add(float v, int) {
    v += dpp_get<0x111, 0xF>(0.f, v); v += dpp_get<0x112, 0xF>(0.f, v); v += dpp_get<0x114, 0xF>(0.f, v); v += dpp_get<0x118, 0xF>(0.f, v);
    v += dpp_get<0x142, 0xA>(0.f, v); v += dpp_get<0x143, 0xC>(0.f, v); return v; }
__device__ __forceinline__ float wscan_max(float v, int) { const float ni = -INFINITY;
    v = fmaxf(v, dpp_get<0x111, 0xF>(ni, v)); v = fmaxf(v, dpp_get<0x112, 0xF>(ni, v)); v = fmaxf(v, dpp_get<0x114, 0xF>(ni, v)); v = fmaxf(v, dpp_get<0x118, 0xF>(ni, v));
    v = fmaxf(v, dpp_get<0x142, 0xA>(ni, v)); v = fmaxf(v, dpp_get<0x143, 0xC>(ni, v)); return v; }
__device__ __forceinline__ float wlast(float v) { return __builtin_bit_cast(float, __builtin_amdgcn_readlane(__builtin_bit_cast(int, v), 63)); }
__device__ __forceinline__ float wmax(float v) { return wlast(wscan_max(v, 0)); }
__device__ __forceinline__ float wsum(float v) { return wlast(wscan_add(v, 0)); }
__device__ __forceinline__ f32x4 mma(bf16x8 a, bf16x8 b, f32x4 c) { return __builtin_amdgcn_mfma_f32_16x16x32_bf16(a, b, c, 0, 0, 0); }
__device__ __forceinline__ bf16x8 frag_row(ldsp base, int pitchB, int row0, int k0, int lane) { return *(const LAS bf16x8*)(base + (row0 + (lane & 15)) * pitchB + (k0 + 8 * (lane >> 4)) * 2); }
__device__ __forceinline__ bf16x8 frag_tr(ldsp base, int pitchB, int k0, int col0, int lane) {
    ldsp p = base + (k0 + 8 * (lane >> 4) + ((lane & 15) >> 2)) * pitchB + (col0 + 4 * (lane & 3)) * 2;
    const s16x4 lo = __builtin_bit_cast(s16x4, __builtin_amdgcn_ds_read_tr16_b64_v4i16((LAS s16x4*)p));
    const s16x4 hi = __builtin_bit_cast(s16x4, __builtin_amdgcn_ds_read_tr16_b64_v4i16((LAS s16x4*)(p + 4 * pitchB)));
    return (bf16x8){lo[0], lo[1], lo[2], lo[3], hi[0], hi[1], hi[2], hi[3]}; }
__device__ __forceinline__ unsigned pkbf(float lo, float hi) { return pk2(lo, hi); }
template <int NCH> __device__ __forceinline__ void stage_tile(ldsp dst, int pb, const bf16* src, size_t gp, int rows, int tid) {
    for (int id = tid; id < rows * NCH; id += 512) { const int s = id / NCH, ch = id % NCH; *(LAS u32x4*)(dst + s * pb + ch * 16) = *(const GAS u32x4*)(src + (size_t)s * gp + ch * 8); } }
struct Ctx { const bf16* Z; const float* ZG; unsigned char* ws; const float* const* in; float* out; ldsp L; int tid, lane, wave, pad; };

__device__ __forceinline__ void scan_phase(const Ctx& c, int gtid, int nthreads) {
    const float* ML = (const float*)(c.ws + WSO.mloc);
    for (int q = gtid; q < 32 * 4096; q += nthreads) { const int bh = q >> 12, e = (q & 4095) * 4, e2 = (q & 4095) * 2, d2 = e2 >> 7;
        const bf16* CL = (const bf16*)(c.ws + WSO.cloc) + (size_t)bh * 32 * 16384 + e; bf16* CS = (bf16*)(c.ws + WSO.cst) + (size_t)bh * 32 * 16384 + e;
        const bf16* SL = (const bf16*)(c.ws + WSO.sloc) + (size_t)bh * 32 * 8192 + e2; bf16* SS = (bf16*)(c.ws + WSO.sst) + (size_t)bh * 32 * 8192 + e2; const float* GD = (const float*)(c.ws + WSO.gdec) + (size_t)bh * 32 * 64 + d2;
        f32x4 C = {0.f, 0.f, 0.f, 0.f}; float m = 0.f, S0 = 0.f, S1 = 0.f;
        for (int c0 = 0; c0 < 32; c0 += 8) { u32x2 lw[8]; unsigned sw[8]; float mlv[8], blv[8], gd[8];
#pragma unroll
            for (int j = 0; j < 8; ++j) { lw[j] = __builtin_nontemporal_load((const GAS u32x2*)(CL + (size_t)(c0 + j) * 16384)); sw[j] = __builtin_nontemporal_load((const GAS unsigned*)(SL + (size_t)(c0 + j) * 8192)); mlv[j] = ML[(bh * 32 + c0 + j) * 2]; blv[j] = ML[(bh * 32 + c0 + j) * 2 + 1]; gd[j] = GD[(c0 + j) * 64]; }
#pragma unroll
            for (int j = 0; j < 8; ++j) { u32x2 o; o.x = pkbf(C[0], C[1]); o.y = pkbf(C[2], C[3]); *(GAS u32x2*)(CS + (size_t)(c0 + j) * 16384) = o; *(GAS unsigned*)(SS + (size_t)(c0 + j) * 8192) = pkbf(S0, S1);
                const float mn = fmaxf(blv[j] + m, mlv[j]), fC = __expf(blv[j] + m - mn), fL = __expf(mlv[j] - mn);
                const f32x4 l = {__uint_as_float(lw[j][0] << 16), __uint_as_float(lw[j][0] & 0xffff0000u), __uint_as_float(lw[j][1] << 16), __uint_as_float(lw[j][1] & 0xffff0000u)}; C = C * fC + l * fL; m = mn;
                S0 = S0 * gd[j] + __uint_as_float(sw[j] << 16); S1 = S1 * gd[j] + __uint_as_float(sw[j] & 0xffff0000u); } }
        *(GAS f32x4*)(c.out + OUTO.cp + (size_t)bh * 16384 + e) = C; float* so = c.out + OUTO.sp + (size_t)bh * 8192 + e2; so[0] = S0; so[1] = S1; }
    for (int q = nthreads - 1 - gtid; q < 32 * 128; q += nthreads) { const int bh = q >> 7, d = q & 127; const float* NL = (const float*)(c.ws + WSO.nloc) + (size_t)bh * 32 * 128 + d; float* NS = (float*)(c.ws + WSO.nst) + (size_t)bh * 32 * 128 + d; float* MS = (float*)(c.ws + WSO.mst) + bh * 32;
        float n = 0.f, m = 0.f;
        for (int c0 = 0; c0 < 32; c0 += 8) { float nl[8], mlv[8], blv[8];
#pragma unroll
            for (int j = 0; j < 8; ++j) { nl[j] = NL[(c0 + j) * 128]; mlv[j] = ML[(bh * 32 + c0 + j) * 2]; blv[j] = ML[(bh * 32 + c0 + j) * 2 + 1]; }
#pragma unroll
            for (int j = 0; j < 8; ++j) { NS[(c0 + j) * 128] = n; if (d == 0) MS[c0 + j] = m; const float mn = fmaxf(blv[j] + m, mlv[j]); n = n * __expf(blv[j] + m - mn) + nl[j] * __expf(mlv[j] - mn); m = mn; } }
        c.out[OUTO.np + bh * 128 + d] = n; if (d == 0) c.out[OUTO.mp + bh] = m; }
}
}
namespace mx {
#define MX_BAR_LDS() do { asm volatile("s_waitcnt lgkmcnt(0)" ::: "memory"); __builtin_amdgcn_s_barrier(); asm volatile("" ::: "memory"); } while (0)
__device__ __forceinline__ void sample_mlstm(const Ctx& c, int item) {
    const int b = item >> 2, h = item & 3, r0 = 16384 + 4 * b;
    LAS float* SQ = (LAS float*)(c.L); LAS float *SK = SQ + 512, *SV = SQ + 1024, *GS = SQ + 1536  , *QK = SQ + 1600  , *PS = SQ + 1632, *RED = SQ + 2048  ;
    const float* C0 = c.in[nv::I_SC] + (size_t)item * 16384; const float* n0 = c.in[nv::I_SN] + item * 128;
    f32x4 cst[8];
#pragma unroll
    for (int j = 0; j < 8; ++j) cst[j] = __builtin_nontemporal_load((const GAS f32x4*)(C0 + ((c.tid >> 5) * 8 + j) * 128 + 4 * (c.tid & 31)));
    { const int t = c.tid >> 7, d = c.tid & 127; const bf16* zr = c.Z + (size_t)(r0 + t) * ZWD + h * 128 + d; SQ[c.tid] = bf2f(zr[ZQ]); SK[c.tid] = bf2f(zr[ZK]); SV[c.tid] = bf2f(zr[ZV]); }
    if (c.tid == 0) { float ip[4], bb[4], a[4]; const float m0 = c.in[nv::I_SM][item]; float run = 0.f;
#pragma unroll
        for (int t = 0; t < 4; ++t) { ip[t] = c.ZG[(r0 + t) * ZGP + h] + c.in[nv::I_BI][h]; run += lsig(c.ZG[(r0 + t) * ZGP + 4 + h] + c.in[nv::I_BF][h]); bb[t] = run; a[t] = run + m0; }
#pragma unroll
        for (int t = 0; t < 4; ++t) { float mt = a[t];
#pragma unroll
            for (int s = 0; s < 4; ++s) if (s <= t) mt = fmaxf(mt, bb[t] - bb[s] + ip[s]);
            GS[t] = __expf(a[t] - mt); GS[4 + t] = mt;
#pragma unroll
            for (int s = 0; s < 4; ++s) GS[8 + t * 4 + s] = (s <= t) ? __expf(bb[t] - bb[s] + ip[s] - mt) : 0.f; } }
    MX_BAR_LDS();
    {
#pragma unroll
        for (int q = 0; q < 2; ++q) { const int p = 2 * c.wave + q, t = p >> 2, s = p & 3; const float v = wsum(SQ[t * 128 + c.lane] * SK[s * 128 + c.lane] + SQ[t * 128 + 64 + c.lane] * SK[s * 128 + 64 + c.lane]); if (c.lane == 0) QK[p] = v; }
        if (c.wave < 4) { const float v = wsum(SQ[c.wave * 128 + c.lane] * n0[c.lane] + SQ[c.wave * 128 + 64 + c.lane] * n0[64 + c.lane]); if (c.lane == 0) QK[16 + c.wave] = v; } }
    {
        const int v4 = c.tid & 31, dg = c.tid >> 5; const float iL = GS[3]; const float wl0 = GS[8 + 12], wl1 = GS[8 + 13], wl2 = GS[8 + 14], wl3 = GS[8 + 15];
        f32x4 p0 = {0.f, 0.f, 0.f, 0.f}, p1 = p0, p2 = p0, p3 = p0; const f32x4 v0 = *(const LAS f32x4*)(SV + 4 * v4), v1 = *(const LAS f32x4*)(SV + 128 + 4 * v4), v2 = *(const LAS f32x4*)(SV + 256 + 4 * v4), v3 = *(const LAS f32x4*)(SV + 384 + 4 * v4);
        float* Co = c.out + OUTO.cs + (size_t)item * 16384;
#pragma unroll
        for (int j = 0; j < 8; ++j) { const int d = dg * 8 + j; const f32x4 cv = cst[j];
            p0 += cv * SQ[d]; p1 += cv * SQ[128 + d]; p2 += cv * SQ[256 + d]; p3 += cv * SQ[384 + d];
            __builtin_nontemporal_store(cv * iL + v0 * (wl0 * SK[d]) + v1 * (wl1 * SK[128 + d]) + v2 * (wl2 * SK[256 + d]) + v3 * (wl3 * SK[384 + d]), (GAS f32x4*)(Co + d * 128 + 4 * v4)); }
        *(LAS f32x4*)(RED + (dg * 4 + 0) * 128 + 4 * v4) = p0; *(LAS f32x4*)(RED + (dg * 4 + 1) * 128 + 4 * v4) = p1; *(LAS f32x4*)(RED + (dg * 4 + 2) * 128 + 4 * v4) = p2; *(LAS f32x4*)(RED + (dg * 4 + 3) * 128 + 4 * v4) = p3;
        if (c.tid < 128) { const int d = c.tid; c.out[OUTO.ns + item * 128 + d] = iL * n0[d] + wl0 * SK[d] + wl1 * SK[128 + d] + wl2 * SK[256 + d] + wl3 * SK[384 + d]; }
        if (c.tid == 0) c.out[OUTO.ms + item] = GS[7]; }
    MX_BAR_LDS();
    float hval;
    { const int t = c.tid >> 7, v = c.tid & 127; float qc = 0.f;
#pragma unroll
      for (int dg = 0; dg < 16; ++dg) qc += RED[(dg * 4 + t) * 128 + v];
      const float wi = GS[t]; float num = wi * qc, den = wi * QK[16 + t];
#pragma unroll
      for (int s = 0; s < 4; ++s) { const float st = QK[t * 4 + s] * GS[8 + t * 4 + s]; num += st * SV[s * 128 + v]; den += st; }
      hval = num / fmaxf(fabsf(den), __expf(-GS[4 + t]));
      const float ss = wsum(hval * hval); if (c.lane == 0) PS[c.wave] = ss; }
    MX_BAR_LDS();
    { const int t = c.tid >> 7, v = c.tid & 127; const float rs = rsqrtf((PS[2 * t] + PS[2 * t + 1]) * (1.0f / 128.0f) + 1e-6f); const float g = bf2f(c.Z[(size_t)(r0 + t) * ZWD + ZO + h * 128 + v]);
      ((bf16*)(c.ws + WSO.ymix))[(size_t)(r0 + t) * 1024 + h * 128 + v] = (bf16)f2bf(hval * rs * c.in[nv::I_MLOG][h * 128 + v] / (1.f + __expf(-g))); }
    MX_BAR_LDS();
}
__device__ __forceinline__ void sample_gla(const Ctx& c, int item) {
    const int b = item >> 2, h = item & 3, r0 = 16384 + 4 * b;
    LAS float* SQ = (LAS float*)(c.L); LAS float *SKH = SQ + 256  , *SKM = SQ + 512  , *BC = SQ + 768, *SV = SQ + 1024  , *AQ = SQ + 1536, *PS = SQ + 1568, *RED = SQ + 2048  ;
    const float* S0 = c.in[nv::I_SS] + (size_t)item * 8192;
    f32x4 sst[4];
#pragma unroll
    for (int j = 0; j < 4; ++j) sst[j] = __builtin_nontemporal_load((const GAS f32x4*)(S0 + ((c.tid >> 5) * 4 + j) * 128 + 4 * (c.tid & 31)));
    if (c.tid < 256) { const int t = c.tid >> 6, d = c.tid & 63; float a = c.in[nv::I_BA][h * 64 + d];
#pragma unroll
        for (int r = 0; r < 16; ++r) a += c.ZG[(r0 + t) * ZGP + 8 + r] * c.in[nv::I_WA2][r * 256 + h * 64 + d];
        BC[c.tid] = lsig(a) * 0.0625f; }
    { const int t = c.tid >> 7, v = c.tid & 127; SV[c.tid] = bf2f(c.Z[(size_t)(r0 + t) * ZWD + GV + h * 128 + v]); }
    MX_BAR_LDS();
    if (c.tid < 64) { float run = 0.f;
#pragma unroll
        for (int t = 0; t < 4; ++t) { run += BC[t * 64 + c.tid]; BC[t * 64 + c.tid] = run; } }
    MX_BAR_LDS();
    if (c.tid < 256) { const int t = c.tid >> 6, d = c.tid & 63; const bf16* zr = c.Z + (size_t)(r0 + t) * ZWD + h * 64 + d; const float bc = BC[c.tid], bl = BC[192 + d], k = bf2f(zr[GK]);
        SQ[c.tid] = bf2f(zr[GQ]) * __expf(bc); SKH[c.tid] = k * __expf(bl - bc); SKM[c.tid] = k * __expf(-bc); }
    MX_BAR_LDS();
#pragma unroll
    for (int q = 0; q < 2; ++q) { const int p = 2 * c.wave + q, t = p >> 2, s = p & 3; const float v = wsum(SQ[t * 64 + c.lane] * SKM[s * 64 + c.lane]); if (c.lane == 0) AQ[p] = (s <= t) ? v : 0.f; }
    { const int v4 = c.tid & 31, dg = c.tid >> 5; f32x4 p0 = {0.f, 0.f, 0.f, 0.f}, p1 = p0, p2 = p0, p3 = p0;
      const f32x4 v0 = *(const LAS f32x4*)(SV + 4 * v4), v1 = *(const LAS f32x4*)(SV + 128 + 4 * v4), v2 = *(const LAS f32x4*)(SV + 256 + 4 * v4), v3 = *(const LAS f32x4*)(SV + 384 + 4 * v4);
      float* So = c.out + OUTO.ss + (size_t)item * 8192;
#pragma unroll
      for (int j = 0; j < 4; ++j) { const int d = dg * 4 + j; const f32x4 sv = sst[j];
          p0 += sv * SQ[d]; p1 += sv * SQ[64 + d]; p2 += sv * SQ[128 + d]; p3 += sv * SQ[192 + d];
          __builtin_nontemporal_store(sv * __expf(BC[192 + d]) + v0 * SKH[d] + v1 * SKH[64 + d] + v2 * SKH[128 + d] + v3 * SKH[192 + d], (GAS f32x4*)(So + d * 128 + 4 * v4)); }
      *(LAS f32x4*)(RED + (dg * 4 + 0) * 128 + 4 * v4) = p0; *(LAS f32x4*)(RED + (dg * 4 + 1) * 128 + 4 * v4) = p1; *(LAS f32x4*)(RED + (dg * 4 + 2) * 128 + 4 * v4) = p2; *(LAS f32x4*)(RED + (dg * 4 + 3) * 128 + 4 * v4) = p3; }
    MX_BAR_LDS();
    float hval;
    { const int t = c.tid >> 7, v = c.tid & 127; float o = 0.f;
#pragma unroll
      for (int dg = 0; dg < 16; ++dg) o += RED[(dg * 4 + t) * 128 + v];
#pragma unroll
      for (int s = 0; s < 4; ++s) o += AQ[t * 4 + s] * SV[s * 128 + v];
      hval = o; const float ss = wsum(hval * hval); if (c.lane == 0) PS[c.wave] = ss; }
    MX_BAR_LDS();
    { const int t = c.tid >> 7, v = c.tid & 127; const float rs = rsqrtf((PS[2 * t] + PS[2 * t + 1]) * (1.0f / 128.0f) + 1e-6f); const float g = bf2f(c.Z[(size_t)(r0 + t) * ZWD + GG + h * 128 + v]);
      ((bf16*)(c.ws + WSO.ymix))[(size_t)(r0 + t) * 1024 + 512 + h * 128 + v] = (bf16)f2bf(hval * rs * c.in[nv::I_GLOG][h * 128 + v] * g / (1.f + __expf(-g))); }
    MX_BAR_LDS();
}
}
namespace m2 {
using namespace mx;
#define BAR_LDS() do { asm volatile("s_waitcnt lgkmcnt(0)" ::: "memory"); __builtin_amdgcn_s_barrier(); asm volatile("" ::: "memory"); } while (0)
constexpr int WA_OFF = 110592;
constexpr int GN_OFF = 131584;
constexpr int PRIV_OFF = 75776, PRIV_BYTES = 4224, PSQ_OFF = 109568;
__device__ __forceinline__ void load_wa(const Ctx& c) {
    LAS float* WA = (LAS float*)(c.L + WA_OFF);
    for (int i = c.tid; i < 1024; i += 512) *(LAS f32x4*)(WA + 4 * i) = *(const GAS f32x4*)(c.in[nv::I_WA2] + 4 * i);
    if (c.tid < 64) *(LAS f32x4*)(WA + 4096 + 4 * c.tid) = *(const GAS f32x4*)(c.in[nv::I_BA] + 4 * c.tid);
    LAS float* GN = (LAS float*)(c.L + GN_OFF);
    if (c.tid < 128) *(LAS f32x4*)(GN + 4 * c.tid) = *(const GAS f32x4*)(c.in[nv::I_MLOG] + 4 * c.tid); else if (c.tid < 256) *(LAS f32x4*)(GN + 4 * c.tid) = *(const GAS f32x4*)(c.in[nv::I_GLOG] + 4 * (c.tid - 128));
    else if (c.tid < 260) GN[1024 + (c.tid - 256)] = c.in[nv::I_BI][c.tid - 256]; else if (c.tid < 264) GN[1028 + (c.tid - 260)] = c.in[nv::I_BF][c.tid - 260];
    BAR_LDS();
}
struct Item { int b, h, ch, r0; };
__device__ __forceinline__ Item decode(int item) { Item it; const int bh = item >> 5; it.ch = item & 31; it.b = bh >> 2; it.h = bh & 3; it.r0 = it.b * 2048 + it.ch * 64; return it; }
struct LmRegs { float zi, zf; u32x4 k[2], v[2]; };
__device__ __forceinline__ void lm_load(LmRegs& R, const Ctx& c, int item) { const Item it = decode(item);
    R.zi = c.ZG[(size_t)(it.r0 + c.lane) * ZGP + it.h]; R.zf = c.ZG[(size_t)(it.r0 + c.lane) * ZGP + 4 + it.h];
#pragma unroll
    for (int j = 0; j < 2; ++j) { const int id = c.tid + 512 * j, s = id >> 4, cc = id & 15; const bf16* zr = c.Z + (size_t)(it.r0 + s) * ZWD + it.h * 128 + cc * 8; R.k[j] = *(const GAS u32x4*)(zr + ZK); R.v[j] = *(const GAS u32x4*)(zr + ZV); } }
__device__ __forceinline__ void lm_stage(const LmRegs& R, const Ctx& c, int item, ldsp Ks, ldsp Vs) { const Item it = decode(item);
    const LAS float* GB = (const LAS float*)(c.L + GN_OFF) + 1024; const float ip = R.zi + GB[it.h], lf = lsig(R.zf + GB[4 + it.h]); const float bc = wscan_add(lf, c.lane), bL = wlast(bc), g = bL - bc + ip, ml = wmax(g), w = __expf(g - ml);
    if (c.tid == 0) { float* M = (float*)(c.ws + WSO.mloc); M[item * 2] = ml; M[item * 2 + 1] = bL; }
#pragma unroll
    for (int j = 0; j < 2; ++j) { const int id = c.tid + 512 * j, s = id >> 4, cc = id & 15; const float wv = shl(w, s); *(LAS u32x4*)(Ks + s * KP + cc * 16) = R.k[j]; u32x4 o;
#pragma unroll
        for (int q = 0; q < 4; ++q) o[q] = pkbf(bf2f((unsigned short)(R.v[j][q] & 0xffffu)) * wv, bf2f((unsigned short)(R.v[j][q] >> 16)) * wv);
        *(LAS u32x4*)(Vs + s * VP + cc * 16) = o; }
    { const int s = (c.tid >> 1) & 63; const float wv = shl(w, s); if (c.tid < 128) { u32x4 o = {0u, 0u, 0u, 0u}; if ((c.tid & 1) == 0) o[0] = pkbf(wv, 0.f); *(LAS u32x4*)(Vs + s * VP + 256 + (c.tid & 1) * 16) = o; } } }
__device__ __forceinline__ void lm_compute(const Ctx& c, int item, ldsp Ks, ldsp Vs) {
    const int d0 = 16 * c.wave; const bf16x8 b0 = frag_tr(Ks, KP, 0, d0, c.lane), b1 = frag_tr(Ks, KP, 32, d0, c.lane);
    bf16* CL = (bf16*)(c.ws + WSO.cloc) + (size_t)item * 16384; float* NL = (float*)(c.ws + WSO.nloc) + (size_t)item * 128;
#pragma unroll
    for (int vt = 0; vt < 9; ++vt) { f32x4 acc = {0.f, 0.f, 0.f, 0.f}; acc = mma(frag_tr(Vs, VP, 0, 16 * vt, c.lane), b0, acc); acc = mma(frag_tr(Vs, VP, 32, 16 * vt, c.lane), b1, acc);
        if (vt < 8) { u32x2 o; o[0] = pkbf(acc[0], acc[1]); o[1] = pkbf(acc[2], acc[3]); *(GAS u32x2*)(CL + (d0 + (c.lane & 15)) * 128 + 16 * vt + 4 * (c.lane >> 4)) = o; }
        else if ((c.lane >> 4) == 0) NL[d0 + (c.lane & 15)] = acc[0]; } }
__device__ __forceinline__ void run_local_mlstm(const Ctx& c, int cu, int G) {
    int item = cu; LmRegs R; if (item < NITEM) lm_load(R, c, item); int set = 0;
    for (; item < NITEM; item += G) { ldsp Ks = c.L + set * 36864, Vs = Ks + 17408; lm_stage(R, c, item, Ks, Vs); if (item + G < NITEM) lm_load(R, c, item + G); BAR_LDS(); lm_compute(c, item, Ks, Vs); set ^= 1; }
    BAR_LDS(); }
__device__ __forceinline__ void gla_bc_wave(const Ctx& c, const f32x4 (&ga)[4], int h, float (&bc)[8]) {
    const LAS float* WA = (const LAS float*)(c.L + WA_OFF) + h * 64 + c.wave * 8; const LAS float* BA = (const LAS float*)(c.L + WA_OFF) + 4096 + h * 64 + c.wave * 8;
#pragma unroll
    for (int j = 0; j < 8; ++j) { float a = BA[j];
#pragma unroll
        for (int q = 0; q < 4; ++q) { a += ga[q][0] * WA[(4 * q) * 256 + j]; a += ga[q][1] * WA[(4 * q + 1) * 256 + j]; a += ga[q][2] * WA[(4 * q + 2) * 256 + j]; a += ga[q][3] * WA[(4 * q + 3) * 256 + j]; }
        bc[j] = wscan_add(lsig(a) * 0.0625f, c.lane); } }
struct LgRegs { f32x4 ga[4]; u32x4 k; u32x4 v[2]; };
__device__ __forceinline__ void lg_load(LgRegs& R, const Ctx& c, int item) { const Item it = decode(item);
#pragma unroll
    for (int q = 0; q < 4; ++q) R.ga[q] = *(const GAS f32x4*)(c.ZG + (size_t)(it.r0 + c.lane) * ZGP + 8 + 4 * q);
    R.k = *(const GAS u32x4*)(c.Z + (size_t)(it.r0 + c.lane) * ZWD + GK + it.h * 64 + c.wave * 8);
#pragma unroll
    for (int j = 0; j < 2; ++j) { const int id = c.tid + 512 * j, s = id >> 4, cc = id & 15; R.v[j] = *(const GAS u32x4*)(c.Z + (size_t)(it.r0 + s) * ZWD + GV + it.h * 128 + cc * 8); } }
__device__ __forceinline__ void lg_stage(const LgRegs& R, const Ctx& c, int item, ldsp Gk, ldsp Gv) { const Item it = decode(item); float bc[8]; gla_bc_wave(c, R.ga, it.h, bc); u32x4 o;
#pragma unroll
    for (int q = 0; q < 4; ++q) { const float bl0 = wlast(bc[2 * q]), bl1 = wlast(bc[2 * q + 1]);
        o[q] = pkbf(bf2f((unsigned short)(R.k[q] & 0xffffu)) * __expf(bl0 - bc[2 * q]), bf2f((unsigned short)(R.k[q] >> 16)) * __expf(bl1 - bc[2 * q + 1]));
        if (c.lane == 63) { float* GD = (float*)(c.ws + WSO.gdec) + item * 64 + c.wave * 8 + 2 * q; GD[0] = __expf(bl0); GD[1] = __expf(bl1); } }
    *(LAS u32x4*)(Gk + c.lane * GP + c.wave * 16) = o;
#pragma unroll
    for (int j = 0; j < 2; ++j) { const int id = c.tid + 512 * j, s = id >> 4, cc = id & 15; *(LAS u32x4*)(Gv + s * KP + cc * 16) = R.v[j]; } }
__device__ __forceinline__ void lg_compute(const Ctx& c, int item, ldsp Gk, ldsp Gv) {
    const int d0 = 16 * (c.wave & 3), vt0 = (c.wave >> 2) * 4; const bf16x8 b0 = frag_tr(Gk, GP, 0, d0, c.lane), b1 = frag_tr(Gk, GP, 32, d0, c.lane); bf16* SL = (bf16*)(c.ws + WSO.sloc) + (size_t)item * 8192;
#pragma unroll
    for (int q = 0; q < 4; ++q) { const int vt = vt0 + q; f32x4 acc = {0.f, 0.f, 0.f, 0.f}; acc = mma(frag_tr(Gv, KP, 0, 16 * vt, c.lane), b0, acc); acc = mma(frag_tr(Gv, KP, 32, 16 * vt, c.lane), b1, acc);
        u32x2 o; o[0] = pkbf(acc[0], acc[1]); o[1] = pkbf(acc[2], acc[3]); *(GAS u32x2*)(SL + (d0 + (c.lane & 15)) * 128 + 16 * vt + 4 * (c.lane >> 4)) = o; } }
__device__ __forceinline__ void run_local_gla(const Ctx& c, int cu, int G) {
    int item = cu; LgRegs R; if (item < NITEM) lg_load(R, c, item); int set = 0;
    for (; item < NITEM; item += G) { ldsp Gk = c.L + set * 26624, Gv = Gk + 9216; lg_stage(R, c, item, Gk, Gv); if (item + G < NITEM) lg_load(R, c, item + G); BAR_LDS(); lg_compute(c, item, Gk, Gv); set ^= 1; }
    BAR_LDS(); }
template <bool ML> __device__ __forceinline__ void tail_out(const Ctx& c, const LAS float* Hp, int r0, int h, int tt, int vh, u32x4 g0, u32x4 g1) {
    LAS float* PSQ = (LAS float*)(c.L + PSQ_OFF); const int t = c.lane >> 2, c0 = (c.lane & 3) * 16; float hv[16]; float ss = 0.f;
#pragma unroll
    for (int j = 0; j < 16; ++j) { hv[j] = Hp[t * 66 + c0 + j]; ss += hv[j] * hv[j]; }
    ss += shx(ss, 1); ss += shx(ss, 2); if ((c.lane & 3) == 0) PSQ[c.wave * 16 + t] = ss;
    const int row = r0 + 16 * tt + t, col = h * 128 + 64 * vh + c0;
    const LAS float* gn = (const LAS float*)(c.L + GN_OFF) + (ML ? 0 : 512) + col; const f32x4 n0 = *(const LAS f32x4*)gn, n1 = *(const LAS f32x4*)(gn + 4), n2 = *(const LAS f32x4*)(gn + 8), n3 = *(const LAS f32x4*)(gn + 12);
    const float gnv[16] = {n0[0], n0[1], n0[2], n0[3], n1[0], n1[1], n1[2], n1[3], n2[0], n2[1], n2[2], n2[3], n3[0], n3[1], n3[2], n3[3]};
    BAR_LDS();
    const float rs = rsqrtf((PSQ[c.wave * 16 + t] + PSQ[(c.wave ^ 4) * 16 + t]) * (1.0f / 128.0f) + 1e-6f);
    bf16* yo = (bf16*)(c.ws + WSO.ymix) + (size_t)row * 1024 + (ML ? 0 : 512) + col; u32x4 o[2];
#pragma unroll
    for (int q = 0; q < 2; ++q)
#pragma unroll
        for (int j = 0; j < 4; ++j) { const unsigned gw = q ? g1[j] : g0[j]; const float ga = bf2f((unsigned short)(gw & 0xffffu)), gb = bf2f((unsigned short)(gw >> 16));
            const float a0 = ML ? 1.f / (1.f + __expf(-ga)) : ga / (1.f + __expf(-ga)), a1 = ML ? 1.f / (1.f + __expf(-gb)) : gb / (1.f + __expf(-gb));
            o[q][j] = pkbf(a0 * hv[8 * q + 2 * j] * rs * gnv[8 * q + 2 * j], a1 * hv[8 * q + 2 * j + 1] * rs * gnv[8 * q + 2 * j + 1]); }
    *(GAS u32x4*)yo = o[0]; *(GAS u32x4*)(yo + 8) = o[1];
}
template <bool ML> __device__ __forceinline__ void gate_load(u32x4 (&gt)[2], const Ctx& c, const Item& it) { const int tt = c.wave & 3, vh = c.wave >> 2, t = c.lane >> 2, c0 = (c.lane & 3) * 16;
    const bf16* gp = c.Z + (size_t)(it.r0 + 16 * tt + t) * ZWD + (ML ? ZO : GG) + it.h * 128 + 64 * vh + c0; gt[0] = *(const GAS u32x4*)gp; gt[1] = *(const GAS u32x4*)(gp + 8); }
struct OmRegs { float zi, zf, mprev, nst; bf16x8 q[4]; u32x4 k[2], v[2], cc[4], gt[2]; };
__device__ __forceinline__ void om_load(OmRegs& R, const Ctx& c, int item) { const Item it = decode(item);
    R.zi = c.ZG[(size_t)(it.r0 + c.lane) * ZGP + it.h]; R.zf = c.ZG[(size_t)(it.r0 + c.lane) * ZGP + 4 + it.h]; R.mprev = ((const float*)(c.ws + WSO.mst))[item]; R.nst = ((const float*)(c.ws + WSO.nst))[item * 128 + (c.tid & 127)];
    const bf16* zr = c.Z + (size_t)it.r0 * ZWD + it.h * 128;
#pragma unroll
    for (int ks = 0; ks < 4; ++ks) R.q[ks] = *(const GAS bf16x8*)(zr + (size_t)(16 * (c.wave & 3) + (c.lane & 15)) * ZWD + ZQ + 32 * ks + 8 * (c.lane >> 4));
#pragma unroll
    for (int j = 0; j < 2; ++j) { const int id = c.tid + 512 * j, s = id >> 4, cc = id & 15; R.k[j] = *(const GAS u32x4*)(zr + (size_t)s * ZWD + ZK + cc * 8); R.v[j] = *(const GAS u32x4*)(zr + (size_t)s * ZWD + ZV + cc * 8); }
    gate_load<true>(R.gt, c, it);
    const bf16* cs = (const bf16*)(c.ws + WSO.cst) + (size_t)item * 16384;
#pragma unroll
    for (int j = 0; j < 4; ++j) { const int id = c.tid + 512 * j; R.cc[j] = *(const GAS u32x4*)(cs + id * 8); } }
__device__ __forceinline__ void om_stage(const OmRegs& R, const Ctx& c, ldsp Ks, ldsp Vs, ldsp Cs) {
#pragma unroll
    for (int j = 0; j < 2; ++j) { const int id = c.tid + 512 * j, s = id >> 4, cc = id & 15; *(LAS u32x4*)(Ks + s * KP + cc * 16) = R.k[j]; *(LAS u32x4*)(Vs + s * VP + cc * 16) = R.v[j]; }
#pragma unroll
    for (int j = 0; j < 4; ++j) { const int id = c.tid + 512 * j, d = id >> 4, cc = id & 15; *(LAS u32x4*)(Cs + d * VP + cc * 16) = R.cc[j]; }
    if (c.tid < 128) { const int s = c.tid >> 1; unsigned zz = 0u; asm volatile("" : "+v"(zz));
        u32x4 o = {zz, zz, zz, zz}; if ((c.tid & 1) == 0) o[0] = zz + 0x3f80u; *(LAS u32x4*)(Vs + s * VP + 256 + (c.tid & 1) * 16) = o;
        u32x4 o2 = {pkbf(R.nst, 0.f), zz, zz, zz}; *(LAS u32x4*)(Cs + c.tid * VP + 256) = o2; u32x4 z = {zz, zz, zz, zz}; *(LAS u32x4*)(Cs + c.tid * VP + 272) = z; } }
__device__ __forceinline__ void om_compute(const OmRegs& R, const Ctx& c, int item, ldsp Ks, ldsp Vs, ldsp Cs) { const Item it = decode(item);
    const int tt = c.wave & 3, vh = c.wave >> 2, g = c.lane >> 4, li = c.lane & 15; ldsp Sp = c.L + PRIV_OFF + c.wave * PRIV_BYTES; LAS float* Hp = (LAS float*)Sp;
    const LAS float* GB = (const LAS float*)(c.L + GN_OFF) + 1024; const float ip = R.zi + GB[it.h], lf = lsig(R.zf + GB[4 + it.h]); const float bc = wscan_add(lf, c.lane), a = bc + R.mprev, u = ip - bc, pm = wscan_max(u, c.lane), mt = fmaxf(a, bc + pm), rt = bc - mt, wi = __expf(a - mt), emt = __expf(-mt);
    float rtv[4], wiv[4], emv[4];
#pragma unroll
    for (int r = 0; r < 4; ++r) { const int t = 16 * tt + 4 * g + r; rtv[r] = shl(rt, t); wiv[r] = shl(wi, t); emv[r] = shl(emt, t); }
#pragma unroll
    for (int st = 0; st < 4; ++st) { const float us = shl(u, 16 * st + li); f32x4 acc = {0.f, 0.f, 0.f, 0.f};
        if (st <= tt) {
#pragma unroll
            for (int ks = 0; ks < 4; ++ks) acc = mma(R.q[ks], frag_row(Ks, KP, 16 * st, 32 * ks, c.lane), acc); }
#pragma unroll
        for (int r = 0; r < 4; ++r) { const int t = 16 * tt + 4 * g + r, s = 16 * st + li; const float v = (s <= t) ? acc[r] * __expf(rtv[r] + us) : 0.f; *(LAS unsigned short*)(Sp + (4 * g + r) * GP + s * 2) = (unsigned short)f2bf(v); } }
    LDS_WAIT();
    const bf16x8 s0 = frag_row(Sp, GP, 0, 0, c.lane), s1 = frag_row(Sp, GP, 0, 32, c.lane);
    f32x4 hv[5];
#pragma unroll
    for (int q = 0; q < 5; ++q) { const int vt = q < 4 ? 4 * vh + q : 8; f32x4 a1 = {0.f, 0.f, 0.f, 0.f}, a2 = {0.f, 0.f, 0.f, 0.f};
        a1 = mma(s0, frag_tr(Vs, VP, 0, 16 * vt, c.lane), a1); a1 = mma(s1, frag_tr(Vs, VP, 32, 16 * vt, c.lane), a1);
#pragma unroll
        for (int ks = 0; ks < 4; ++ks) a2 = mma(R.q[ks], frag_tr(Cs, VP, 32 * ks, 16 * vt, c.lane), a2);
#pragma unroll
        for (int r = 0; r < 4; ++r) hv[q][r] = a1[r] + wiv[r] * a2[r]; }
    LDS_WAIT();
#pragma unroll
    for (int r = 0; r < 4; ++r) { const float den = shl(hv[4][r], 16 * g); const float sc = 1.f / fmaxf(fabsf(den), emv[r]);
#pragma unroll
        for (int q = 0; q < 4; ++q) Hp[(4 * g + r) * 66 + 16 * q + li] = hv[q][r] * sc; }
    LDS_WAIT();
    tail_out<true>(c, Hp, it.r0, it.h, tt, vh, R.gt[0], R.gt[1]);
}
__device__ __forceinline__ void run_out_mlstm(const Ctx& c, int cu, int G) {
    int item = cu; OmRegs R; if (item < NITEM) om_load(R, c, item); ldsp Ks = c.L, Vs = c.L + 17408, Cs = c.L + 36864;
    for (; item < NITEM; item += G) { BAR_LDS(); om_stage(R, c, Ks, Vs, Cs); OmRegs R2 = R; if (item + G < NITEM) om_load(R, c, item + G); BAR_LDS(); om_compute(R2, c, item, Ks, Vs, Cs); }
    BAR_LDS(); }
struct OgRegs { f32x4 ga[4]; u32x4 q, k; u32x4 v[2], s[2], gt[2]; };
__device__ __forceinline__ void og_load(OgRegs& R, const Ctx& c, int item) { const Item it = decode(item);
#pragma unroll
    for (int q = 0; q < 4; ++q) R.ga[q] = *(const GAS f32x4*)(c.ZG + (size_t)(it.r0 + c.lane) * ZGP + 8 + 4 * q);
    const bf16* zr = c.Z + (size_t)(it.r0 + c.lane) * ZWD + it.h * 64 + c.wave * 8; R.q = *(const GAS u32x4*)(zr + GQ); R.k = *(const GAS u32x4*)(zr + GK);
    gate_load<false>(R.gt, c, it);
    const bf16* ss = (const bf16*)(c.ws + WSO.sst) + (size_t)item * 8192;
#pragma unroll
    for (int j = 0; j < 2; ++j) { const int id = c.tid + 512 * j, s = id >> 4, cc = id & 15; R.v[j] = *(const GAS u32x4*)(c.Z + (size_t)(it.r0 + s) * ZWD + GV + it.h * 128 + cc * 8); R.s[j] = *(const GAS u32x4*)(ss + id * 8); } }
__device__ __forceinline__ void og_stage(const OgRegs& R, const Ctx& c, int item, ldsp Gq, ldsp Gk, ldsp Gv, ldsp Gs) { const Item it = decode(item); float bc[8]; gla_bc_wave(c, R.ga, it.h, bc); u32x4 oq, ok;
#pragma unroll
    for (int q = 0; q < 4; ++q) { const float e0 = bc[2 * q], e1 = bc[2 * q + 1];
        oq[q] = pkbf(bf2f((unsigned short)(R.q[q] & 0xffffu)) * __expf(e0), bf2f((unsigned short)(R.q[q] >> 16)) * __expf(e1));
        ok[q] = pkbf(bf2f((unsigned short)(R.k[q] & 0xffffu)) * __expf(-e0), bf2f((unsigned short)(R.k[q] >> 16)) * __expf(-e1)); }
    *(LAS u32x4*)(Gq + c.lane * GP + c.wave * 16) = oq; *(LAS u32x4*)(Gk + c.lane * GP + c.wave * 16) = ok;
#pragma unroll
    for (int j = 0; j < 2; ++j) { const int id = c.tid + 512 * j, s = id >> 4, cc = id & 15; *(LAS u32x4*)(Gv + s * KP + cc * 16) = R.v[j]; *(LAS u32x4*)(Gs + s * KP + cc * 16) = R.s[j]; } }
__device__ __forceinline__ void og_compute(const Ctx& c, int item, ldsp Gq, ldsp Gk, ldsp Gv, ldsp Gs, u32x4 g0, u32x4 g1) { const Item it = decode(item);
    const int tt = c.wave & 3, vh = c.wave >> 2, g = c.lane >> 4, li = c.lane & 15; ldsp Ap = c.L + PRIV_OFF + c.wave * PRIV_BYTES; LAS float* Hp = (LAS float*)Ap;
    const bf16x8 q0 = frag_row(Gq, GP, 16 * tt, 0, c.lane), q1 = frag_row(Gq, GP, 16 * tt, 32, c.lane);
#pragma unroll
    for (int st = 0; st < 4; ++st) { f32x4 acc = {0.f, 0.f, 0.f, 0.f};
        if (st <= tt) { acc = mma(q0, frag_row(Gk, GP, 16 * st, 0, c.lane), acc); acc = mma(q1, frag_row(Gk, GP, 16 * st, 32, c.lane), acc); }
#pragma unroll
        for (int r = 0; r < 4; ++r) { const int t = 16 * tt + 4 * g + r, s = 16 * st + li; *(LAS unsigned short*)(Ap + (4 * g + r) * GP + s * 2) = (unsigned short)f2bf((s <= t) ? acc[r] : 0.f); } }
    LDS_WAIT();
    const bf16x8 a0 = frag_row(Ap, GP, 0, 0, c.lane), a1 = frag_row(Ap, GP, 0, 32, c.lane); f32x4 hv[4];
#pragma unroll
    for (int q = 0; q < 4; ++q) { const int vt = 4 * vh + q; f32x4 acc = {0.f, 0.f, 0.f, 0.f};
        acc = mma(a0, frag_tr(Gv, KP, 0, 16 * vt, c.lane), acc); acc = mma(a1, frag_tr(Gv, KP, 32, 16 * vt, c.lane), acc);
        acc = mma(q0, frag_tr(Gs, KP, 0, 16 * vt, c.lane), acc); acc = mma(q1, frag_tr(Gs, KP, 32, 16 * vt, c.lane), acc); hv[q] = acc; }
    LDS_WAIT();
#pragma unroll
    for (int q = 0; q < 4; ++q)
#pragma unroll
        for (int r = 0; r < 4; ++r) Hp[(4 * g + r) * 66 + 16 * q + li] = hv[q][r];
    LDS_WAIT();
    tail_out<false>(c, Hp, it.r0, it.h, tt, vh, g0, g1);
}
__device__ __forceinline__ void run_out_gla(const Ctx& c, int cu, int G) {
    int item = cu; OgRegs R; if (item < NITEM) og_load(R, c, item); ldsp Gq = c.L, Gk = c.L + 9216, Gv = c.L + 18432, Gs = c.L + 35840;
    for (; item < NITEM; item += G) { BAR_LDS(); og_stage(R, c, item, Gq, Gk, Gv, Gs); const u32x4 g0 = R.gt[0], g1 = R.gt[1]; if (item + G < NITEM) og_load(R, c, item + G); BAR_LDS(); og_compute(c, item, Gq, Gk, Gv, Gs, g0, g1); }
    BAR_LDS(); }
__device__ __forceinline__ void phase_local(const Ctx& c, int cu, int G) {
    load_wa(c); run_local_mlstm(c, cu, G); run_local_gla(c, cu, G);
#ifdef MK_X2_LM
    run_local_mlstm(c, cu, G);
#endif
#ifdef MK_X2_LG
    run_local_gla(c, cu, G);
#endif
#ifdef MK_X2_SM
    for (int it = cu; it < 512; it += G) sample_mlstm(c, it);
#endif
#ifdef MK_X2_SG
    for (int it = cu; it < 512; it += G) sample_gla(c, it);
#endif
    for (int it = cu; it < 512; it += G) sample_mlstm(c, it);
    for (int it = cu; it < 512; it += G) sample_gla(c, it);
}
__device__ __forceinline__ void phase_out(const Ctx& c, int cu, int G) { load_wa(c); run_out_mlstm(c, cu, G); run_out_gla(c, cu, G);
#ifdef MK_X2_OM
    run_out_mlstm(c, cu, G);
#endif
#ifdef MK_X2_OG
    run_out_gla(c, cu, G);
#endif
}
}
#undef BAR_LDS
namespace xa {
using mx::bf16x8; using mx::f32x4; using mx::u32x4; using mx::u32x2; using mx::ldsp; using mx::mma; using mx::frag_row; using mx::frag_tr; using mx::bf2f;
#define BAR_LDS() do { asm volatile("s_waitcnt lgkmcnt(0)" ::: "memory"); __builtin_amdgcn_s_barrier(); asm volatile("" ::: "memory"); } while (0)
constexpr int CP = 528;
constexpr int CB_BYTES = 64 * CP;
constexpr int SC_OFF = 2 * CB_BYTES, PL_OFF = SC_OFF + 4096, PLP = 528;
__device__ __forceinline__ void pa_load(u32x4 (&pre)[4], const mx::Ctx& c, int item, int i, int tid) {
    const int b = item >> 5, h = (item >> 3) & 3; const bf16* p; int pitch;
    if (i < 4) { p = (const bf16*)(c.ws + WSO.kb) + (size_t)(b * 256 + 64 * i) * 1024 + h * 256; pitch = 1024; } else { p = (const bf16*)(c.ws + WSO.vt) + (size_t)((b * 4 + h) * 256 + 64 * (i - 4)) * 256; pitch = 256; }
#pragma unroll
    for (int j = 0; j < 4; ++j) { const int id = tid + 512 * j, s = id >> 5, ch = id & 31; pre[j] = *(const GAS u32x4*)(p + (size_t)s * pitch + ch * 8); }
}
__device__ __forceinline__ void pa_store(ldsp buf, const u32x4 (&pre)[4], int tid) {
#pragma unroll
    for (int j = 0; j < 4; ++j) { const int id = tid + 512 * j, s = id >> 5, ch = id & 31; *(LAS u32x4*)(buf + s * CP + ch * 16) = pre[j]; }
}
__device__ __forceinline__ void prompt_stream(const mx::Ctx& c, int cu, int G) {
    ldsp B0 = c.L, B1 = c.L + CB_BYTES; int item = cu; if (item >= 256) return;
    u32x4 pre[4]; pa_load(pre, c, item, 0, c.tid); pa_store(B0, pre, c.tid); BAR_LDS();
    const bf16* Q = (const bf16*)(c.ws + WSO.q); bf16* O = (bf16*)(c.ws + WSO.o); const int g = c.lane >> 4, li = c.lane & 15;
    for (; item < 256; item += G) {
        const int b = item >> 5, h = (item >> 3) & 3, qb = item & 7, row0 = b * 2048 + qb * 256 + c.wave * 32, nxt = item + G;
        bf16x8 qf[2][8];
#pragma unroll
        for (int mt = 0; mt < 2; ++mt)
#pragma unroll
            for (int ks = 0; ks < 8; ++ks) qf[mt][ks] = __builtin_nontemporal_load((const GAS bf16x8*)(Q + (size_t)(row0 + 16 * mt + li) * 1024 + h * 256 + 32 * ks + 8 * g));
        f32x4 sc[2][16]; u32x4 pf[2][8]; float rinv[2] = {0.f, 0.f};
#pragma unroll
        for (int i = 0; i < 8; ++i) {
            ldsp cur = (i & 1) ? B1 : B0; ldsp oth = (i & 1) ? B0 : B1; const bool have_next = (i < 7) || (nxt < 256);
            if (have_next) pa_load(pre, c, i < 7 ? item : nxt, i < 7 ? i + 1 : 0, c.tid);
            if (i < 4) {
#pragma unroll
                for (int nt = 0; nt < 4; ++nt) { f32x4 a0 = {0.f, 0.f, 0.f, 0.f}, a1 = {0.f, 0.f, 0.f, 0.f};
#pragma unroll
                    for (int ks = 0; ks < 8; ++ks) { const bf16x8 kf = frag_row(cur, CP, 16 * nt, 32 * ks, c.lane); a0 = mma(kf, qf[0][ks], a0); a1 = mma(kf, qf[1][ks], a1); }
                    sc[0][i * 4 + nt] = a0; sc[1][i * 4 + nt] = a1; }
                if (i == 3) {
#pragma unroll
                    for (int mt = 0; mt < 2; ++mt) { float m = sc[mt][0][0];
#pragma unroll
                        for (int tl = 0; tl < 16; ++tl)
#pragma unroll
                            for (int r = 0; r < 4; ++r) m = fmaxf(m, sc[mt][tl][r]);
                        m = fmaxf(m, shx(m, 16)); m = fmaxf(m, shx(m, 32)); float s = 0.f;
#pragma unroll
                        for (int tl = 0; tl < 16; ++tl)
#pragma unroll
                            for (int r = 0; r < 4; ++r) { sc[mt][tl][r] = __expf(sc[mt][tl][r] - m); s += sc[mt][tl][r]; }
                        s += shx(s, 16); s += shx(s, 32); rinv[mt] = 1.f / s;
#pragma unroll
                        for (int ks = 0; ks < 8; ++ks) { pf[mt][ks][0] = pk2(sc[mt][2 * ks][0], sc[mt][2 * ks][1]); pf[mt][ks][1] = pk2(sc[mt][2 * ks][2], sc[mt][2 * ks][3]); pf[mt][ks][2] = pk2(sc[mt][2 * ks + 1][0], sc[mt][2 * ks + 1][1]); pf[mt][ks][3] = pk2(sc[mt][2 * ks + 1][2], sc[mt][2 * ks + 1][3]); } }
                }
            } else {
                const int dc = i - 4;
#pragma unroll
                for (int nt = 0; nt < 4; ++nt) { f32x4 a0 = {0.f, 0.f, 0.f, 0.f}, a1 = {0.f, 0.f, 0.f, 0.f}; ldsp ar = cur + (16 * nt + li) * CP + 8 * g;
#pragma unroll
                    for (int ks = 0; ks < 8; ++ks) { const u32x2 lo = *(const LAS u32x2*)(ar + 64 * ks), hi = *(const LAS u32x2*)(ar + 64 * ks + 32); const u32x4 av = {lo[0], lo[1], hi[0], hi[1]};
                        a0 = mma(__builtin_bit_cast(bf16x8, av), __builtin_bit_cast(bf16x8, pf[0][ks]), a0); a1 = mma(__builtin_bit_cast(bf16x8, av), __builtin_bit_cast(bf16x8, pf[1][ks]), a1); }
                    u32x2 o; o[0] = pk2(a0[0] * rinv[0], a0[1] * rinv[0]); o[1] = pk2(a0[2] * rinv[0], a0[3] * rinv[0]);
                    *(GAS u32x2*)(O + (size_t)(row0 + li) * 1024 + h * 256 + 64 * dc + 16 * nt + 4 * g) = o;
                    o[0] = pk2(a1[0] * rinv[1], a1[1] * rinv[1]); o[1] = pk2(a1[2] * rinv[1], a1[3] * rinv[1]);
                    *(GAS u32x2*)(O + (size_t)(row0 + 16 + li) * 1024 + h * 256 + 64 * dc + 16 * nt + 4 * g) = o; }
            }
            if (have_next) pa_store(oth, pre, c.tid);
            BAR_LDS();
        }
    }
}
__device__ __forceinline__ void sa_load(f32x4 (&pre)[8], const mx::Ctx& c, int item, int i, int tid) {
    const int b = item >> 2, h = item & 3; const float* p = (i < 4 ? c.in[nv::I_CK] : c.in[nv::I_CV]) + ((size_t)(b * 256 + 64 * (i & 3)) * 4 + h) * 256;
#pragma unroll
    for (int j = 0; j < 8; ++j) { const int id = tid + 512 * j, key = id >> 6, c4 = id & 63; pre[j] = __builtin_nontemporal_load((const GAS f32x4*)(p + (size_t)key * 1024 + 4 * c4)); }
}
__device__ __forceinline__ void sa_store(ldsp buf, const f32x4 (&pre)[8], int tid) {
#pragma unroll
    for (int j = 0; j < 8; ++j) { const int id = tid + 512 * j, key = id >> 6, c4 = id & 63; u32x2 o; o[0] = pk2(pre[j][0], pre[j][1]); o[1] = pk2(pre[j][2], pre[j][3]); *(LAS u32x2*)(buf + key * CP + c4 * 8) = o; }
}
__device__ __forceinline__ void sample_stream(const mx::Ctx& c, int cu, int G) {
    ldsp B0 = c.L, B1 = c.L + CB_BYTES; LAS float* SCs = (LAS float*)(c.L + SC_OFF); ldsp Pl = c.L + PL_OFF; int item = cu; if (item >= 512) return;
    for (int i = c.tid; i < 16 * PLP / 4; i += 512) ((LAS unsigned*)Pl)[i] = 0u;
    f32x4 preA[8], preB[8];
    sa_load(preA, c, item, 0, c.tid); sa_load(preB, c, item, 1, c.tid); sa_store(B0, preA, c.tid); BAR_LDS();
    const bf16* Q = (const bf16*)(c.ws + WSO.q); bf16* O = (bf16*)(c.ws + WSO.o); const int g = c.lane >> 4, li = c.lane & 15;
    for (; item < 512; item += G) {
        const int b = item >> 2, h = item & 3, r0 = 16384 + 4 * b, nxt = item + G;
        bf16x8 qf[8];
#pragma unroll
        for (int ks = 0; ks < 8; ++ks) { u32x4 v = {0u, 0u, 0u, 0u}; if (li < 4) v = *(const GAS u32x4*)(Q + (size_t)(r0 + li) * 1024 + h * 256 + 32 * ks + 8 * g); qf[ks] = __builtin_bit_cast(bf16x8, v); }
        f32x4 oacc[2] = {{0.f, 0.f, 0.f, 0.f}, {0.f, 0.f, 0.f, 0.f}};
#pragma unroll
        for (int i = 0; i < 8; ++i) {
            ldsp cur = (i & 1) ? B1 : B0; ldsp oth = (i & 1) ? B0 : B1;
            const bool have1 = (i < 7) || (nxt < 512), have2 = (i < 6) || (nxt < 512);
            if (have2) { if (i & 1) sa_load(preB, c, i < 6 ? item : nxt, i < 6 ? i + 2 : i - 6, c.tid); else sa_load(preA, c, i < 6 ? item : nxt, i < 6 ? i + 2 : i - 6, c.tid); }
            if (i < 4) {
                if (c.wave < 4) { f32x4 acc = {0.f, 0.f, 0.f, 0.f};
#pragma unroll
                    for (int ks = 0; ks < 8; ++ks) acc = mma(frag_row(cur, CP, 16 * c.wave, 32 * ks, c.lane), qf[ks], acc);
                    if (li < 4) *(LAS f32x4*)(SCs + li * 256 + 64 * i + 16 * c.wave + 4 * g) = acc; }
            } else {
                if (i == 4) {
                    if (c.wave < 4) { const f32x4 s = *(const LAS f32x4*)(SCs + c.wave * 256 + 4 * c.lane); const float m = mx::wmax(fmaxf(fmaxf(s[0], s[1]), fmaxf(s[2], s[3])));
                        const float p0 = __expf(s[0] - m), p1 = __expf(s[1] - m), p2 = __expf(s[2] - m), p3 = __expf(s[3] - m); const float inv = 1.f / mx::wsum((p0 + p1) + (p2 + p3));
                        u32x2 o; o[0] = pk2(p0 * inv, p1 * inv); o[1] = pk2(p2 * inv, p3 * inv); *(LAS u32x2*)(Pl + c.wave * PLP + c.lane * 8) = o; }
                    BAR_LDS();
                }
                const int vc = i - 4;
#pragma unroll
                for (int q = 0; q < 2; ++q)
#pragma unroll
                    for (int ks = 0; ks < 2; ++ks) oacc[q] = mma(frag_row(Pl, PLP, 0, 64 * vc + 32 * ks, c.lane), frag_tr(cur, CP, 32 * ks, 16 * (2 * c.wave + q), c.lane), oacc[q]);
                if (i == 7 && g == 0) {
#pragma unroll
                    for (int q = 0; q < 2; ++q)
#pragma unroll
                        for (int r = 0; r < 4; ++r) O[(size_t)(r0 + r) * 1024 + h * 256 + 16 * (2 * c.wave + q) + li] = (bf16)f2bf(oacc[q][r]); }
            }
            if (have1) { if (i & 1) sa_store(oth, preA, c.tid); else sa_store(oth, preB, c.tid); }
            BAR_LDS();
        }
    }
}
__device__ __forceinline__ void phase_attn(const mx::Ctx& c, int cu, int G) {
#ifdef MK_X2_PROMPT
    prompt_stream(c, cu, G); __syncthreads();
#endif
#ifdef MK_X2_SAMPLE
    sample_stream(c, cu, G); __syncthreads();
#endif
    if ((G & 1) == 0) { if (cu & 1) prompt_stream(c, cu >> 1, G >> 1); else sample_stream(c, cu >> 1, G >> 1); }
    else { prompt_stream(c, cu, G); __syncthreads(); sample_stream(c, cu, G); }
}
}
namespace sg {
using mx::bf16x8; using mx::f32x4; using mx::u32x2; using mx::ldsp; using mx::mma;
template <int MODE> __device__ __forceinline__ void small_gemm(ldsp L, unsigned char* ws, const bf16* A, const bf16* Bt, int K, float alpha, const float* base0, int tile, int tid, int lane, int wave, float* yout = nullptr) {
    const int rt = tile >> 4, ct = tile & 15, row0 = PROWS + 32 * rt, col0 = 64 * ct, kw = K >> 3, kbeg = wave * kw, nks = kw >> 5;
    f32x4 acc[2][4];
#pragma unroll
    for (int m = 0; m < 2; ++m)
#pragma unroll
        for (int n = 0; n < 4; ++n) acc[m][n] = (f32x4){0.f, 0.f, 0.f, 0.f};
    const bf16* ap = A + (size_t)(row0 + (lane & 15)) * K + kbeg + 8 * (lane >> 4); const bf16* bp = Bt + (size_t)(col0 + (lane & 15)) * K + kbeg + 8 * (lane >> 4);
#pragma unroll 4
    for (int ks = 0; ks < nks; ++ks) { bf16x8 a[2], b[4];
#pragma unroll
        for (int m = 0; m < 2; ++m) a[m] = *(const GAS bf16x8*)(ap + (size_t)(16 * m) * K + 32 * ks);
#pragma unroll
        for (int n = 0; n < 4; ++n) b[n] = *(const GAS bf16x8*)(bp + (size_t)(16 * n) * K + 32 * ks);
#pragma unroll
        for (int m = 0; m < 2; ++m)
#pragma unroll
            for (int n = 0; n < 4; ++n) acc[m][n] = mma(a[m], b[n], acc[m][n]); }
    LAS float* P = (LAS float*)L + wave * 2048;
#pragma unroll
    for (int m = 0; m < 2; ++m)
#pragma unroll
        for (int n = 0; n < 4; ++n)
#pragma unroll
            for (int r = 0; r < 4; ++r) P[(16 * m + 4 * (lane >> 4) + r) * 64 + 16 * n + (lane & 15)] = acc[m][n][r];
    __syncthreads();
    { const int r = tid >> 4, c4 = (tid & 15) * 4; f32x4 s = {0.f, 0.f, 0.f, 0.f};
#pragma unroll
      for (int w = 0; w < 8; ++w) s += *(const LAS f32x4*)((LAS float*)L + w * 2048 + r * 64 + c4);
      const int row = row0 + r, col = col0 + c4;
      if (MODE == 0) { bf16* XBp = (bf16*)(ws + WSO.xb) + (size_t)row * DM + col; f32x4 bs;
          if (base0) bs = *(const GAS f32x4*)(base0 + (size_t)(row - PROWS) * DM + col);
          else { const u32x2 w = *(const GAS u32x2*)XBp; bs[0] = __uint_as_float(w[0] << 16); bs[1] = __uint_as_float(w[0] & 0xffff0000u); bs[2] = __uint_as_float(w[1] << 16); bs[3] = __uint_as_float(w[1] & 0xffff0000u); }
          const f32x4 o = bs + s * alpha; u32x2 pk; pk.x = pk2(o[0], o[1]); pk.y = pk2(o[2], o[3]); *(GAS u32x2*)XBp = pk;
          float q = (o[0] * o[0] + o[1] * o[1]) + (o[2] * o[2] + o[3] * o[3]); q += shx(q, 1); q += shx(q, 2); q += shx(q, 4); q += shx(q, 8);
          if ((tid & 15) == 0) ((float*)(ws + WSO.ssq))[(size_t)row * 16 + ct] = q; }
      else if (MODE == 2) { const bf16* XBp = (const bf16*)(ws + WSO.xb) + (size_t)row * DM + col; const u32x2 w = *(const GAS u32x2*)XBp;
          const f32x4 bs = {__uint_as_float(w[0] << 16), __uint_as_float(w[0] & 0xffff0000u), __uint_as_float(w[1] << 16), __uint_as_float(w[1] & 0xffff0000u)}; const f32x4 o = bs + s * alpha;
          float q = (o[0] * o[0] + o[1] * o[1]) + (o[2] * o[2] + o[3] * o[3]); q += shx(q, 1); q += shx(q, 2); q += shx(q, 4); q += shx(q, 8);
          float* SSQ = (float*)(ws + WSO.ssq); if ((tid & 15) == 0) __hip_atomic_store((unsigned*)(SSQ + (size_t)row * 16 + ct), __float_as_uint(q), __ATOMIC_RELAXED, __HIP_MEMORY_SCOPE_AGENT);
          asm volatile("s_waitcnt vmcnt(0)" ::: "memory"); unsigned* cnt = (unsigned*)(ws + WSO.ctl) + pg8::CW_PANEL + 64 * (64 + rt);
          if (lane == 0) __hip_atomic_fetch_add(cnt, 1u, __ATOMIC_RELAXED, __HIP_MEMORY_SCOPE_AGENT);
          pg8::panel_wait(cnt, 128u, wave, lane);
          float ss = 0.f; { const unsigned long long* sp = (const unsigned long long*)(SSQ + (size_t)row * 16);
#pragma unroll
              for (int j = 0; j < 8; ++j) { const unsigned long long v = __hip_atomic_load(sp + j, __ATOMIC_RELAXED, __HIP_MEMORY_SCOPE_AGENT); ss += __uint_as_float((unsigned)v) + __uint_as_float((unsigned)(v >> 32)); } }
          const float rs = rsqrtf(ss * (1.0f / DM) + 1e-6f); const f32x4 gv = *(const GAS f32x4*)(base0 + col);
          *(GAS f32x4*)(yout + (size_t)row * DM + col) = o * rs * gv; }
      else { const GAS f32x4* sp = (const GAS f32x4*)((const float*)(ws + WSO.ssq) + (size_t)row * 16); const f32x4 s0 = sp[0], s1 = sp[1], s2 = sp[2], s3 = sp[3];
          const float ss = ((s0[0] + s0[1]) + (s0[2] + s0[3])) + ((s1[0] + s1[1]) + (s1[2] + s1[3])) + ((s2[0] + s2[1]) + (s2[2] + s2[3])) + ((s3[0] + s3[1]) + (s3[2] + s3[3]));
          const float rs = rsqrtf(ss * (1.0f / DM) + 1e-6f); u32x2 pk; pk.x = pk2(s[0] * rs, s[1] * rs); pk.y = pk2(s[2] * rs, s[3] * rs); *(GAS u32x2*)((bf16*)(ws + WSO.q) + (size_t)row * DM + col) = pk; } }
    __syncthreads();
}
}
#define MK_PROGRAM launch_mk(hs, 0, MK_NSTEPS, li, stream);
#ifndef MK_SP2_SINGLE
#define MK_SP2_SINGLE true
#endif
#ifndef MK_SEQ0
#define MK_SEQ0 0x00DCBA9876543210ull
#define MK_SEQ1 0ull
#define MK_REPBITS 0u
#define MK_NSTEPS 14
#endif

__global__ void __launch_bounds__(NWAVES * 64, 2) mk_fwd(Args args) {
    extern __shared__ __attribute__((aligned(16))) unsigned char lds[];
    volatile LAS unsigned* MISC = (volatile LAS unsigned*)((LAS unsigned char*)lds + MISC_OFF);
    gu32* ctl = (gu32*)(args.ws + WSO.ctl);
    for (int u = threadIdx.x; u < (LDS_BYTES - LDSCTL_OFF) / 4; u += NWAVES * 64) ((LAS unsigned*)((LAS unsigned char*)lds + LDSCTL_OFF))[u] = 0u;
    __syncthreads();
    XcdBarrier bar = xcd_barrier_post((unsigned*)(ctl + CW_BAR) + args.li * XCD_BAR_WORDS, MISC + 8);
    constexpr nv::Ws w = WSO; const int wave_s = __builtin_amdgcn_readfirstlane((int)threadIdx.x >> 6);
    for (int pi = args.ph_lo; pi < args.ph_hi; ++pi) {
        const int ph = (int)(((pi < 16 ? MK_SEQ0 : MK_SEQ1) >> (4 * (pi & 15))) & 15ull); const int rep = (int)((MK_REPBITS >> pi) & 1u);
        int tid_ = wave_s * 64 + (int)__builtin_amdgcn_mbcnt_hi(~0u, __builtin_amdgcn_mbcnt_lo(~0u, 0u)); asm volatile("" : "+v"(tid_));     unsigned char* ws = args.ws; asm volatile("" : "+s"(ws)); int zoff_ = 0; asm volatile("" : "+s"(zoff_)); const float* const* inp = args.in + zoff_;     float* outp = args.out; asm volatile("" : "+s"(outp));
        Frame F; F.lds = (LAS unsigned char*)lds; F.tid = tid_; F.lane = F.tid & 63; F.wave = __builtin_amdgcn_readfirstlane(F.tid >> 6);
        F.G = gridDim.x; { const int bx = blockIdx.x; F.vcu = (F.G % 8 == 0) ? (bx % 8) * (F.G / 8) + bx / 8 : bx; }
        const float* SSQ = (const float*)(ws + w.ssq);
        switch (ph) {
#ifndef MK_NO_PRO
        case PH_PROLOGUE: p0_prologue(F, inp, ws); break;
#endif
#ifndef MK_NO_UP
        case PH_UP1: case PH_UP2: {
            pg8::Gemm g{(const pg8::bf16_t*)(ws + w.xb), (const pg8::bf16_t*)(ws + (ph == PH_UP1 ? w.wgu1 : w.wgu2)), MROWS, 2 * DFF, DM}; pg8::StaticOrder S; S.init(MROWS, 2 * DFF, F.G, (int)blockIdx.x);
            PG8_LAS float* rsl = (PG8_LAS float*)(F.lds + RSL_OFF); pg8::rstd_to_lds(rsl, SSQ, S, F.tid);
            pg8::EpiSwigluL E{(pg8::bf16_t*)(ws + w.r1), rsl, DFF, 0};
            pg8::gemm_phase<pg8::EpiSwigluL, pg8::StaticOrder, true, true>(F.lds + RING_OFF, g, S, E, F.tid);
            if (ph == PH_UP1) {
                pg8::Gemm g2{(const pg8::bf16_t*)(ws + w.memb), (const pg8::bf16_t*)(ws + w.wkv), MEMROWS, 2 * DM, DM}; pg8::StaticOrder S2;
                const int rem = ((MROWS / 256) * (2 * DFF / 256)) % F.G; S2.init(MEMROWS, 2 * DM, F.G, ((int)blockIdx.x + F.G - rem) % F.G);
                pg8::EpiKV E2{outp + OUTO.mk, outp + OUTO.mv, (pg8::bf16_t*)(ws + w.kb), (pg8::bf16_t*)(ws + w.vt), (const float*)(ws + w.mssq)};
                pg8::gemm_phase<pg8::EpiKV, pg8::StaticOrder, true, true>(F.lds + RING_OFF, g2, S2, E2, F.tid);
            }
            break; }
#endif
#ifndef MK_NO_RES
        case PH_DOWN1: case PH_WOUT: case PH_WO: case PH_DOWN2: {
            const bool down = (ph == PH_DOWN1 || ph == PH_DOWN2);
            const size_t aoff = down ? w.r1 : (ph == PH_WOUT ? w.ymix : w.o), boff = ph == PH_DOWN1 ? w.wd1 : ph == PH_DOWN2 ? w.wd2 : ph == PH_WOUT ? w.wout : w.wo;
            const int KK = down ? DFF : DM; const float alpha = (rep && ph != PH_DOWN1) ? 0.f : (down ? 0.5f : 1.0f);
            pg8::Gemm g{(const pg8::bf16_t*)(ws + aoff), (const pg8::bf16_t*)(ws + boff), PROWS, DM, KK}; pg8::StaticOrder S; S.init(PROWS, DM, F.G, (int)blockIdx.x);
#ifdef MK_FUSED_FINAL
            if (ph == PH_DOWN2 && !rep && F.G == 256) {
                pg8::EpiResidFinal EF{(const pg8::bf16_t*)(ws + w.xb), (float*)(ws + w.ssq), outp + OUTO.yp, inp[nv::I_FING], (unsigned*)(ws + w.ctl) + pg8::CW_PANEL, alpha, 0};
                pg8::gemm_phase<pg8::EpiResidFinal, pg8::StaticOrder, false, true>(F.lds + RING_OFF, g, S, EF, F.tid);
                sg::small_gemm<2>(F.lds, ws, (const bf16*)(ws + aoff), (const bf16*)(ws + boff), KK, alpha, inp[nv::I_FING], (int)blockIdx.x, F.tid, F.lane, F.wave, outp + OUTO.yp);
                break; }
#endif
            pg8::EpiResid E{inp[nv::I_XP], inp[nv::I_XS], (float*)(ws + w.xf), (pg8::bf16_t*)(ws + w.xb), (float*)(ws + w.ssq), alpha, ph == PH_DOWN1 ? 1 : 0};
            pg8::gemm_phase<pg8::EpiResid, pg8::StaticOrder, true, MK_SP2_SINGLE>(F.lds + RING_OFF, g, S, E, F.tid);
            for (int tl = (int)blockIdx.x; tl < 256; tl += F.G) sg::small_gemm<0>(F.lds, ws, (const bf16*)(ws + aoff), (const bf16*)(ws + boff), KK, alpha, nullptr, tl, F.tid, F.lane, F.wave);
#ifdef MK_X2_SMALL
            for (int tl = (int)blockIdx.x; tl < 256; tl += F.G) sg::small_gemm<0>(F.lds, ws, (const bf16*)(ws + aoff), (const bf16*)(ws + boff), KK, 0.f, nullptr, tl, F.tid, F.lane, F.wave);
#endif
            break; }
#endif
#ifndef MK_NO_WIN
        case PH_WIN: {
            pg8::Gemm g{(const pg8::bf16_t*)(ws + w.xb), (const pg8::bf16_t*)(ws + w.win), MROWS, WIN_N, DM}; pg8::StaticOrder S; S.init(MROWS, WIN_N, F.G, (int)blockIdx.x);
            PG8_LAS float* rsl = (PG8_LAS float*)(F.lds + RSL_OFF); pg8::rstd_to_lds(rsl, SSQ, S, F.tid);
            pg8::EpiZL E{(pg8::bf16_t*)(ws + w.r1), (float*)(ws + w.zg), rsl};
            pg8::gemm_phase<pg8::EpiZL, pg8::StaticOrder, true, true>(F.lds + RING_OFF, g, S, E, F.tid);
            break; }
#endif
#ifndef MK_NO_Q
        case PH_Q: {
            pg8::Gemm g{(const pg8::bf16_t*)(ws + w.xb), (const pg8::bf16_t*)(ws + w.wq), PROWS, DM, DM}; pg8::StaticOrder S; S.init(PROWS, DM, F.G, (int)blockIdx.x);
            pg8::EpiQ E{(pg8::bf16_t*)(ws + w.q), SSQ};
            pg8::gemm_phase<pg8::EpiQ, pg8::StaticOrder, true, MK_SP2_SINGLE>(F.lds + RING_OFF, g, S, E, F.tid);
            for (int tl = (int)blockIdx.x; tl < 256; tl += F.G) sg::small_gemm<1>(F.lds, ws, (const bf16*)(ws + w.xb), (const bf16*)(ws + w.wq), DM, 1.f, nullptr, tl, F.tid, F.lane, F.wave);
            break; }
#endif
#ifndef MK_NO_MIX
        case PH_MIX_LOCAL: case PH_MIX_SCAN: case PH_MIX_OUT: {
            mx::Ctx c{(const bf16*)(ws + w.r1), (const float*)(ws + w.zg), ws, inp, outp, F.lds, F.tid, F.lane, F.wave, 0};
            if (ph == PH_MIX_LOCAL) m2::phase_local(c, (int)blockIdx.x, F.G); else if (ph == PH_MIX_SCAN) mx::scan_phase(c, (int)blockIdx.x * 512 + F.tid, F.G * 512); else m2::phase_out(c, (int)blockIdx.x, F.G);
            break; }
#endif
#ifndef MK_NO_ATTN
        case PH_ATTN: {
            mx::Ctx c{(const bf16*)(ws + w.r1), (const float*)(ws + w.zg), ws, inp, outp, F.lds, F.tid, F.lane, F.wave, 0};
            xa::phase_attn(c, (int)blockIdx.x, F.G);
            break; }
#endif
#ifndef MK_NO_FIN
        case PH_FINAL: p_final(F, inp, outp, ws); break;
#endif
        default: break;
        }
        if (pi + 1 < args.ph_hi) { XcdBarrier b2 = bar; asm volatile("" : "+s"(b2.bar), "+s"(b2.x)); xcd_barrier(b2);
#ifdef MK_X2_BARRIER
            xcd_barrier(b2);
#endif
        }
    }
}

struct HostState { int grid; Args a; };
static void launch_mk(HostState& hs, int lo, int hi, int& li, hipStream_t stream) {
    hs.a.ph_lo = lo; hs.a.ph_hi = hi; hs.a.li = li++;
    hipLaunchKernelGGL(mk_fwd, dim3(hs.grid), dim3(NWAVES * 64), LDS_BYTES, stream, hs.a);
    const hipError_t le = hipPeekAtLastError(); if (le != hipSuccess) fprintf(stderr, "kernel_launch: launch [%d,%d) failed: %s\n", lo, hi, hipGetErrorName(le));
}
extern "C" void kernel_launch(void* const* d_in, const int* in_sizes, int n_in, void* d_out, int out_size, void* d_ws, size_t ws_size, hipStream_t stream) {
    static HostState hs; static int ready = 0;
    if (ready == 0) {
        if (n_in != 33 || (long)out_size != OUTO.total || ws_size < WSO.total) { fprintf(stderr, "kernel_launch: unexpected n_in %d / out_size %d / ws %zu (need %zu)\n", n_in, out_size, ws_size, (size_t)WSO.total); ready = -1; return; }
        int dev = 0, cus = 0;
        if (hipGetDevice(&dev) != hipSuccess || hipDeviceGetAttribute(&cus, hipDeviceAttributeMultiprocessorCount, dev) != hipSuccess) { ready = -1; return; }
        if (hipFuncSetAttribute((const void*)mk_fwd, hipFuncAttributeMaxDynamicSharedMemorySize, LDS_BYTES) != hipSuccess) { fprintf(stderr, "kernel_launch: hipFuncSetAttribute failed\n"); ready = -1; return; }
        (void)hipGetLastError();
        hs.grid = cus; ready = 1;
    }
    if (ready < 0) return;
    memset(&hs.a, 0, sizeof(hs.a));
    for (int i = 0; i < 33; ++i) hs.a.in[i] = (const float*)d_in[i];
    hs.a.out = (float*)d_out; hs.a.ws = (unsigned char*)d_ws;
    if (hipMemsetAsync((char*)d_ws + WSO.ctl, 0, CTL_ZERO_BYTES, stream) != hipSuccess) { fprintf(stderr, "kernel_launch: memset failed\n"); return; }
    int li = 0;
    MK_PROGRAM
}
```

```cpp
#include <hip/hip_runtime.h>
#include <cstdio>
#include <cstdint>
#include <cstring>
#include <cmath>
#ifdef __HIPCC__
#define SHD __host__ __device__ __forceinline__
#else
#define SHD inline
#include <cmath>
#endif
namespace nv {
typedef unsigned short bf16_t;
SHD float bf2f(bf16_t v) { union { unsigned u; float f; } x; x.u = (unsigned)v << 16; return x.f; }
SHD bf16_t f2bf(float f) { union { unsigned u; float f; } x; x.f = f; return (bf16_t)((x.u + 0x7fffu + ((x.u >> 16) & 1u)) >> 16); }
struct Dm { int D, B, T, SB, ST, MLH, DK, DV, GH, GDK, GDV, RANK, NMEM, XH, XDH, FF, DIN, pad; float eps, tau; };
SHD long rows_of(const Dm& d) { return (long)d.B * d.T + (long)d.SB * d.ST; }
constexpr int ZGP = 32, NSSQ = 16;
}

namespace nv {
struct Ws {
  size_t ctl, wgu1, wd1, win, wout, wq, wkv, wo, wgu2, wd2, ssq, mssq, memb, kb, vt, xb, xf, zg, r1, r2, ymix, total;
  size_t q, o, hr, pn, al, fd, iw, mt, s, st2;
  size_t cloc, nloc, mloc, sloc, gdec, cst, nst, mst, sst;
};
constexpr int WIN_NPAD = 256;
struct Carver { size_t c; constexpr size_t al(size_t bytes) { const size_t p = c; c += (bytes + 255) / 256 * 256; return p; } };
constexpr Ws carve_ws(const Dm& d) { Ws w{}; const size_t M = (size_t)d.B * d.T + (size_t)d.SB * d.ST; Carver a{0};
  const size_t ZWc = (size_t)(2 * d.MLH * d.DK + 2 * d.MLH * d.DV + 2 * d.GH * d.GDK + 2 * d.GH * d.GDV); const size_t D = d.D, FF = d.FF; const size_t winN = (ZWc + ZGP + WIN_NPAD - 1) / WIN_NPAD * WIN_NPAD;
  w.ctl = a.al(1 << 20); w.wgu1 = a.al(2 * FF * D * 2); w.wd1 = a.al(D * FF * 2); w.win = a.al(winN * D * 2); w.wout = a.al(D * D * 2); w.wq = a.al(D * D * 2); w.wkv = a.al(2 * D * D * 2); w.wo = a.al(D * D * 2); w.wgu2 = a.al(2 * FF * D * 2); w.wd2 = a.al(D * FF * 2);
  w.ssq = a.al(M * NSSQ * 4); w.mssq = a.al((size_t)d.B * d.NMEM * 4); w.memb = a.al((size_t)d.B * d.NMEM * D * 2); w.kb = a.al((size_t)d.B * d.NMEM * D * 2); w.vt = a.al((size_t)d.B * d.NMEM * D * 2);
  w.xb = a.al(M * D * 2); w.xf = a.al(M * D * 4); w.zg = a.al(M * ZGP * 4);
  size_t r1 = M * FF * 2; if (M * ZWc * 2 > r1) r1 = M * ZWc * 2; if (2 * M * D * 2 + 256 > r1) r1 = 2 * M * D * 2 + 256; w.r1 = a.al(r1); w.q = w.r1; w.o = w.r1 + (M * D * 2 + 255) / 256 * 256;
  const size_t NCH = (size_t)d.B * (d.T / 64 > 0 ? d.T / 64 : 1);
  const size_t r2s = a.c; w.r2 = a.c;
  w.cloc = a.al(NCH * d.MLH * d.DK * d.DV * 4); w.sloc = a.al(NCH * d.GH * d.GDK * d.GDV * 4); w.cst = a.al(NCH * d.MLH * d.DK * d.DV * 2); w.sst = a.al(NCH * d.GH * d.GDK * d.GDV * 2);
  w.nloc = a.al(NCH * d.MLH * d.DK * 4); w.mloc = a.al(NCH * d.MLH * 2 * 4); w.gdec = a.al(NCH * d.GH * d.GDK * 4); w.nst = a.al(NCH * d.MLH * d.DK * 4); w.mst = a.al(NCH * d.MLH * 4);
  const size_t opt_end = a.c;
  a.c = r2s; w.hr = a.al(M * D * 4); w.pn = a.al(M * d.MLH * d.DK * 4); w.al = a.al(M * d.GH * d.GDK * 4); w.fd = a.al(M * d.MLH * 4); w.iw = a.al(M * d.MLH * 4); w.mt = a.al(M * d.MLH * 4); const size_t nv1_end = a.c;
  a.c = r2s; w.s = a.al(M * d.XH * d.NMEM * 4); w.st2 = a.al(M * d.XH * 2 * 4); const size_t nv2_end = a.c;
  a.c = opt_end > nv1_end ? opt_end : nv1_end; if (nv2_end > a.c) a.c = nv2_end;
  w.ymix = a.al(M * D * 2); w.total = a.c; return w; }
struct OutOff { long yp, ys, mk, mv, cp, np, mp, sp, cs, ns, ms, ss, total; };
constexpr OutOff out_off(const Dm& d) { OutOff o{}; long c = 0; o.yp = c; c += (long)d.B * d.T * d.D; o.ys = c; c += (long)d.SB * d.ST * d.D; o.mk = c; c += (long)d.B * d.NMEM * d.D; o.mv = c; c += (long)d.B * d.NMEM * d.D;
  o.cp = c; c += (long)d.B * d.MLH * d.DK * d.DV; o.np = c; c += (long)d.B * d.MLH * d.DK; o.mp = c; c += (long)d.B * d.MLH; o.sp = c; c += (long)d.B * d.GH * d.GDK * d.GDV;
  o.cs = c; c += (long)d.SB * d.MLH * d.DK * d.DV; o.ns = c; c += (long)d.SB * d.MLH * d.DK; o.ms = c; c += (long)d.SB * d.MLH; o.ss = c; c += (long)d.SB * d.GH * d.GDK * d.GDV; o.total = c; return o; }
enum In { I_XP, I_XS, I_MEM, I_CK, I_CV, I_SC, I_SN, I_SM, I_SS, I_F1G, I_F1WG, I_F1WU, I_F1WD, I_MIXG, I_WIN, I_BI, I_BF, I_MLOG, I_WA2, I_BA, I_GLOG, I_WOUT, I_XG, I_MEMG, I_WQ, I_WK, I_WV, I_WO, I_F2G, I_F2WG, I_F2WU, I_F2WD, I_FING };
}
__device__ __forceinline__ int my_lane() { int l = (int)__builtin_amdgcn_mbcnt_hi(~0u, __builtin_amdgcn_mbcnt_lo(~0u, 0u)); asm volatile("" : "+v"(l)); return l; }
__device__ __forceinline__ float shx(float v, int mask) { return __builtin_bit_cast(float, __builtin_amdgcn_ds_bpermute((my_lane() ^ mask) << 2, __builtin_bit_cast(int, v))); }
__device__ __forceinline__ float shl(float v, int src) { return __builtin_bit_cast(float, __builtin_amdgcn_ds_bpermute(src << 2, __builtin_bit_cast(int, v))); }
#ifndef MK_WGM
#define MK_WGM 8
#endif
namespace pg8 {
#define PG8_LAS __attribute__((address_space(3)))
typedef unsigned short bf16_t;
typedef short bf16x8 __attribute__((ext_vector_type(8)));
typedef float f32x4 __attribute__((ext_vector_type(4)));
typedef unsigned u32x4 __attribute__((ext_vector_type(4)));
constexpr int BM = 256, BK = 64, HALF = 128, HTB = HALF * BK * 2  , STAGE_BYTES = 8 * HTB, NXCD = 8, WGM = MK_WGM;

__host__ __device__ __forceinline__ int lds_byte(int r, int c) { const int st = (r >> 4) * 2 + (c >> 5), rr = r & 15, cc = c & 31, ob = rr * 64 + cc * 2; return st * 1024 + (ob ^ (((ob >> 9) & 1) << 5)); }
__host__ __device__ __forceinline__ void stage_rc(int b, int& R, int& C) { const int st = b / 1024, sb = b % 1024, swz = sb ^ (((sb >> 9) & 1) << 5); R = (st >> 1) * 16 + swz / 64; C = (st & 1) * 32 + (swz % 64) / 2; }
__host__ __device__ __forceinline__ int perm32(int rho) { const int n = rho >> 4, i = rho & 15; return 8 * (i >> 2) + 4 * n + (i & 3); }

struct Unit { int pm, pn, idx; };
struct Gemm { const bf16_t* A; const bf16_t* Bt; int M, N, K; };

struct StaticOrder {
    int nM, nN, nwg, G, c;
    __host__ __device__ void init(int M, int N, int G_, int c_) { nM = M / BM; nN = N / BM; nwg = nM * nN; G = G_; c = c_; }
    __host__ __device__ bool next(int i, Unit& u) const {
        const long L = (long)i * G + c; if (L >= nwg) return false;
        int wgid = (int)L; { const int q = nwg / NXCD, r = nwg % NXCD, xcd = wgid % NXCD, off = wgid / NXCD; wgid = (xcd < r ? xcd * (q + 1) : r * (q + 1) + (xcd - r) * q) + off; }
        const int nig = WGM * nN, gid = wgid / nig, fm = gid * WGM, gsz = (nM - fm) < WGM ? (nM - fm) : WGM;
        u.pm = fm + ((wgid % nig) % gsz); u.pn = (wgid % nig) / gsz; u.idx = i; return true;
    }
    __device__ __forceinline__ void a_ready(const Unit&) const {}
    __device__ __forceinline__ void done(const Unit&) const {}
};

__device__ __forceinline__ unsigned cvt_pk_bf16(float lo, float hi) { unsigned r; asm volatile("v_cvt_pk_bf16_f32 %0, %1, %2" : "=v"(r) : "v"(lo), "v"(hi)); return r; }
template <class Epi, class Sched, bool ALIGN_EPI = false, bool SP2 = false>
__device__ __forceinline__ void gemm_phase(PG8_LAS unsigned char* lds, const Gemm g, const Sched& S, const Epi& E, const int tid) {
    const int wid = __builtin_amdgcn_readfirstlane(tid >> 6), lane = tid & 63, wr = wid >> 2, wc = wid & 3, fr = lane & 15, fq = lane >> 4;
    const int K = g.K, nt = K / BK;
    unsigned voffA[2], voffB[2];
#pragma unroll
    for (int i = 0; i < 2; ++i) { int R, C; stage_rc(tid * 16 + i * 8192, R, C); const int Rb = Epi::PERM ? ((R & ~31) + perm32(R & 31)) : R;
        voffA[i] = (unsigned)(R * K + C) * 2u; voffB[i] = (unsigned)(Rb * K + C) * 2u; }
    const size_t kstep = (size_t)(BK * 2);
    const size_t hstep = (size_t)HALF * K * 2;
    const size_t tstep = 2 * hstep;
    const unsigned ldsw = (unsigned)wid * 1024u;
    const int aoff = lds_byte(wr * 64 + fr, fq * 8), boff = lds_byte(wc * 32 + fr, fq * 8);
#define PG8_SA(b, h) (((b) * 2 + (h)) * HTB)
#define PG8_SB(b, h) ((4 + (b) * 2 + (h)) * HTB)
#define PG8_STAGE(bufoff, gbase, voff) do { _Pragma("unroll") for (int _i = 0; _i < 2; ++_i) \
        __builtin_amdgcn_global_load_lds((const unsigned*)((const char*)(gbase) + (voff)[_i]), (PG8_LAS unsigned*)(lds + (bufoff) + ldsw + _i * 8192), 16, 0, 0); } while (0)
#define PG8_LDA(dst, b, h) do { _Pragma("unroll") for (int m = 0; m < 4; ++m) _Pragma("unroll") for (int k = 0; k < 2; ++k) dst[m][k] = *(const PG8_LAS bf16x8*)(lds + PG8_SA(b, h) + aoff + m * 2048 + k * 1024); } while (0)
#define PG8_LDB(dst, b, h) do { _Pragma("unroll") for (int n = 0; n < 2; ++n) _Pragma("unroll") for (int k = 0; k < 2; ++k) dst[n][k] = *(const PG8_LAS bf16x8*)(lds + PG8_SB(b, h) + boff + n * 2048 + k * 1024); } while (0)
#define PG8_MMA(ai, bj, At, Bt) do { __builtin_amdgcn_s_setprio(1); _Pragma("unroll") for (int m = 0; m < 4; ++m) _Pragma("unroll") for (int n = 0; n < 2; ++n) _Pragma("unroll") for (int k = 0; k < 2; ++k) \
        acc[ai][bj][m][n] = __builtin_amdgcn_mfma_f32_16x16x32_bf16(Bt[n][k], At[m][k], acc[ai][bj][m][n], 0, 0, 0); __builtin_amdgcn_s_setprio(0); } while (0)
#define PG8_WAIT_V(n) asm volatile("s_waitcnt vmcnt(" #n ")" ::: "memory")
#define PG8_WAIT_L(n) asm volatile("s_waitcnt lgkmcnt(" #n ")" ::: "memory")
#define PG8_BAR __builtin_amdgcn_s_barrier()
#define PG8_SCHED __builtin_amdgcn_sched_barrier(0)
    Unit cur, nxt; int ui = 0;
    if (!S.next(0, cur)) return;
    f32x4 acc[2][2][4][2];
#pragma unroll
    for (int a = 0; a < 2; ++a)
#pragma unroll
        for (int b = 0; b < 2; ++b)
#pragma unroll
            for (int m = 0; m < 4; ++m)
#pragma unroll
                for (int n = 0; n < 2; ++n) acc[a][b][m][n] = (f32x4){0.f, 0.f, 0.f, 0.f};
    bf16x8 At[4][2], B0[2][2], B1[2][2];
    const char* cA = (const char*)g.A + (size_t)cur.pm * tstep; const char* cB = (const char*)g.Bt + (size_t)cur.pn * tstep;
    S.a_ready(cur);
    if constexpr (SP2) {
        PG8_STAGE(PG8_SB(0, 0), cB, voffB); PG8_STAGE(PG8_SB(0, 1), cB + hstep, voffB); PG8_STAGE(PG8_SA(0, 0), cA, voffA); PG8_STAGE(PG8_SA(0, 1), cA + hstep, voffA);
        if (wr == 1) PG8_BAR;
        PG8_WAIT_V(2); PG8_BAR;
        PG8_STAGE(PG8_SB(1, 0), cB + kstep, voffB); PG8_STAGE(PG8_SA(1, 0), cA + kstep, voffA); PG8_STAGE(PG8_SB(1, 1), cB + hstep + kstep, voffB);
        PG8_WAIT_V(6); PG8_BAR;
    } else {
        PG8_STAGE(PG8_SB(0, 0), cB, voffB); PG8_STAGE(PG8_SA(0, 0), cA, voffA); PG8_STAGE(PG8_SB(0, 1), cB + hstep, voffB); PG8_STAGE(PG8_SA(0, 1), cA + hstep, voffA);
        if (wr == 1) PG8_BAR;
        PG8_WAIT_V(4); PG8_BAR;
        PG8_STAGE(PG8_SB(1, 0), cB + kstep, voffB); PG8_STAGE(PG8_SA(1, 0), cA + kstep, voffA); PG8_STAGE(PG8_SB(1, 1), cB + hstep + kstep, voffB);
        PG8_WAIT_V(6); PG8_BAR;
    }
    for (;;) {
        const bool has_next = S.next(ui + 1, nxt);
        const char* nA = has_next ? (const char*)g.A + (size_t)nxt.pm * tstep : cA; const char* nB = has_next ? (const char*)g.Bt + (size_t)nxt.pn * tstep : cB;
        for (int t = 0; t < nt; t += 2) {
            const bool last = (t == nt - 2);
            const char* a1 = cA + (size_t)(t + 1) * kstep;
            const char* a2 = last ? nA : cA + (size_t)(t + 2) * kstep; const char* b2 = last ? nB : cB + (size_t)(t + 2) * kstep;
            const char* a3 = a2 + kstep; const char* b3 = b2 + kstep;
            if (last && has_next) S.a_ready(nxt);
            if constexpr (SP2) {
            PG8_LDB(B0, 0, 0); PG8_LDB(B1, 0, 1); PG8_SCHED; PG8_LDA(At, 0, 0); PG8_STAGE(PG8_SA(1, 1), a1 + hstep, voffA);
            PG8_WAIT_V(8); PG8_WAIT_L(0); PG8_BAR; PG8_MMA(0, 0, At, B0); PG8_MMA(0, 1, At, B1); PG8_BAR; PG8_SCHED;
            PG8_LDA(At, 0, 1); PG8_STAGE(PG8_SB(0, 0), b2, voffB); PG8_STAGE(PG8_SB(0, 1), b2 + hstep, voffB); PG8_STAGE(PG8_SA(0, 0), a2, voffA);
            PG8_WAIT_V(8); PG8_WAIT_L(0); PG8_BAR; PG8_MMA(1, 0, At, B0); PG8_MMA(1, 1, At, B1); PG8_BAR; PG8_SCHED;
            PG8_LDB(B0, 1, 0); PG8_LDB(B1, 1, 1); PG8_SCHED; PG8_LDA(At, 1, 0); PG8_STAGE(PG8_SA(0, 1), a2 + hstep, voffA);
            PG8_WAIT_V(8); PG8_WAIT_L(0); PG8_BAR; PG8_MMA(0, 0, At, B0); PG8_MMA(0, 1, At, B1); PG8_BAR; PG8_SCHED;
            PG8_LDA(At, 1, 1); PG8_STAGE(PG8_SB(1, 0), b3, voffB); PG8_STAGE(PG8_SB(1, 1), b3 + hstep, voffB); PG8_STAGE(PG8_SA(1, 0), a3, voffA);
            PG8_WAIT_V(8); PG8_WAIT_L(0); PG8_BAR; PG8_MMA(1, 0, At, B0); PG8_MMA(1, 1, At, B1); PG8_BAR; PG8_SCHED;
            } else {
            PG8_LDB(B0, 0, 0); PG8_SCHED; PG8_LDA(At, 0, 0); PG8_STAGE(PG8_SA(1, 1), a1 + hstep, voffA);
            PG8_WAIT_L(8); PG8_BAR; PG8_WAIT_L(0); PG8_MMA(0, 0, At, B0); PG8_BAR; PG8_SCHED;
            PG8_LDB(B1, 0, 1); PG8_STAGE(PG8_SB(0, 0), b2, voffB);
            PG8_BAR; PG8_WAIT_L(0); PG8_MMA(0, 1, At, B1); PG8_BAR;
            PG8_LDA(At, 0, 1); PG8_STAGE(PG8_SA(0, 0), a2, voffA);
            PG8_BAR; PG8_WAIT_L(0); PG8_MMA(1, 0, At, B0); PG8_BAR; PG8_SCHED;
            PG8_STAGE(PG8_SB(0, 1), b2 + hstep, voffB);
            PG8_WAIT_V(6); PG8_BAR; PG8_MMA(1, 1, At, B1); PG8_BAR;
            PG8_LDB(B0, 1, 0); PG8_SCHED; PG8_LDA(At, 1, 0); PG8_STAGE(PG8_SA(0, 1), a2 + hstep, voffA);
            PG8_WAIT_L(8); PG8_BAR; PG8_WAIT_L(0); PG8_MMA(0, 0, At, B0); PG8_BAR; PG8_SCHED;
            PG8_LDB(B1, 1, 1); PG8_STAGE(PG8_SB(1, 0), b3, voffB);
            PG8_BAR; PG8_WAIT_L(0); PG8_MMA(0, 1, At, B1); PG8_BAR;
            PG8_LDA(At, 1, 1); PG8_STAGE(PG8_SA(1, 0), a3, voffA);
            PG8_BAR; PG8_WAIT_L(0); PG8_MMA(1, 0, At, B0); PG8_BAR; PG8_SCHED;
            PG8_STAGE(PG8_SB(1, 1), b3 + hstep, voffB);
            PG8_WAIT_V(6); PG8_BAR; PG8_MMA(1, 1, At, B1); PG8_BAR;
            }
        }
        if constexpr (ALIGN_EPI) { if (wr == 0) PG8_BAR; }
        if constexpr (!Epi::AFTER_DRAIN) { E(acc, cur, wr, wc, fr, fq); S.done(cur); }
        if (!has_next) break;
#pragma unroll
        for (int a = 0; a < 2; ++a)
#pragma unroll
            for (int b = 0; b < 2; ++b)
#pragma unroll
                for (int m = 0; m < 4; ++m)
#pragma unroll
                    for (int n = 0; n < 2; ++n) acc[a][b][m][n] = (f32x4){0.f, 0.f, 0.f, 0.f};
        cur = nxt; cA = nA; cB = nB; ++ui;
        if constexpr (ALIGN_EPI) { if (wr == 1) PG8_BAR; }
    }
    PG8_WAIT_V(0);
    if constexpr (!ALIGN_EPI) { if (wr == 0) PG8_BAR; }
    PG8_BAR;
    if constexpr (Epi::AFTER_DRAIN) { E.fused(acc, cur, wr, wc, fr, fq, lds, wid, lane); S.done(cur); }
#undef PG8_SA
#undef PG8_SB
#undef PG8_STAGE
#undef PG8_LDA
#undef PG8_LDB
#undef PG8_MMA
#undef PG8_WAIT_V
#undef PG8_WAIT_L
#undef PG8_BAR
#undef PG8_SCHED
}
}
namespace pg8 {
typedef unsigned u32x2 __attribute__((ext_vector_type(2)));
constexpr int DMODEL = 1024, NSSQ = 16;
constexpr float RMS_EPS = 1e-6f;
__device__ __forceinline__ float row_rstd(const float* ssq, int row, int fq) {
    const f32x4 v = *(const f32x4*)(ssq + (size_t)row * NSSQ + 4 * fq); float s = (v[0] + v[1]) + (v[2] + v[3]); s += shx(s, 16); s += shx(s, 32);
    return rsqrtf(s * (1.0f / DMODEL) + RMS_EPS); }
__device__ __forceinline__ float silu_f(float g) { return g * __builtin_amdgcn_rcpf(1.0f + __expf(-g)); }
struct EpiSwiglu { static constexpr bool PERM = false, AFTER_DRAIN = false;
    bf16_t* H; const float* ssq; int ldh, pad;
    __device__ __forceinline__ void operator()(const f32x4 (&acc)[2][2][4][2], const Unit& u, int wr, int wc, int fr, int fq) const {
#pragma unroll
        for (int ai = 0; ai < 2; ++ai)
#pragma unroll
            for (int m = 0; m < 4; ++m) { const int row = u.pm * BM + ai * HALF + wr * 64 + m * 16 + fr; const float rs = row_rstd(ssq, row, fq);
#pragma unroll
                for (int bj = 0; bj < 2; ++bj) { const f32x4 g = acc[ai][bj][m][0] * rs, up = acc[ai][bj][m][1] * rs; u32x2 w;
                    w.x = cvt_pk_bf16(silu_f(g[0]) * up[0], silu_f(g[1]) * up[1]); w.y = cvt_pk_bf16(silu_f(g[2]) * up[2], silu_f(g[3]) * up[3]);
                    *(u32x2*)(H + (size_t)row * ldh + u.pn * 128 + bj * 64 + wc * 16 + 4 * fq) = w; } asm volatile("" ::: "memory"); }
    }
};
struct EpiResid { static constexpr bool PERM = false, AFTER_DRAIN = false;
    const float* xp; const float* xs; float* XF; bf16_t* XB; float* ssq; float alpha; int first;
    __device__ __forceinline__ void operator()(const f32x4 (&acc)[2][2][4][2], const Unit& u, int wr, int wc, int fr, int fq) const {
#pragma unroll
        for (int ai = 0; ai < 2; ++ai) { u32x2 bw[4][2][2];
#pragma unroll
            for (int m = 0; m < 4; ++m)
#pragma unroll
                for (int bj = 0; bj < 2; ++bj)
#pragma unroll
                    for (int n = 0; n < 2; ++n) bw[m][bj][n] = *(const u32x2*)(XB + (size_t)(u.pm * BM + ai * HALF + wr * 64 + m * 16 + fr) * DMODEL + u.pn * BM + bj * HALF + wc * 32 + n * 16 + 4 * fq);
#pragma unroll
            for (int m = 0; m < 4; ++m) { const int row = u.pm * BM + ai * HALF + wr * 64 + m * 16 + fr; float q = 0.f;
#pragma unroll
                for (int bj = 0; bj < 2; ++bj)
#pragma unroll
                    for (int n = 0; n < 2; ++n) { const int col = u.pn * BM + bj * HALF + wc * 32 + n * 16 + 4 * fq; const u32x2 w0 = bw[m][bj][n];
                        const f32x4 b = {__uint_as_float(w0.x << 16), __uint_as_float(w0.x & 0xffff0000u), __uint_as_float(w0.y << 16), __uint_as_float(w0.y & 0xffff0000u)};
                        const f32x4 o = b + acc[ai][bj][m][n] * alpha;
                        u32x2 w; w.x = cvt_pk_bf16(o[0], o[1]); w.y = cvt_pk_bf16(o[2], o[3]); *(u32x2*)(XB + (size_t)row * DMODEL + col) = w;
                        q += (o[0] * o[0] + o[1] * o[1]) + (o[2] * o[2] + o[3] * o[3]); }
                q += shx(q, 16); q += shx(q, 32);
                if (fq == 0) ssq[(size_t)row * NSSQ + u.pn * 4 + wc] = q; }
            asm volatile("" ::: "memory"); }
    }
};
struct EpiZ { static constexpr bool PERM = true, AFTER_DRAIN = false;
    bf16_t* Z; float* ZG; const float* ssq;
    __device__ __forceinline__ void operator()(const f32x4 (&acc)[2][2][4][2], const Unit& u, int wr, int wc, int fr, int fq) const {
        constexpr int ZW = 3584, ZGP = 32;
#pragma unroll
        for (int ai = 0; ai < 2; ++ai)
#pragma unroll
            for (int m = 0; m < 4; ++m) { const int row = u.pm * BM + ai * HALF + wr * 64 + m * 16 + fr; const float rs = row_rstd(ssq, row, fq);
                if (u.pn < ZW / BM) {
#pragma unroll
                    for (int bj = 0; bj < 2; ++bj) { const f32x4 v0 = acc[ai][bj][m][0] * rs, v1 = acc[ai][bj][m][1] * rs; u32x4 w; w.x = cvt_pk_bf16(v0[0], v0[1]); w.y = cvt_pk_bf16(v0[2], v0[3]); w.z = cvt_pk_bf16(v1[0], v1[1]); w.w = cvt_pk_bf16(v1[2], v1[3]);
                        *(u32x4*)(Z + (size_t)row * ZW + u.pn * BM + bj * HALF + wc * 32 + 8 * fq) = w; }
                } else if (wc == 0) { *(f32x4*)(ZG + (size_t)row * ZGP + 8 * fq) = acc[ai][0][m][0] * rs; *(f32x4*)(ZG + (size_t)row * ZGP + 8 * fq + 4) = acc[ai][0][m][1] * rs; } asm volatile("" ::: "memory"); }
    }
};
struct EpiQ { static constexpr bool PERM = true, AFTER_DRAIN = false;
    bf16_t* Q; const float* ssq;
    __device__ __forceinline__ void operator()(const f32x4 (&acc)[2][2][4][2], const Unit& u, int wr, int wc, int fr, int fq) const {
#pragma unroll
        for (int ai = 0; ai < 2; ++ai)
#pragma unroll
            for (int m = 0; m < 4; ++m) { const int row = u.pm * BM + ai * HALF + wr * 64 + m * 16 + fr; const float rs = row_rstd(ssq, row, fq);
#pragma unroll
                for (int bj = 0; bj < 2; ++bj) { const f32x4 v0 = acc[ai][bj][m][0] * rs, v1 = acc[ai][bj][m][1] * rs; u32x4 w; w.x = cvt_pk_bf16(v0[0], v0[1]); w.y = cvt_pk_bf16(v0[2], v0[3]); w.z = cvt_pk_bf16(v1[0], v1[1]); w.w = cvt_pk_bf16(v1[2], v1[3]);
                    *(u32x4*)(Q + (size_t)row * DMODEL + u.pn * BM + bj * HALF + wc * 32 + 8 * fq) = w; } asm volatile("" ::: "memory"); }
    }
};
struct EpiKV { static constexpr bool PERM = false, AFTER_DRAIN = false;
    float* outk; float* outv; bf16_t* KB; bf16_t* VT; const float* mssq;
    __device__ __forceinline__ void operator()(const f32x4 (&acc)[2][2][4][2], const Unit& u, int wr, int wc, int fr, int fq) const {
#pragma unroll
        for (int ai = 0; ai < 2; ++ai)
#pragma unroll
            for (int m = 0; m < 4; ++m) { const int row = u.pm * BM + ai * HALF + wr * 64 + m * 16 + fr; const float rs = rsqrtf(mssq[row] * (1.0f / DMODEL) + RMS_EPS);
#pragma unroll
                for (int bj = 0; bj < 2; ++bj)
#pragma unroll
                    for (int n = 0; n < 2; ++n) { const int cl = bj * HALF + wc * 32 + n * 16 + 4 * fq; const f32x4 o = acc[ai][bj][m][n] * rs;
                        if (u.pn < 4) { const int col = u.pn * BM + cl; __builtin_nontemporal_store(o, (f32x4*)(outk + (size_t)row * DMODEL + col)); u32x2 w; w.x = cvt_pk_bf16(o[0], o[1]); w.y = cvt_pk_bf16(o[2], o[3]); *(u32x2*)(KB + (size_t)row * DMODEL + col) = w; }
                        else { const int h = u.pn - 4, col = h * BM + cl; __builtin_nontemporal_store(o, (f32x4*)(outv + (size_t)row * DMODEL + col)); const int b = row >> 8, mm = row & 255; bf16_t* vt = VT + ((size_t)(b * 4 + h) * 256 + cl) * 256 + mm;
                            const unsigned w0 = cvt_pk_bf16(o[0], o[1]), w1 = cvt_pk_bf16(o[2], o[3]); vt[0] = (bf16_t)(w0 & 0xffffu); vt[256] = (bf16_t)(w0 >> 16); vt[512] = (bf16_t)(w1 & 0xffffu); vt[768] = (bf16_t)(w1 >> 16); } } asm volatile("" ::: "memory"); }
    }
};
template <class Sched> __device__ __forceinline__ void rstd_to_lds(PG8_LAS float* rsl, const float* ssq, const Sched& S, int tid) {
    Unit u;
    for (int i = 0; i < 8; ++i) { if (!S.next(i, u)) break;
        if (tid < 256) { const int row = u.pm * BM + tid; const f32x4* sp = (const f32x4*)(ssq + (size_t)row * NSSQ); const f32x4 s0 = sp[0], s1 = sp[1], s2 = sp[2], s3 = sp[3];
            const float ss = ((s0[0] + s0[1]) + (s0[2] + s0[3])) + ((s1[0] + s1[1]) + (s1[2] + s1[3])) + ((s2[0] + s2[1]) + (s2[2] + s2[3])) + ((s3[0] + s3[1]) + (s3[2] + s3[3]));
            rsl[i * 256 + tid] = rsqrtf(ss * (1.0f / DMODEL) + RMS_EPS); } }
    __syncthreads();
}
struct EpiSwigluL { static constexpr bool PERM = false, AFTER_DRAIN = false;
    bf16_t* H; const PG8_LAS float* rsl; int ldh, pad;
    __device__ __forceinline__ void operator()(const f32x4 (&acc)[2][2][4][2], const Unit& u, int wr, int wc, int fr, int fq) const {
#pragma unroll
        for (int ai = 0; ai < 2; ++ai)
#pragma unroll
            for (int m = 0; m < 4; ++m) { const int lr = ai * HALF + wr * 64 + m * 16 + fr, row = u.pm * BM + lr; const float rs = rsl[u.idx * 256 + lr];
#pragma unroll
                for (int bj = 0; bj < 2; ++bj) { const f32x4 g = acc[ai][bj][m][0] * rs, up = acc[ai][bj][m][1] * rs; u32x2 w;
                    w.x = cvt_pk_bf16(silu_f(g[0]) * up[0], silu_f(g[1]) * up[1]); w.y = cvt_pk_bf16(silu_f(g[2]) * up[2], silu_f(g[3]) * up[3]);
                    *(u32x2*)(H + (size_t)row * ldh + u.pn * 128 + bj * 64 + wc * 16 + 4 * fq) = w; } }
    }
};
struct EpiZL { static constexpr bool PERM = true, AFTER_DRAIN = false;
    bf16_t* Z; float* ZG; const PG8_LAS float* rsl;
    __device__ __forceinline__ void operator()(const f32x4 (&acc)[2][2][4][2], const Unit& u, int wr, int wc, int fr, int fq) const {
        constexpr int ZW = 3584, ZGP = 32;
#pragma unroll
        for (int ai = 0; ai < 2; ++ai)
#pragma unroll
            for (int m = 0; m < 4; ++m) { const int lr = ai * HALF + wr * 64 + m * 16 + fr, row = u.pm * BM + lr; const float rs = rsl[u.idx * 256 + lr];
                if (u.pn < ZW / BM) {
#pragma unroll
                    for (int bj = 0; bj < 2; ++bj) { const f32x4 v0 = acc[ai][bj][m][0] * rs, v1 = acc[ai][bj][m][1] * rs; u32x4 w; w.x = cvt_pk_bf16(v0[0], v0[1]); w.y = cvt_pk_bf16(v0[2], v0[3]); w.z = cvt_pk_bf16(v1[0], v1[1]); w.w = cvt_pk_bf16(v1[2], v1[3]);
                        *(u32x4*)(Z + (size_t)row * ZW + u.pn * BM + bj * HALF + wc * 32 + 8 * fq) = w; }
                } else if (wc == 0) { *(f32x4*)(ZG + (size_t)row * ZGP + 8 * fq) = acc[ai][0][m][0] * rs; *(f32x4*)(ZG + (size_t)row * ZGP + 8 * fq + 4) = acc[ai][0][m][1] * rs; } }
    }
};
constexpr int CW_PANEL = 65536;
__device__ __forceinline__ void panel_wait(unsigned* cnt, unsigned want, int wid, int lane) {
    if (wid == 0) { unsigned spins = 0;
        while ((unsigned)__builtin_amdgcn_readfirstlane(__hip_atomic_load(cnt, __ATOMIC_RELAXED, __HIP_MEMORY_SCOPE_AGENT)) < want) { __builtin_amdgcn_s_sleep(2); if (++spins > (1u << 22)) break; }
        __builtin_amdgcn_fence(__ATOMIC_ACQUIRE, "agent"); }
    asm volatile("s_waitcnt vmcnt(0) lgkmcnt(0)" ::: "memory"); __builtin_amdgcn_s_barrier(); asm volatile("" ::: "memory");
}
__device__ __forceinline__ float row_rstd_sc1(const float* ssq, int row, int fq) {
    const unsigned long long* p = (const unsigned long long*)(ssq + (size_t)row * NSSQ + 4 * fq); const unsigned long long a = __hip_atomic_load(p, __ATOMIC_RELAXED, __HIP_MEMORY_SCOPE_AGENT), b = __hip_atomic_load(p + 1, __ATOMIC_RELAXED, __HIP_MEMORY_SCOPE_AGENT);
    float s = (__uint_as_float((unsigned)a) + __uint_as_float((unsigned)(a >> 32))) + (__uint_as_float((unsigned)b) + __uint_as_float((unsigned)(b >> 32))); s += shx(s, 16); s += shx(s, 32);
    return rsqrtf(s * (1.0f / DMODEL) + RMS_EPS); }
struct EpiResidFinal { static constexpr bool PERM = false, AFTER_DRAIN = true;
    const bf16_t* XB; float* ssq; float* Y; const float* gfin; unsigned* cnt; float alpha; int pad;
    __device__ __forceinline__ void fused(f32x4 (&acc)[2][2][4][2], const Unit& u, int wr, int wc, int fr, int fq, PG8_LAS unsigned char* lds, int wid, int lane) const {
#pragma unroll
        for (int ai = 0; ai < 2; ++ai) { u32x2 bw[4][2][2];
#pragma unroll
            for (int m = 0; m < 4; ++m)
#pragma unroll
                for (int bj = 0; bj < 2; ++bj)
#pragma unroll
                    for (int n = 0; n < 2; ++n) bw[m][bj][n] = *(const u32x2*)(XB + (size_t)(u.pm * BM + ai * HALF + wr * 64 + m * 16 + fr) * DMODEL + u.pn * BM + bj * HALF + wc * 32 + n * 16 + 4 * fq);
#pragma unroll
            for (int m = 0; m < 4; ++m) { const int row = u.pm * BM + ai * HALF + wr * 64 + m * 16 + fr; float q = 0.f;
#pragma unroll
                for (int bj = 0; bj < 2; ++bj)
#pragma unroll
                    for (int n = 0; n < 2; ++n) { const u32x2 w0 = bw[m][bj][n]; const f32x4 b = {__uint_as_float(w0.x << 16), __uint_as_float(w0.x & 0xffff0000u), __uint_as_float(w0.y << 16), __uint_as_float(w0.y & 0xffff0000u)};
                        const f32x4 o = b + acc[ai][bj][m][n] * alpha; q += (o[0] * o[0] + o[1] * o[1]) + (o[2] * o[2] + o[3] * o[3]);
#ifdef MK_DBG_XB
                        { u32x2 w; w.x = cvt_pk_bf16(o[0], o[1]); w.y = cvt_pk_bf16(o[2], o[3]); *(u32x2*)(const_cast<bf16_t*>(XB) + (size_t)row * DMODEL + u.pn * BM + bj * HALF + wc * 32 + n * 16 + 4 * fq) = w; }
#endif
                        }
                q += shx(q, 16); q += shx(q, 32);
                if (fq == 0) __hip_atomic_store((unsigned*)(ssq + (size_t)row * NSSQ + u.pn * 4 + wc), __float_as_uint(q), __ATOMIC_RELAXED, __HIP_MEMORY_SCOPE_AGENT); }
            asm volatile("" ::: "memory"); }
        asm volatile("s_waitcnt vmcnt(0)" ::: "memory");
        if (lane == 0) __hip_atomic_fetch_add(cnt + 64 * u.pm, 1u, __ATOMIC_RELAXED, __HIP_MEMORY_SCOPE_AGENT);
        panel_wait(cnt + 64 * u.pm, 32u, wid, lane);
        f32x4 gv[2][2];
#pragma unroll
        for (int bj = 0; bj < 2; ++bj)
#pragma unroll
            for (int n = 0; n < 2; ++n) gv[bj][n] = *(const f32x4*)(gfin + u.pn * BM + bj * HALF + wc * 32 + n * 16 + 4 * fq);
#pragma unroll
        for (int ai = 0; ai < 2; ++ai) { u32x2 bw[4][2][2]; float rs[4];
#pragma unroll
            for (int m = 0; m < 4; ++m) { const int row = u.pm * BM + ai * HALF + wr * 64 + m * 16 + fr; rs[m] = row_rstd_sc1(ssq, row, fq);
#pragma unroll
                for (int bj = 0; bj < 2; ++bj)
#pragma unroll
                    for (int n = 0; n < 2; ++n) bw[m][bj][n] = *(const u32x2*)(XB + (size_t)row * DMODEL + u.pn * BM + bj * HALF + wc * 32 + n * 16 + 4 * fq); }
#pragma unroll
            for (int m = 0; m < 4; ++m) { const int row = u.pm * BM + ai * HALF + wr * 64 + m * 16 + fr;
#pragma unroll
                for (int bj = 0; bj < 2; ++bj)
#pragma unroll
                    for (int n = 0; n < 2; ++n) { const u32x2 w0 = bw[m][bj][n]; const f32x4 b = {__uint_as_float(w0.x << 16), __uint_as_float(w0.x & 0xffff0000u), __uint_as_float(w0.y << 16), __uint_as_float(w0.y & 0xffff0000u)};
                        const f32x4 o = b + acc[ai][bj][m][n] * alpha; *(f32x4*)(Y + (size_t)row * DMODEL + u.pn * BM + bj * HALF + wc * 32 + n * 16 + 4 * fq) = o * rs[m] * gv[bj][n]; } }
            asm volatile("" ::: "memory"); }
    }
};
}
#define GAS __attribute__((address_space(1)))
#define LAS __attribute__((address_space(3)))
typedef unsigned short bf16;
typedef unsigned v4u __attribute__((ext_vector_type(4)));
typedef float f32x4 __attribute__((ext_vector_type(4)));
typedef short bf16x8 __attribute__((ext_vector_type(8)));
typedef GAS unsigned gu32;
typedef GAS unsigned long long gu64;
#define RLX_AGENT __ATOMIC_RELAXED, __HIP_MEMORY_SCOPE_AGENT
#define LDS_WAIT() asm volatile("s_waitcnt lgkmcnt(0)" ::: "memory")
#define VM_WAIT() asm volatile("s_waitcnt vmcnt(0)" ::: "memory")
__device__ __forceinline__ unsigned long long rt() { return __builtin_amdgcn_s_memrealtime(); }
__device__ __forceinline__ unsigned f2bf(float f) { unsigned u = __builtin_bit_cast(unsigned, f); return (u + 0x7fffu + ((u >> 16) & 1u)) >> 16; }
__device__ __forceinline__ unsigned pk2(float lo, float hi) { return f2bf(lo) | (f2bf(hi) << 16); }

#define XB_TMO      128
#define XB_XCNT(j)  (256  + 64 * (j))
#define XB_XSUB(j)  (1280 + 64 * (j))
#define XB_XGEN(j)  (2304 + 64 * (j))
#define XB_TOP      3328
#define XB_TOPGEN   3392
#define XCD_BAR_WORDS 3456
#define XB_SPIN_CAP (1u << 18)

__device__ __forceinline__ unsigned xb_ld(unsigned* p)              { return __hip_atomic_load(p, __ATOMIC_RELAXED, __HIP_MEMORY_SCOPE_AGENT); }
__device__ __forceinline__ unsigned xb_add(unsigned* p, unsigned v) { return __hip_atomic_fetch_add(p, v, __ATOMIC_RELAXED, __HIP_MEMORY_SCOPE_AGENT); }
__device__ __forceinline__ unsigned xb_xcc_id() { return (unsigned)__builtin_amdgcn_s_getreg((3 << 11) | 20) & 0xFu; }
#define XB_SPIN(cond, bar) do { unsigned _sp = 0; while (cond) { __builtin_amdgcn_s_sleep(1); \
    if ((++_sp & 255u) == 0u) { if (xb_ld(&(bar)[XB_TMO])) break; if (_sp > XB_SPIN_CAP) { atomicAdd(&(bar)[XB_TMO], 1u); break; } } } } while (0)

struct XcdBarrier {
    unsigned* bar; unsigned x;
    volatile LAS unsigned* st;
};

__device__ __forceinline__ XcdBarrier xcd_barrier_post(unsigned* bar, volatile LAS unsigned* st) {
    XcdBarrier b; b.bar = bar; b.x = xb_xcc_id(); b.st = st;
    if (threadIdx.x == 0) (void)xb_add(&bar[XB_XCNT(b.x)], 1u);
    return b;
}
__device__ __forceinline__ void xcd_barrier_complete(unsigned* bar, unsigned x, unsigned& nloc, unsigned& nx) {
    const unsigned G = gridDim.x * gridDim.y * gridDim.z;
    unsigned sum, cnt, mine, sp = 0u;
    for (;;) {
        sum = 0u; cnt = 0u; mine = 0u;
#pragma unroll
        for (unsigned j = 0; j < 16; ++j) { const unsigned c = xb_ld(&bar[XB_XCNT(j)]); sum += c; cnt += (c > 0u) ? 1u : 0u; mine = (j == x) ? c : mine; }
        if (sum == G) break;
        __builtin_amdgcn_s_sleep(1);
        if ((++sp & 255u) == 0u) { if (xb_ld(&bar[XB_TMO])) break; if (sp > XB_SPIN_CAP) { atomicAdd(&bar[XB_TMO], 1u); break; } }
    }
    nloc = mine > 0u ? mine : 1u; nx = cnt > 0u ? cnt : 1u;
}

__device__ __forceinline__ void xcd_barrier(const XcdBarrier& b) {
    asm volatile("s_waitcnt vmcnt(0)" ::: "memory");
    __syncthreads();
    if (threadIdx.x == 0) {
        unsigned* bar = b.bar;
        __builtin_amdgcn_s_waitcnt(0);
        unsigned nloc = b.st[0], nx = b.st[1];
        if (nloc == 0u) { xcd_barrier_complete(bar, b.x, nloc, nx); b.st[0] = nloc; b.st[1] = nx; }
        const unsigned old = xb_add(&bar[XB_XSUB(b.x)], 1u);
        const unsigned gen = old / nloc;
        if (old + 1u == (gen + 1u) * nloc) {
            __builtin_amdgcn_fence(__ATOMIC_RELEASE, "agent");
            asm volatile("s_waitcnt vmcnt(0)" ::: "memory");
            const unsigned og = xb_add(&bar[XB_TOP], 1u);
            const unsigned tg = og / nx;
            if (og + 1u == (tg + 1u) * nx) xb_add(&bar[XB_TOPGEN], 1u);
            else XB_SPIN(xb_ld(&bar[XB_TOPGEN]) == tg, bar);
            __builtin_amdgcn_fence(__ATOMIC_ACQUIRE, "agent");
            xb_add(&bar[XB_XGEN(b.x)], 1u);
            asm volatile("s_waitcnt vmcnt(0)" ::: "memory");
        } else {
            XB_SPIN(xb_ld(&bar[XB_XGEN(b.x)]) == gen, bar);
            __builtin_amdgcn_fence(__ATOMIC_ACQUIRE, "agent");
            asm volatile("s_waitcnt vmcnt(0)" ::: "memory");
        }
    }
    __syncthreads();
}
constexpr int NWAVES = 8;
constexpr int RING_OFF = 0, RING_BYTES = 131072;
constexpr int LDSCTL_OFF = RING_BYTES, MISC_OFF = LDSCTL_OFF + 320;
constexpr int LDS_BYTES = 147456;
constexpr int RSL_OFF = MISC_OFF + 128;
static_assert(RSL_OFF + 8 * 256 * 4 <= LDS_BYTES, "LDS map");
constexpr int CW_TMO = 0, CW_CODE = 1, CW_BAR = 4096, MAX_LAUNCHES = 16;
constexpr size_t CTL_ZERO_BYTES = 1u << 20;
static_assert((CW_BAR + MAX_LAUNCHES * XCD_BAR_WORDS) * 4 <= (int)CTL_ZERO_BYTES, "barrier regions inside the memset region");
constexpr int MROWS = 16896, PROWS = 16384, DM = 1024, DFF = 2816, ZW = 3584, WIN_N = 3840, MEMROWS = 2048;
enum Phase { PH_PROLOGUE = 0, PH_UP1, PH_DOWN1, PH_WIN, PH_MIX_LOCAL, PH_MIX_SCAN, PH_MIX_OUT, PH_WOUT, PH_Q, PH_ATTN, PH_WO, PH_UP2, PH_DOWN2, PH_FINAL, PH_COUNT };

constexpr nv::Dm FULL_DIMS{1024, 8, 2048, 128, 4, 4, 128, 128, 4, 64, 128, 16, 256, 4, 256, 2816, 3608, 0, 1e-6f, 16.f};
constexpr nv::Ws WSO = nv::carve_ws(FULL_DIMS);
constexpr nv::OutOff OUTO = nv::out_off(FULL_DIMS);
struct Args { const float* in[33]; float* out; unsigned char* ws; int ph_lo, ph_hi, li, pad; };

__device__ __forceinline__ float wave_sum(float v) {
#pragma unroll
    for (int o = 1; o < 64; o <<= 1) v += shx(v, o);
    return v;
}
struct WSrc { const float* W; const float* gain; int col, pitch; float scale; int zero; };
__device__ __forceinline__ WSrc wsrc(int mat, int np, const float* const* in) {
    WSrc s; s.gain = nullptr; s.scale = 1.f; s.zero = 0; s.col = np; s.pitch = DM; s.W = nullptr;
    switch (mat) {
    case 0: case 7: { const int g = np >> 5, i = np & 31; const bool up = i >= 16; s.W = in[mat == 0 ? (up ? nv::I_F1WU : nv::I_F1WG) : (up ? nv::I_F2WU : nv::I_F2WG)]; s.col = 16 * g + (i & 15); s.pitch = DFF; s.gain = in[mat == 0 ? nv::I_F1G : nv::I_F2G]; break; }
    case 1: case 8: s.W = in[mat == 1 ? nv::I_F1WD : nv::I_F2WD]; break;
    case 2: { s.W = in[nv::I_WIN]; s.pitch = 3608; s.gain = in[nv::I_MIXG];
        if (np < 1536) { s.col = np; if (np >= 512 && np < 1024) s.scale = 0.08838834764831845f; }
        else if (np < 3072) { s.col = np + 8; if (np >= 2048 && np < 2304) s.scale = 0.125f; }
        else if (np < 3584) s.col = np + 24;
        else if (np < 3592) s.col = 1536 + (np - 3584);
        else if (np < 3608) s.col = 3080 + (np - 3592);
        else { s.zero = 1; s.col = 0; }
        break; }
    case 3: s.W = in[nv::I_WOUT]; break;
    case 4: s.W = in[nv::I_WQ]; s.gain = in[nv::I_XG]; s.scale = 0.0625f; break;
    case 5: s.W = in[np < DM ? nv::I_WK : nv::I_WV]; s.col = np & (DM - 1); s.gain = in[nv::I_MEMG]; break;
    default: s.W = in[nv::I_WO]; break;
    }
    return s;
}
struct WItem { int mat, K, kb, nb; size_t off; };
__device__ __forceinline__ WItem witem(int g) {
    WItem w; int nnb;
    if (g < 2816) { w.mat = 0; w.K = DM; nnb = 88; w.off = WSO.wgu1; }
    else if ((g -= 2816) < 1408) { w.mat = 1; w.K = DFF; nnb = 16; w.off = WSO.wd1; }
    else if ((g -= 1408) < 1920) { w.mat = 2; w.K = DM; nnb = 60; w.off = WSO.win; }
    else if ((g -= 1920) < 512) { w.mat = 3; w.K = DM; nnb = 16; w.off = WSO.wout; }
    else if ((g -= 512) < 512) { w.mat = 4; w.K = DM; nnb = 16; w.off = WSO.wq; }
    else if ((g -= 512) < 1024) { w.mat = 5; w.K = DM; nnb = 32; w.off = WSO.wkv; }
    else if ((g -= 1024) < 512) { w.mat = 6; w.K = DM; nnb = 16; w.off = WSO.wo; }
    else if ((g -= 512) < 2816) { w.mat = 7; w.K = DM; nnb = 88; w.off = WSO.wgu2; }
    else { g -= 2816; w.mat = 8; w.K = DFF; nnb = 16; w.off = WSO.wd2; }
    w.kb = g / nnb; w.nb = g % nnb; return w; }
constexpr int W_ITEMS = 2816 + 1408 + 1920 + 512 + 512 + 1024 + 512 + 2816 + 1408;
struct WRegs { f32x4 v[8]; };
__device__ __forceinline__ void witem_load(WRegs& R, const float* const* in, int g, int lane) { const WItem w = witem(g); const int k0 = 32 * w.kb, n0 = 64 * w.nb, n4 = lane & 15, kq = lane >> 4; const WSrc s = wsrc(w.mat, n0 + 4 * n4, in);
#pragma unroll
    for (int i = 0; i < 8; ++i) { const int kk = kq + 4 * i; R.v[i] = (f32x4){0.f, 0.f, 0.f, 0.f}; if (!s.zero) R.v[i] = __builtin_nontemporal_load((const GAS f32x4*)(s.W + (size_t)(k0 + kk) * s.pitch + s.col)); } }
__device__ __forceinline__ void witem_store(const WRegs& R, const float* const* in, unsigned char* ws, LAS float* scr, int g, int lane) { const WItem w = witem(g); const int k0 = 32 * w.kb, n0 = 64 * w.nb, n4 = lane & 15, kq = lane >> 4; bf16* WT = (bf16*)(ws + w.off); const WSrc s = wsrc(w.mat, n0 + 4 * n4, in);
#pragma unroll
    for (int i = 0; i < 8; ++i) { const int kk = kq + 4 * i; *(LAS f32x4*)(scr + kk * 68 + 4 * n4) = R.v[i] * (s.gain ? s.gain[k0 + kk] * s.scale : s.scale); }
    LDS_WAIT(); asm volatile("" ::: "memory");
    const int c = lane & 3;
#pragma unroll
    for (int j = 0; j < 4; ++j) { const int n = (lane >> 2) + 16 * j; const LAS float* p = scr + (8 * c) * 68 + n;
        v4u o; o.x = pk2(p[0 * 68], p[1 * 68]); o.y = pk2(p[2 * 68], p[3 * 68]); o.z = pk2(p[4 * 68], p[5 * 68]); o.w = pk2(p[6 * 68], p[7 * 68]);
        *(GAS v4u*)(WT + (size_t)(n0 + n) * w.K + k0 + 8 * c) = o; }
    LDS_WAIT(); asm volatile("" ::: "memory");
}
__device__ __forceinline__ float row_to_bf16(const float* xrow, bf16* orow, int lane) {
    const GAS f32x4* xr = (const GAS f32x4*)xrow + lane; f32x4 v[4]; float s = 0.f;
#pragma unroll
    for (int j = 0; j < 4; ++j) { v[j] = __builtin_nontemporal_load(xr + 64 * j); s += (v[j].x * v[j].x + v[j].y * v[j].y) + (v[j].z * v[j].z + v[j].w * v[j].w); }
    GAS unsigned long long* o8 = (GAS unsigned long long*)orow + lane;
#pragma unroll
    for (int j = 0; j < 4; ++j) o8[64 * j] = (unsigned long long)pk2(v[j].x, v[j].y) | ((unsigned long long)pk2(v[j].z, v[j].w) << 32);
    return wave_sum(s);
}
struct Frame { LAS unsigned char* lds; int tid, lane, wave, vcu, G; };
__device__ __forceinline__ void p0_prologue(const Frame& F, const float* const* in, unsigned char* ws) {
    LAS float* scr = (LAS float*)(F.lds + RING_OFF + F.wave * 16384);
    const int gw = F.vcu * NWAVES + F.wave, NGW = F.G * NWAVES;
    for (int g = gw; g < W_ITEMS; g += 2 * NGW) { WRegs A, B; const bool two = g + NGW < W_ITEMS; witem_load(A, in, g, F.lane); if (two) witem_load(B, in, g + NGW, F.lane);
        witem_store(A, in, ws, scr, g, F.lane); if (two) witem_store(B, in, ws, scr, g + NGW, F.lane); }
    bf16* XB = (bf16*)(ws + WSO.xb); float* SSQ = (float*)(ws + WSO.ssq);
    for (int m0 = gw; m0 < MROWS; m0 += 2 * NGW) { const int m1 = m0 + NGW;
        const float* s0p = m0 < PROWS ? in[nv::I_XP] + (size_t)m0 * DM : in[nv::I_XS] + (size_t)(m0 - PROWS) * DM; const bool two = m1 < MROWS; const int m1c = two ? m1 : m0;
        const float* s1p = m1c < PROWS ? in[nv::I_XP] + (size_t)m1c * DM : in[nv::I_XS] + (size_t)(m1c - PROWS) * DM;
        f32x4 va[4], vb[4];
#pragma unroll
        for (int j = 0; j < 4; ++j) { va[j] = __builtin_nontemporal_load((const GAS f32x4*)s0p + F.lane + 64 * j); vb[j] = __builtin_nontemporal_load((const GAS f32x4*)s1p + F.lane + 64 * j); }
        float sa = 0.f, sb = 0.f; GAS unsigned long long* oa = (GAS unsigned long long*)(XB + (size_t)m0 * DM) + F.lane; GAS unsigned long long* ob = (GAS unsigned long long*)(XB + (size_t)m1c * DM) + F.lane;
#pragma unroll
        for (int j = 0; j < 4; ++j) { sa += (va[j].x * va[j].x + va[j].y * va[j].y) + (va[j].z * va[j].z + va[j].w * va[j].w); sb += (vb[j].x * vb[j].x + vb[j].y * vb[j].y) + (vb[j].z * vb[j].z + vb[j].w * vb[j].w);
            oa[64 * j] = (unsigned long long)pk2(va[j].x, va[j].y) | ((unsigned long long)pk2(va[j].z, va[j].w) << 32); if (two) ob[64 * j] = (unsigned long long)pk2(vb[j].x, vb[j].y) | ((unsigned long long)pk2(vb[j].z, vb[j].w) << 32); }
        sa = wave_sum(sa); sb = wave_sum(sb);
        if (F.lane < 16) { SSQ[(size_t)m0 * 16 + F.lane] = F.lane == 0 ? sa : 0.f; if (two) SSQ[(size_t)m1 * 16 + F.lane] = F.lane == 0 ? sb : 0.f; } }
    bf16* MEMB = (bf16*)(ws + WSO.memb); float* MSSQ = (float*)(ws + WSO.mssq);
    for (int m = gw; m < MEMROWS; m += NGW) { const float s = row_to_bf16(in[nv::I_MEM] + (size_t)m * DM, MEMB + (size_t)m * DM, F.lane); if (F.lane == 0) MSSQ[m] = s; }
}
__device__ __forceinline__ void p_final(const Frame& F, const float* const* in, float* out, unsigned char* ws) {
    const int gw = F.vcu * NWAVES + F.wave, NGW = F.G * NWAVES; const bf16* XB = (const bf16*)(ws + WSO.xb); const float* SSQ = (const float*)(ws + WSO.ssq); const float* g = in[nv::I_FING];
    f32x4 gv[4];
#pragma unroll
    for (int j = 0; j < 4; ++j) gv[j] = ((const GAS f32x4*)g)[F.lane + 64 * j];
    for (int m0 = gw; m0 < MROWS; m0 += 2 * NGW) { const int m1 = m0 + NGW < MROWS ? m0 + NGW : m0; unsigned long long xw[2][4]; f32x4 sv[2][4];
#pragma unroll
        for (int q = 0; q < 2; ++q) { const int m = q ? m1 : m0; const GAS f32x4* sp = (const GAS f32x4*)(SSQ + (size_t)m * 16); const GAS unsigned long long* xr = (const GAS unsigned long long*)(XB + (size_t)m * DM) + F.lane;
#pragma unroll
            for (int j = 0; j < 4; ++j) { sv[q][j] = sp[j]; xw[q][j] = __builtin_nontemporal_load(xr + 64 * j); } }
#pragma unroll
        for (int q = 0; q < 2; ++q) { const int m = q ? m1 : m0; if (q == 1 && m1 == m0) break;
        const f32x4 s0 = sv[q][0], s1 = sv[q][1], s2 = sv[q][2], s3 = sv[q][3];
        const float ss = ((s0.x + s0.y) + (s0.z + s0.w)) + ((s1.x + s1.y) + (s1.z + s1.w)) + ((s2.x + s2.y) + (s2.z + s2.w)) + ((s3.x + s3.y) + (s3.z + s3.w));
        const float rs = rsqrtf(ss * (1.0f / DM) + 1e-6f); GAS f32x4* yo = (GAS f32x4*)(out + OUTO.yp + (size_t)m * DM) + F.lane;
#pragma unroll
        for (int j = 0; j < 4; ++j) { const unsigned long long w = xw[q][j]; const unsigned lo = (unsigned)w, hi = (unsigned)(w >> 32);
            const f32x4 x = {__uint_as_float(lo << 16), __uint_as_float(lo & 0xffff0000u), __uint_as_float(hi << 16), __uint_as_float(hi & 0xffff0000u)}; __builtin_nontemporal_store(x * rs * gv[j], yo + 64 * j); } } }
}
namespace mx {
typedef short bf16x8 __attribute__((ext_vector_type(8)));
typedef short s16x4 __attribute__((ext_vector_type(4)));
typedef float f32x4 __attribute__((ext_vector_type(4)));
typedef unsigned u32x4 __attribute__((ext_vector_type(4)));
typedef unsigned u32x2 __attribute__((ext_vector_type(2)));
typedef LAS unsigned char* ldsp;
constexpr int ZQ = 0, ZK = 512, ZV = 1024, ZO = 1536, GQ = 2048, GK = 2304, GV = 2560, GG = 3072, ZWD = 3584, ZGP = 32;
constexpr int KP = 272, VP = 304, GP = 144, HP = 132;
constexpr int NITEM = 1024;
__device__ __forceinline__ float bf2f(unsigned short v) { return __uint_as_float((unsigned)v << 16); }
__device__ __forceinline__ float lsig(float x) { return fminf(x, 0.f) - __logf(1.f + __expf(-fabsf(x))); }
template <int CTRL, int ROW_MASK> __device__ __forceinline__ float dpp_get(float old, float x) { return __builtin_bit_cast(float, __builtin_amdgcn_update_dpp(__builtin_bit_cast(int, old), __builtin_bit_cast(int, x), CTRL, ROW_MASK, 0xF, false)); }
__device__ __forceinline__ float wscan_add(float v, int) {
    v += dpp_get<0x111, 0xF>(0.f, v); v += dpp_get<0x112, 0xF>(0.f, v); v += dpp_get<0x114, 0xF>(0.f, v); v += dpp_get<0x118, 0xF>(0.f, v);
    v += dpp_get<0x142, 0xA>(0.f, v); v += dpp_get<0x143, 0xC>(0.f, v); return v; }
__device__ __forceinline__ float wscan_max(float v, int) { const float ni = -INFINITY;
    v = fmaxf(v, dpp_get<0x111, 0xF>(ni, v)); v = fmaxf(v, dpp_get<0x112, 0xF>(ni, v)); v = fmaxf(v, dpp_get<0x114, 0xF>(ni, v)); v = fmaxf(v, dpp_get<0x118, 0xF>(ni, v));
    v = fmaxf(v, dpp_get<0x142, 0xA>(ni, v)); v = fmaxf(v, dpp_get<0x143, 0xC>(ni, v)); return v; }
__device__ __forceinline__ float wlast(float v) { return __builtin_bit_cast(float, __builtin_amdgcn_readlane(__builtin_bit_cast(int, v), 63)); }
__device__ __forceinline__ float wmax(float v) { return wlast(wscan_max(v, 0)); }
__device__ __forceinline__ float wsum(float v) { return wlast(wscan_add(v, 0)); }
__device__ __forceinline__ f32x4 mma(bf16x8 a, bf16x8 b, f32x4 c) { return __builtin_amdgcn_mfma_f32_16x16x32_bf16(a, b, c, 0, 0, 0); }
__device__ __forceinline__ bf16x8 frag_row(ldsp base, int pitchB, int row0, int k0, int lane) { return *(const LAS bf16x8*)(base + (row0 + (lane & 15)) * pitchB + (k0 + 8 * (lane >> 4)) * 2); }
__device__ __forceinline__ bf16x8 frag_tr(ldsp base, int pitchB, int k0, int col0, int lane) {
    ldsp p = base + (k0 + 8 * (lane >> 4) + ((lane & 15) >> 2)) * pitchB + (col0 + 4 * (lane & 3)) * 2;
    const s16x4 lo = __builtin_bit_cast(s16x4, __builtin_amdgcn_ds_read_tr16_b64_v4i16((LAS s16x4*)p));
    const s16x4 hi = __builtin_bit_cast(s16x4, __builtin_amdgcn_ds_read_tr16_b64_v4i16((LAS s16x4*)(p + 4 * pitchB)));
    return (bf16x8){lo[0], lo[1], lo[2], lo[3], hi[0], hi[1], hi[2], hi[3]}; }
__device__ __forceinline__ unsigned pkbf(float lo, float hi) { return pk2(lo, hi); }
template <int NCH> __device__ __forceinline__ void stage_tile(ldsp dst, int pb, const bf16* src, size_t gp, int rows, int tid) {
    for (int id = tid; id < rows * NCH; id += 512) { const int s = id / NCH, ch = id % NCH; *(LAS u32x4*)(dst + s * pb + ch * 16) = *(const GAS u32x4*)(src + (size_t)s * gp + ch * 8); } }
struct Ctx { const bf16* Z; const float* ZG; unsigned char* ws; const float* const* in; float* out; ldsp L; int tid, lane, wave, pad; };

__device__ __forceinline__ void scan_phase(const Ctx& c, int gtid, int nthreads) {
    const float* ML = (const float*)(c.ws + WSO.mloc);
    for (int q = gtid; q < 32 * 4096; q += nthreads) { const int bh = q >> 12, e = (q & 4095) * 4, e2 = (q & 4095) * 2, d2 = e2 >> 7;
        const bf16* CL = (const bf16*)(c.ws + WSO.cloc) + (size_t)bh * 32 * 16384 + e; bf16* CS = (bf16*)(c.ws + WSO.cst) + (size_t)bh * 32 * 16384 + e;
        const bf16* SL = (const bf16*)(c.ws + WSO.sloc) + (size_t)bh * 32 * 8192 + e2; bf16* SS = (bf16*)(c.ws + WSO.sst) + (size_t)bh * 32 * 8192 + e2; const float* GD = (const float*)(c.ws + WSO.gdec) + (size_t)bh * 32 * 64 + d2;
        f32x4 C = {0.f, 0.f, 0.f, 0.f}; float m = 0.f, S0 = 0.f, S1 = 0.f;
        for (int c0 = 0; c0 < 32; c0 += 8) { u32x2 lw[8]; unsigned sw[8]; float mlv[8], blv[8], gd[8];
#pragma unroll
            for (int j = 0; j < 8; ++j) { lw[j] = __builtin_nontemporal_load((const GAS u32x2*)(CL + (size_t)(c0 + j) * 16384)); sw[j] = __builtin_nontemporal_load((const GAS unsigned*)(SL + (size_t)(c0 + j) * 8192)); mlv[j] = ML[(bh * 32 + c0 + j) * 2]; blv[j] = ML[(bh * 32 + c0 + j) * 2 + 1]; gd[j] = GD[(c0 + j) * 64]; }
#pragma unroll
            for (int j = 0; j < 8; ++j) { u32x2 o; o.x = pkbf(C[0], C[1]); o.y = pkbf(C[2], C[3]); *(GAS u32x2*)(CS + (size_t)(c0 + j) * 16384) = o; *(GAS unsigned*)(SS + (size_t)(c0 + j) * 8192) = pkbf(S0, S1);
                const float mn = fmaxf(blv[j] + m, mlv[j]), fC = __expf(blv[j] + m - mn), fL = __expf(mlv[j] - mn);
                const f32x4 l = {__uint_as_float(lw[j][0] << 16), __uint_as_float(lw[j][0] & 0xffff0000u), __uint_as_float(lw[j][1] << 16), __uint_as_float(lw[j][1] & 0xffff0000u)}; C = C * fC + l * fL; m = mn;
                S0 = S0 * gd[j] + __uint_as_float(sw[j] << 16); S1 = S1 * gd[j] + __uint_as_float(sw[j] & 0xffff0000u); } }
        *(GAS f32x4*)(c.out + OUTO.cp + (size_t)bh * 16384 + e) = C; float* so = c.out + OUTO.sp + (size_t)bh * 8192 + e2; so[0] = S0; so[1] = S1; }
    for (int q = nthreads - 1 - gtid; q < 32 * 128; q += nthreads) { const int bh = q >> 7, d = q & 127; const float* NL = (const float*)(c.ws + WSO.nloc) + (size_t)bh * 32 * 128 + d; float* NS = (float*)(c.ws + WSO.nst) + (size_t)bh * 32 * 128 + d; float* MS = (float*)(c.ws + WSO.mst) + bh * 32;
        float n = 0.f, m = 0.f;
        for (int c0 = 0; c0 < 32; c0 += 8) { float nl[8], mlv[8], blv[8];
#pragma unroll
            for (int j = 0; j < 8; ++j) { nl[j] = NL[(c0 + j) * 128]; mlv[j] = ML[(bh * 32 + c0 + j) * 2]; blv[j] = ML[(bh * 32 + c0 + j) * 2 + 1]; }
#pragma unroll
            for (int j = 0; j < 8; ++j) { NS[(c0 + j) * 128] = n; if (d == 0) MS[c0 + j] = m; const float mn = fmaxf(blv[j] + m, mlv[j]); n = n * __expf(blv[j] + m - mn) + nl[j] * __expf(mlv[j] - mn); m = mn; } }
        c.out[OUTO.np + bh * 128 + d] = n; if (d == 0) c.out[OUTO.mp + bh] = m; }
}
}
namespace mx {
#define MX_BAR_LDS() do { asm volatile("s_waitcnt lgkmcnt(0)" ::: "memory"); __builtin_amdgcn_s_barrier(); asm volatile("" ::: "memory"); } while (0)
__device__ __forceinline__ void sample_mlstm(const Ctx& c, int item) {
    const int b = item >> 2, h = item & 3, r0 = 16384 + 4 * b;
    LAS float* SQ = (LAS float*)(c.L); LAS float *SK = SQ + 512, *SV = SQ + 1024, *GS = SQ + 1536  , *QK = SQ + 1600  , *PS = SQ + 1632, *RED = SQ + 2048  ;
    const float* C0 = c.in[nv::I_SC] + (size_t)item * 16384; const float* n0 = c.in[nv::I_SN] + item * 128;
    f32x4 cst[8];
#pragma unroll
    for (int j = 0; j < 8; ++j) cst[j] = __builtin_nontemporal_load((const GAS f32x4*)(C0 + ((c.tid >> 5) * 8 + j) * 128 + 4 * (c.tid & 31)));
    { const int t = c.tid >> 7, d = c.tid & 127; const bf16* zr = c.Z + (size_t)(r0 + t) * ZWD + h * 128 + d; SQ[c.tid] = bf2f(zr[ZQ]); SK[c.tid] = bf2f(zr[ZK]); SV[c.tid] = bf2f(zr[ZV]); }
    if (c.tid == 0) { float ip[4], bb[4], a[4]; const float m0 = c.in[nv::I_SM][item]; float run = 0.f;
#pragma unroll
        for (int t = 0; t < 4; ++t) { ip[t] = c.ZG[(r0 + t) * ZGP + h] + c.in[nv::I_BI][h]; run += lsig(c.ZG[(r0 + t) * ZGP + 4 + h] + c.in[nv::I_BF][h]); bb[t] = run; a[t] = run + m0; }
#pragma unroll
        for (int t = 0; t < 4; ++t) { float mt = a[t];
#pragma unroll
            for (int s = 0; s < 4; ++s) if (s <= t) mt = fmaxf(mt, bb[t] - bb[s] + ip[s]);
            GS[t] = __expf(a[t] - mt); GS[4 + t] = mt;
#pragma unroll
            for (int s = 0; s < 4; ++s) GS[8 + t * 4 + s] = (s <= t) ? __expf(bb[t] - bb[s] + ip[s] - mt) : 0.f; } }
    MX_BAR_LDS();
    {
#pragma unroll
        for (int q = 0; q < 2; ++q) { const int p = 2 * c.wave + q, t = p >> 2, s = p & 3; const float v = wsum(SQ[t * 128 + c.lane] * SK[s * 128 + c.lane] + SQ[t * 128 + 64 + c.lane] * SK[s * 128 + 64 + c.lane]); if (c.lane == 0) QK[p] = v; }
        if (c.wave < 4) { const float v = wsum(SQ[c.wave * 128 + c.lane] * n0[c.lane] + SQ[c.wave * 128 + 64 + c.lane] * n0[64 + c.lane]); if (c.lane == 0) QK[16 + c.wave] = v; } }
    {
        const int v4 = c.tid & 31, dg = c.tid >> 5; const float iL = GS[3]; const float wl0 = GS[8 + 12], wl1 = GS[8 + 13], wl2 = GS[8 + 14], wl3 = GS[8 + 15];
        f32x4 p0 = {0.f, 0.f, 0.f, 0.f}, p1 = p0, p2 = p0, p3 = p0; const f32x4 v0 = *(const LAS f32x4*)(SV + 4 * v4), v1 = *(const LAS f32x4*)(SV + 128 + 4 * v4), v2 = *(const LAS f32x4*)(SV + 256 + 4 * v4), v3 = *(const LAS f32x4*)(SV + 384 + 4 * v4);
        float* Co = c.out + OUTO.cs + (size_t)item * 16384;
#pragma unroll
        for (int j = 0; j < 8; ++j) { const int d = dg * 8 + j; const f32x4 cv = cst[j];
            p0 += cv * SQ[d]; p1 += cv * SQ[128 + d]; p2 += cv * SQ[256 + d]; p3 += cv * SQ[384 + d];
            __builtin_nontemporal_store(cv * iL + v0 * (wl0 * SK[d]) + v1 * (wl1 * SK[128 + d]) + v2 * (wl2 * SK[256 + d]) + v3 * (wl3 * SK[384 + d]), (GAS f32x4*)(Co + d * 128 + 4 * v4)); }
        *(LAS f32x4*)(RED + (dg * 4 + 0) * 128 + 4 * v4) = p0; *(LAS f32x4*)(RED + (dg * 4 + 1) * 128 + 4 * v4) = p1; *(LAS f32x4*)(RED + (dg * 4 + 2) * 128 + 4 * v4) = p2; *(LAS f32x4*)(RED + (dg * 4 + 3) * 128 + 4 * v4) = p3;
        if (c.tid < 128) { const int d = c.tid; c.out[OUTO.ns + item * 128 + d] = iL * n0[d] + wl0 * SK[d] + wl1 * SK[128 + d] + wl2 * SK[256 + d] + wl3 * SK[384 + d]; }
        if (c.tid == 0) c.out[OUTO.ms + item] = GS[7]; }
    MX_BAR_LDS();
    float hval;
    { const int t = c.tid >> 7, v = c.tid & 127; float qc = 0.f;
#pragma unroll
      for (int dg = 0; dg < 16; ++dg) qc += RED[(dg * 4 + t) * 128 + v];
      const float wi = GS[t]; float num = wi * qc, den = wi * QK[16 + t];
#pragma unroll
      for (int s = 0; s < 4; ++s) { const float st = QK[t * 4 + s] * GS[8 + t * 4 + s]; num += st * SV[s * 128 + v]; den += st; }
      hval = num / fmaxf(fabsf(den), __expf(-GS[4 + t]));
      const float ss = wsum(hval * hval); if (c.lane == 0) PS[c.wave] = ss; }
    MX_BAR_LDS();
    { const int t = c.tid >> 7, v = c.tid & 127; const float rs = rsqrtf((PS[2 * t] + PS[2 * t + 1]) * (1.0f / 128.0f) + 1e-6f); const float g = bf2f(c.Z[(size_t)(r0 + t) * ZWD + ZO + h * 128 + v]);
      ((bf16*)(c.ws + WSO.ymix))[(size_t)(r0 + t) * 1024 + h * 128 + v] = (bf16)f2bf(hval * rs * c.in[nv::I_MLOG][h * 128 + v] / (1.f + __expf(-g))); }
    MX_BAR_LDS();
}
__device__ __forceinline__ void sample_gla(const Ctx& c, int item) {
    const int b = item >> 2, h = item & 3, r0 = 16384 + 4 * b;
    LAS float* SQ = (LAS float*)(c.L); LAS float *SKH = SQ + 256  , *SKM = SQ + 512  , *BC = SQ + 768, *SV = SQ + 1024  , *AQ = SQ + 1536, *PS = SQ + 1568, *RED = SQ + 2048  ;
    const float* S0 = c.in[nv::I_SS] + (size_t)item * 8192;
    f32x4 sst[4];
#pragma unroll
    for (int j = 0; j < 4; ++j) sst[j] = __builtin_nontemporal_load((const GAS f32x4*)(S0 + ((c.tid >> 5) * 4 + j) * 128 + 4 * (c.tid & 31)));
    if (c.tid < 256) { const int t = c.tid >> 6, d = c.tid & 63; float a = c.in[nv::I_BA][h * 64 + d];
#pragma unroll
        for (int r = 0; r < 16; ++r) a += c.ZG[(r0 + t) * ZGP + 8 + r] * c.in[nv::I_WA2][r * 256 + h * 64 + d];
        BC[c.tid] = lsig(a) * 0.0625f; }
    { const int t = c.tid >> 7, v = c.tid & 127; SV[c.tid] = bf2f(c.Z[(size_t)(r0 + t) * ZWD + GV + h * 128 + v]); }
    MX_BAR_LDS();
    if (c.tid < 64) { float run = 0.f;
#pragma unroll
        for (int t = 0; t < 4; ++t) { run += BC[t * 64 + c.tid]; BC[t * 64 + c.tid] = run; } }
    MX_BAR_LDS();
    if (c.tid < 256) { const int t = c.tid >> 6, d = c.tid & 63; const bf16* zr = c.Z + (size_t)(r0 + t) * ZWD + h * 64 + d; const float bc = BC[c.tid], bl = BC[192 + d], k = bf2f(zr[GK]);
        SQ[c.tid] = bf2f(zr[GQ]) * __expf(bc); SKH[c.tid] = k * __expf(bl - bc); SKM[c.tid] = k * __expf(-bc); }
    MX_BAR_LDS();
#pragma unroll
    for (int q = 0; q < 2; ++q) { const int p = 2 * c.wave + q, t = p >> 2, s = p & 3; const float v = wsum(SQ[t * 64 + c.lane] * SKM[s * 64 + c.lane]); if (c.lane == 0) AQ[p] = (s <= t) ? v : 0.f; }
    { const int v4 = c.tid & 31, dg = c.tid >> 5; f32x4 p0 = {0.f, 0.f, 0.f, 0.f}, p1 = p0, p2 = p0, p3 = p0;
      const f32x4 v0 = *(const LAS f32x4*)(SV + 4 * v4), v1 = *(const LAS f32x4*)(SV + 128 + 4 * v4), v2 = *(const LAS f32x4*)(SV + 256 + 4 * v4), v3 = *(const LAS f32x4*)(SV + 384 + 4 * v4);
      float* So = c.out + OUTO.ss + (size_t)item * 8192;
#pragma unroll
      for (int j = 0; j < 4; ++j) { const int d = dg * 4 + j; const f32x4 sv = sst[j];
          p0 += sv * SQ[d]; p1 += sv * SQ[64 + d]; p2 += sv * SQ[128 + d]; p3 += sv * SQ[192 + d];
          __builtin_nontemporal_store(sv * __expf(BC[192 + d]) + v0 * SKH[d] + v1 * SKH[64 + d] + v2 * SKH[128 + d] + v3 * SKH[192 + d], (GAS f32x4*)(So + d * 128 + 4 * v4)); }
      *(LAS f32x4*)(RED + (dg * 4 + 0) * 128 + 4 * v4) = p0; *(LAS f32x4*)(RED + (dg * 4 + 1) * 128 + 4 * v4) = p1; *(LAS f32x4*)(RED + (dg * 4 + 2) * 128 + 4 * v4) = p2; *(LAS f32x4*)(RED + (dg * 4 + 3) * 128 + 4 * v4) = p3; }
    MX_BAR_LDS();
    float hval;
    { const int t = c.tid >> 7, v = c.tid & 127; float o = 0.f;
#pragma unroll
      for (int dg = 0; dg < 16; ++dg) o += RED[(dg * 4 + t) * 128 + v];
#pragma unroll
      for (int s = 0; s < 4; ++s) o += AQ[t * 4 + s] * SV[s * 128 + v];
      hval = o; const float ss = wsum(hval * hval); if (c.lane == 0) PS[c.wave] = ss; }
    MX_BAR_LDS();
    { const int t = c.tid >> 7, v = c.tid & 127; const float rs = rsqrtf((PS[2 * t] + PS[2 * t + 1]) * (1.0f / 128.0f) + 1e-6f); const float g = bf2f(c.Z[(size_t)(r0 + t) * ZWD + GG + h * 128 + v]);
      ((bf16*)(c.ws + WSO.ymix))[(size_t)(r0 + t) * 1024 + 512 + h * 128 + v] = (bf16)f2bf(hval * rs * c.in[nv::I_GLOG][h * 128 + v] * g / (1.f + __expf(-g))); }
    MX_BAR_LDS();
}
}
namespace m2 {
using namespace mx;
#define BAR_LDS() do { asm volatile("s_waitcnt lgkmcnt(0)" ::: "memory"); __builtin_amdgcn_s_barrier(); asm volatile("" ::: "memory"); } while (0)
constexpr int WA_OFF = 110592;
constexpr int GN_OFF = 131584;
constexpr int PRIV_OFF = 75776, PRIV_BYTES = 4224, PSQ_OFF = 109568;
__device__ __forceinline__ void load_wa(const Ctx& c) {
    LAS float* WA = (LAS float*)(c.L + WA_OFF);
    for (int i = c.tid; i < 1024; i += 512) *(LAS f32x4*)(WA + 4 * i) = *(const GAS f32x4*)(c.in[nv::I_WA2] + 4 * i);
    if (c.tid < 64) *(LAS f32x4*)(WA + 4096 + 4 * c.tid) = *(const GAS f32x4*)(c.in[nv::I_BA] + 4 * c.tid);
    LAS float* GN = (LAS float*)(c.L + GN_OFF);
    if (c.tid < 128) *(LAS f32x4*)(GN + 4 * c.tid) = *(const GAS f32x4*)(c.in[nv::I_MLOG] + 4 * c.tid); else if (c.tid < 256) *(LAS f32x4*)(GN + 4 * c.tid) = *(const GAS f32x4*)(c.in[nv::I_GLOG] + 4 * (c.tid - 128));
    else if (c.tid < 260) GN[1024 + (c.tid - 256)] = c.in[nv::I_BI][c.tid - 256]; else if (c.tid < 264) GN[1028 + (c.tid - 260)] = c.in[nv::I_BF][c.tid - 260];
    BAR_LDS();
}
struct Item { int b, h, ch, r0; };
__device__ __forceinline__ Item decode(int item) { Item it; const int bh = item >> 5; it.ch = item & 31; it.b = bh >> 2; it.h = bh & 3; it.r0 = it.b * 2048 + it.ch * 64; return it; }
struct LmRegs { float zi, zf; u32x4 k[2], v[2]; };
__device__ __forceinline__ void lm_load(LmRegs& R, const Ctx& c, int item) { const Item it = decode(item);
    R.zi = c.ZG[(size_t)(it.r0 + c.lane) * ZGP + it.h]; R.zf = c.ZG[(size_t)(it.r0 + c.lane) * ZGP + 4 + it.h];
#pragma unroll
    for (int j = 0; j < 2; ++j) { const int id = c.tid + 512 * j, s = id >> 4, cc = id & 15; const bf16* zr = c.Z + (size_t)(it.r0 + s) * ZWD + it.h * 128 + cc * 8; R.k[j] = *(const GAS u32x4*)(zr + ZK); R.v[j] = *(const GAS u32x4*)(zr + ZV); } }
__device__ __forceinline__ void lm_stage(const LmRegs& R, const Ctx& c, int item, ldsp Ks, ldsp Vs) { const Item it = decode(item);
    const LAS float* GB = (const LAS float*)(c.L + GN_OFF) + 1024; const float ip = R.zi + GB[it.h], lf = lsig(R.zf + GB[4 + it.h]); const float bc = wscan_add(lf, c.lane), bL = wlast(bc), g = bL - bc + ip, ml = wmax(g), w = __expf(g - ml);
    if (c.tid == 0) { float* M = (float*)(c.ws + WSO.mloc); M[item * 2] = ml; M[item * 2 + 1] = bL; }
#pragma unroll
    for (int j = 0; j < 2; ++j) { const int id = c.tid + 512 * j, s = id >> 4, cc = id & 15; const float wv = shl(w, s); *(LAS u32x4*)(Ks + s * KP + cc * 16) = R.k[j]; u32x4 o;
#pragma unroll
        for (int q = 0; q < 4; ++q) o[q] = pkbf(bf2f((unsigned short)(R.v[j][q] & 0xffffu)) * wv, bf2f((unsigned short)(R.v[j][q] >> 16)) * wv);
        *(LAS u32x4*)(Vs + s * VP + cc * 16) = o; }
    { const int s = (c.tid >> 1) & 63; const float wv = shl(w, s); if (c.tid < 128) { u32x4 o = {0u, 0u, 0u, 0u}; if ((c.tid & 1) == 0) o[0] = pkbf(wv, 0.f); *(LAS u32x4*)(Vs + s * VP + 256 + (c.tid & 1) * 16) = o; } } }
__device__ __forceinline__ void lm_compute(const Ctx& c, int item, ldsp Ks, ldsp Vs) {
    const int d0 = 16 * c.wave; const bf16x8 b0 = frag_tr(Ks, KP, 0, d0, c.lane), b1 = frag_tr(Ks, KP, 32, d0, c.lane);
    bf16* CL = (bf16*)(c.ws + WSO.cloc) + (size_t)item * 16384; float* NL = (float*)(c.ws + WSO.nloc) + (size_t)item * 128;
#pragma unroll
    for (int vt = 0; vt < 9; ++vt) { f32x4 acc = {0.f, 0.f, 0.f, 0.f}; acc = mma(frag_tr(Vs, VP, 0, 16 * vt, c.lane), b0, acc); acc = mma(frag_tr(Vs, VP, 32, 16 * vt, c.lane), b1, acc);
        if (vt < 8) { u32x2 o; o[0] = pkbf(acc[0], acc[1]); o[1] = pkbf(acc[2], acc[3]); *(GAS u32x2*)(CL + (d0 + (c.lane & 15)) * 128 + 16 * vt + 4 * (c.lane >> 4)) = o; }
        else if ((c.lane >> 4) == 0) NL[d0 + (c.lane & 15)] = acc[0]; } }
__device__ __forceinline__ void run_local_mlstm(const Ctx& c, int cu, int G) {
    int item = cu; LmRegs R; if (item < NITEM) lm_load(R, c, item); int set = 0;
    for (; item < NITEM; item += G) { ldsp Ks = c.L + set * 36864, Vs = Ks + 17408; lm_stage(R, c, item, Ks, Vs); if (item + G < NITEM) lm_load(R, c, item + G); BAR_LDS(); lm_compute(c, item, Ks, Vs); set ^= 1; }
    BAR_LDS(); }
__device__ __forceinline__ void gla_bc_wave(const Ctx& c, const f32x4 (&ga)[4], int h, float (&bc)[8]) {
    const LAS float* WA = (const LAS float*)(c.L + WA_OFF) + h * 64 + c.wave * 8; const LAS float* BA = (const LAS float*)(c.L + WA_OFF) + 4096 + h * 64 + c.wave * 8;
#pragma unroll
    for (int j = 0; j < 8; ++j) { float a = BA[j];
#pragma unroll
        for (int q = 0; q < 4; ++q) { a += ga[q][0] * WA[(4 * q) * 256 + j]; a += ga[q][1] * WA[(4 * q + 1) * 256 + j]; a += ga[q][2] * WA[(4 * q + 2) * 256 + j]; a += ga[q][3] * WA[(4 * q + 3) * 256 + j]; }
        bc[j] = wscan_add(lsig(a) * 0.0625f, c.lane); } }
struct LgRegs { f32x4 ga[4]; u32x4 k; u32x4 v[2]; };
__device__ __forceinline__ void lg_load(LgRegs& R, const Ctx& c, int item) { const Item it = decode(item);
#pragma unroll
    for (int q = 0; q < 4; ++q) R.ga[q] = *(const GAS f32x4*)(c.ZG + (size_t)(it.r0 + c.lane) * ZGP + 8 + 4 * q);
    R.k = *(const GAS u32x4*)(c.Z + (size_t)(it.r0 + c.lane) * ZWD + GK + it.h * 64 + c.wave * 8);
#pragma unroll
    for (int j = 0; j < 2; ++j) { const int id = c.tid + 512 * j, s = id >> 4, cc = id & 15; R.v[j] = *(const GAS u32x4*)(c.Z + (size_t)(it.r0 + s) * ZWD + GV + it.h * 128 + cc * 8); } }
__device__ __forceinline__ void lg_stage(const LgRegs& R, const Ctx& c, int item, ldsp Gk, ldsp Gv) { const Item it = decode(item); float bc[8]; gla_bc_wave(c, R.ga, it.h, bc); u32x4 o;
#pragma unroll
    for (int q = 0; q < 4; ++q) { const float bl0 = wlast(bc[2 * q]), bl1 = wlast(bc[2 * q + 1]);
        o[q] = pkbf(bf2f((unsigned short)(R.k[q] & 0xffffu)) * __expf(bl0 - bc[2 * q]), bf2f((unsigned short)(R.k[q] >> 16)) * __expf(bl1 - bc[2 * q + 1]));
        if (c.lane == 63) { float* GD = (float*)(c.ws + WSO.gdec) + item * 64 + c.wave * 8 + 2 * q; GD[0] = __expf(bl0); GD[1] = __expf(bl1); } }
    *(LAS u32x4*)(Gk + c.lane * GP + c.wave * 16) = o;
#pragma unroll
    for (int j = 0; j < 2; ++j) { const int id = c.tid + 512 * j, s = id >> 4, cc = id & 15; *(LAS u32x4*)(Gv + s * KP + cc * 16) = R.v[j]; } }
__device__ __forceinline__ void lg_compute(const Ctx& c, int item, ldsp Gk, ldsp Gv) {
    const int d0 = 16 * (c.wave & 3), vt0 = (c.wave >> 2) * 4; const bf16x8 b0 = frag_tr(Gk, GP, 0, d0, c.lane), b1 = frag_tr(Gk, GP, 32, d0, c.lane); bf16* SL = (bf16*)(c.ws + WSO.sloc) + (size_t)item * 8192;
#pragma unroll
    for (int q = 0; q < 4; ++q) { const int vt = vt0 + q; f32x4 acc = {0.f, 0.f, 0.f, 0.f}; acc = mma(frag_tr(Gv, KP, 0, 16 * vt, c.lane), b0, acc); acc = mma(frag_tr(Gv, KP, 32, 16 * vt, c.lane), b1, acc);
        u32x2 o; o[0] = pkbf(acc[0], acc[1]); o[1] = pkbf(acc[2], acc[3]); *(GAS u32x2*)(SL + (d0 + (c.lane & 15)) * 128 + 16 * vt + 4 * (c.lane >> 4)) = o; } }
__device__ __forceinline__ void run_local_gla(const Ctx& c, int cu, int G) {
    int item = cu; LgRegs R; if (item < NITEM) lg_load(R, c, item); int set = 0;
    for (; item < NITEM; item += G) { ldsp Gk = c.L + set * 26624, Gv = Gk + 9216; lg_stage(R, c, item, Gk, Gv); if (item + G < NITEM) lg_load(R, c, item + G); BAR_LDS(); lg_compute(c, item, Gk, Gv); set ^= 1; }
    BAR_LDS(); }
template <bool ML> __device__ __forceinline__ void tail_out(const Ctx& c, const LAS float* Hp, int r0, int h, int tt, int vh, u32x4 g0, u32x4 g1) {
    LAS float* PSQ = (LAS float*)(c.L + PSQ_OFF); const int t = c.lane >> 2, c0 = (c.lane & 3) * 16; float hv[16]; float ss = 0.f;
#pragma unroll
    for (int j = 0; j < 16; ++j) { hv[j] = Hp[t * 66 + c0 + j]; ss += hv[j] * hv[j]; }
    ss += shx(ss, 1); ss += shx(ss, 2); if ((c.lane & 3) == 0) PSQ[c.wave * 16 + t] = ss;
    const int row = r0 + 16 * tt + t, col = h * 128 + 64 * vh + c0;
    const LAS float* gn = (const LAS float*)(c.L + GN_OFF) + (ML ? 0 : 512) + col; const f32x4 n0 = *(const LAS f32x4*)gn, n1 = *(const LAS f32x4*)(gn + 4), n2 = *(const LAS f32x4*)(gn + 8), n3 = *(const LAS f32x4*)(gn + 12);
    const float gnv[16] = {n0[0], n0[1], n0[2], n0[3], n1[0], n1[1], n1[2], n1[3], n2[0], n2[1], n2[2], n2[3], n3[0], n3[1], n3[2], n3[3]};
    BAR_LDS();
    const float rs = rsqrtf((PSQ[c.wave * 16 + t] + PSQ[(c.wave ^ 4) * 16 + t]) * (1.0f / 128.0f) + 1e-6f);
    bf16* yo = (bf16*)(c.ws + WSO.ymix) + (size_t)row * 1024 + (ML ? 0 : 512) + col; u32x4 o[2];
#pragma unroll
    for (int q = 0; q < 2; ++q)
#pragma unroll
        for (int j = 0; j < 4; ++j) { const unsigned gw = q ? g1[j] : g0[j]; const float ga = bf2f((unsigned short)(gw & 0xffffu)), gb = bf2f((unsigned short)(gw >> 16));
            const float a0 = ML ? 1.f / (1.f + __expf(-ga)) : ga / (1.f + __expf(-ga)), a1 = ML ? 1.f / (1.f + __expf(-gb)) : gb / (1.f + __expf(-gb));
            o[q][j] = pkbf(a0 * hv[8 * q + 2 * j] * rs * gnv[8 * q + 2 * j], a1 * hv[8 * q + 2 * j + 1] * rs * gnv[8 * q + 2 * j + 1]); }
    *(GAS u32x4*)yo = o[0]; *(GAS u32x4*)(yo + 8) = o[1];
}
template <bool ML> __device__ __forceinline__ void gate_load(u32x4 (&gt)[2], const Ctx& c, const Item& it) { const int tt = c.wave & 3, vh = c.wave >> 2, t = c.lane >> 2, c0 = (c.lane & 3) * 16;
    const bf16* gp = c.Z + (size_t)(it.r0 + 16 * tt + t) * ZWD + (ML ? ZO : GG) + it.h * 128 + 64 * vh + c0; gt[0] = *(const GAS u32x4*)gp; gt[1] = *(const GAS u32x4*)(gp + 8); }
struct OmRegs { float zi, zf, mprev, nst; bf16x8 q[4]; u32x4 k[2], v[2], cc[4], gt[2]; };
__device__ __forceinline__ void om_load(OmRegs& R, const Ctx& c, int item) { const Item it = decode(item);
    R.zi = c.ZG[(size_t)(it.r0 + c.lane) * ZGP + it.h]; R.zf = c.ZG[(size_t)(it.r0 + c.lane) * ZGP + 4 + it.h]; R.mprev = ((const float*)(c.ws + WSO.mst))[item]; R.nst = ((const float*)(c.ws + WSO.nst))[item * 128 + (c.tid & 127)];
    const bf16* zr = c.Z + (size_t)it.r0 * ZWD + it.h * 128;
#pragma unroll
    for (int ks = 0; ks < 4; ++ks) R.q[ks] = *(const GAS bf16x8*)(zr + (size_t)(16 * (c.wave & 3) + (c.lane & 15)) * ZWD + ZQ + 32 * ks + 8 * (c.lane >> 4));
#pragma unroll
    for (int j = 0; j < 2; ++j) { const int id = c.tid + 512 * j, s = id >> 4, cc = id & 15; R.k[j] = *(const GAS u32x4*)(zr + (size_t)s * ZWD + ZK + cc * 8); R.v[j] = *(const GAS u32x4*)(zr + (size_t)s * ZWD + ZV + cc * 8); }
    gate_load<true>(R.gt, c, it);
    const bf16* cs = (const bf16*)(c.ws + WSO.cst) + (size_t)item * 16384;
#pragma unroll
    for (int j = 0; j < 4; ++j) { const int id = c.tid + 512 * j; R.cc[j] = __builtin_nontemporal_load((const GAS u32x4*)(cs + id * 8)); } }
__device__ __forceinline__ void om_stage(const OmRegs& R, const Ctx& c, ldsp Ks, ldsp Vs, ldsp Cs) {
#pragma unroll
    for (int j = 0; j < 2; ++j) { const int id = c.tid + 512 * j, s = id >> 4, cc = id & 15; *(LAS u32x4*)(Ks + s * KP + cc * 16) = R.k[j]; *(LAS u32x4*)(Vs + s * VP + cc * 16) = R.v[j]; }
#pragma unroll
    for (int j = 0; j < 4; ++j) { const int id = c.tid + 512 * j, d = id >> 4, cc = id & 15; *(LAS u32x4*)(Cs + d * VP + cc * 16) = R.cc[j]; }
    if (c.tid < 128) { const int s = c.tid >> 1; unsigned zz = 0u; asm volatile("" : "+v"(zz));
        u32x4 o = {zz, zz, zz, zz}; if ((c.tid & 1) == 0) o[0] = zz + 0x3f80u; *(LAS u32x4*)(Vs + s * VP + 256 + (c.tid & 1) * 16) = o;
        u32x4 o2 = {pkbf(R.nst, 0.f), zz, zz, zz}; *(LAS u32x4*)(Cs + c.tid * VP + 256) = o2; u32x4 z = {zz, zz, zz, zz}; *(LAS u32x4*)(Cs + c.tid * VP + 272) = z; } }
__device__ __forceinline__ void om_compute(const OmRegs& R, const Ctx& c, int item, ldsp Ks, ldsp Vs, ldsp Cs) { const Item it = decode(item);
    const int tt = c.wave & 3, vh = c.wave >> 2, g = c.lane >> 4, li = c.lane & 15; ldsp Sp = c.L + PRIV_OFF + c.wave * PRIV_BYTES; LAS float* Hp = (LAS float*)Sp;
    const LAS float* GB = (const LAS float*)(c.L + GN_OFF) + 1024; const float ip = R.zi + GB[it.h], lf = lsig(R.zf + GB[4 + it.h]); const float bc = wscan_add(lf, c.lane), a = bc + R.mprev, u = ip - bc, pm = wscan_max(u, c.lane), mt = fmaxf(a, bc + pm), rt = bc - mt, wi = __expf(a - mt), emt = __expf(-mt);
    float rtv[4], wiv[4], emv[4];
#pragma unroll
    for (int r = 0; r < 4; ++r) { const int t = 16 * tt + 4 * g + r; rtv[r] = shl(rt, t); wiv[r] = shl(wi, t); emv[r] = shl(emt, t); }
#pragma unroll
    for (int st = 0; st < 4; ++st) { const float us = shl(u, 16 * st + li); f32x4 acc = {0.f, 0.f, 0.f, 0.f};
        if (st <= tt) {
#pragma unroll
            for (int ks = 0; ks < 4; ++ks) acc = mma(R.q[ks], frag_row(Ks, KP, 16 * st, 32 * ks, c.lane), acc); }
#pragma unroll
        for (int r = 0; r < 4; ++r) { const int t = 16 * tt + 4 * g + r, s = 16 * st + li; const float v = (s <= t) ? acc[r] * __expf(rtv[r] + us) : 0.f; *(LAS unsigned short*)(Sp + (4 * g + r) * GP + s * 2) = (unsigned short)f2bf(v); } }
    LDS_WAIT();
    const bf16x8 s0 = frag_row(Sp, GP, 0, 0, c.lane), s1 = frag_row(Sp, GP, 0, 32, c.lane);
    f32x4 hv[5];
#pragma unroll
    for (int q = 0; q < 5; ++q) { const int vt = q < 4 ? 4 * vh + q : 8; f32x4 a1 = {0.f, 0.f, 0.f, 0.f}, a2 = {0.f, 0.f, 0.f, 0.f};
        a1 = mma(s0, frag_tr(Vs, VP, 0, 16 * vt, c.lane), a1); a1 = mma(s1, frag_tr(Vs, VP, 32, 16 * vt, c.lane), a1);
#pragma unroll
        for (int ks = 0; ks < 4; ++ks) a2 = mma(R.q[ks], frag_tr(Cs, VP, 32 * ks, 16 * vt, c.lane), a2);
#pragma unroll
        for (int r = 0; r < 4; ++r) hv[q][r] = a1[r] + wiv[r] * a2[r]; }
    LDS_WAIT();
#pragma unroll
    for (int r = 0; r < 4; ++r) { const float den = shl(hv[4][r], 16 * g); const float sc = 1.f / fmaxf(fabsf(den), emv[r]);
#pragma unroll
        for (int q = 0; q < 4; ++q) Hp[(4 * g + r) * 66 + 16 * q + li] = hv[q][r] * sc; }
    LDS_WAIT();
    tail_out<true>(c, Hp, it.r0, it.h, tt, vh, R.gt[0], R.gt[1]);
}
__device__ __forceinline__ void run_out_mlstm(const Ctx& c, int cu, int G) {
    int item = cu; OmRegs R; if (item < NITEM) om_load(R, c, item); ldsp Ks = c.L, Vs = c.L + 17408, Cs = c.L + 36864;
    for (; item < NITEM; item += G) { BAR_LDS(); om_stage(R, c, Ks, Vs, Cs); OmRegs R2 = R; if (item + G < NITEM) om_load(R, c, item + G); BAR_LDS(); om_compute(R2, c, item, Ks, Vs, Cs); }
    BAR_LDS(); }
struct OgRegs { f32x4 ga[4]; u32x4 q, k; u32x4 v[2], s[2], gt[2]; };
__device__ __forceinline__ void og_load(OgRegs& R, const Ctx& c, int item) { const Item it = decode(item);
#pragma unroll
    for (int q = 0; q < 4; ++q) R.ga[q] = *(const GAS f32x4*)(c.ZG + (size_t)(it.r0 + c.lane) * ZGP + 8 + 4 * q);
    const bf16* zr = c.Z + (size_t)(it.r0 + c.lane) * ZWD + it.h * 64 + c.wave * 8; R.q = *(const GAS u32x4*)(zr + GQ); R.k = *(const GAS u32x4*)(zr + GK);
    gate_load<false>(R.gt, c, it);
    const bf16* ss = (const bf16*)(c.ws + WSO.sst) + (size_t)item * 8192;
#pragma unroll
    for (int j = 0; j < 2; ++j) { const int id = c.tid + 512 * j, s = id >> 4, cc = id & 15; R.v[j] = *(const GAS u32x4*)(c.Z + (size_t)(it.r0 + s) * ZWD + GV + it.h * 128 + cc * 8); R.s[j] = __builtin_nontemporal_load((const GAS u32x4*)(ss + id * 8)); } }
__device__ __forceinline__ void og_stage(const OgRegs& R, const Ctx& c, int item, ldsp Gq, ldsp Gk, ldsp Gv, ldsp Gs) { const Item it = decode(item); float bc[8]; gla_bc_wave(c, R.ga, it.h, bc); u32x4 oq, ok;
#pragma unroll
    for (int q = 0; q < 4; ++q) { const float e0 = bc[2 * q], e1 = bc[2 * q + 1];
        oq[q] = pkbf(bf2f((unsigned short)(R.q[q] & 0xffffu)) * __expf(e0), bf2f((unsigned short)(R.q[q] >> 16)) * __expf(e1));
        ok[q] = pkbf(bf2f((unsigned short)(R.k[q] & 0xffffu)) * __expf(-e0), bf2f((unsigned short)(R.k[q] >> 16)) * __expf(-e1)); }
    *(LAS u32x4*)(Gq + c.lane * GP + c.wave * 16) = oq; *(LAS u32x4*)(Gk + c.lane * GP + c.wave * 16) = ok;
#pragma unroll
    for (int j = 0; j < 2; ++j) { const int id = c.tid + 512 * j, s = id >> 4, cc = id & 15; *(LAS u32x4*)(Gv + s * KP + cc * 16) = R.v[j]; *(LAS u32x4*)(Gs + s * KP + cc * 16) = R.s[j]; } }
__device__ __forceinline__ void og_compute(const Ctx& c, int item, ldsp Gq, ldsp Gk, ldsp Gv, ldsp Gs, u32x4 g0, u32x4 g1) { const Item it = decode(item);
    const int tt = c.wave & 3, vh = c.wave >> 2, g = c.lane >> 4, li = c.lane & 15; ldsp Ap = c.L + PRIV_OFF + c.wave * PRIV_BYTES; LAS float* Hp = (LAS float*)Ap;
    const bf16x8 q0 = frag_row(Gq, GP, 16 * tt, 0, c.lane), q1 = frag_row(Gq, GP, 16 * tt, 32, c.lane);
#pragma unroll
    for (int st = 0; st < 4; ++st) { f32x4 acc = {0.f, 0.f, 0.f, 0.f};
        if (st <= tt) { acc = mma(q0, frag_row(Gk, GP, 16 * st, 0, c.lane), acc); acc = mma(q1, frag_row(Gk, GP, 16 * st, 32, c.lane), acc); }
#pragma unroll
        for (int r = 0; r < 4; ++r) { const int t = 16 * tt + 4 * g + r, s = 16 * st + li; *(LAS unsigned short*)(Ap + (4 * g + r) * GP + s * 2) = (unsigned short)f2bf((s <= t) ? acc[r] : 0.f); } }
    LDS_WAIT();
    const bf16x8 a0 = frag_row(Ap, GP, 0, 0, c.lane), a1 = frag_row(Ap, GP, 0, 32, c.lane); f32x4 hv[4];
#pragma unroll
    for (int q = 0; q < 4; ++q) { const int vt = 4 * vh + q; f32x4 acc = {0.f, 0.f, 0.f, 0.f};
        acc = mma(a0, frag_tr(Gv, KP, 0, 16 * vt, c.lane), acc); acc = mma(a1, frag_tr(Gv, KP, 32, 16 * vt, c.lane), acc);
        acc = mma(q0, frag_tr(Gs, KP, 0, 16 * vt, c.lane), acc); acc = mma(q1, frag_tr(Gs, KP, 32, 16 * vt, c.lane), acc); hv[q] = acc; }
    LDS_WAIT();
#pragma unroll
    for (int q = 0; q < 4; ++q)
#pragma unroll
        for (int r = 0; r < 4; ++r) Hp[(4 * g + r) * 66 + 16 * q + li] = hv[q][r];
    LDS_WAIT();
    tail_out<false>(c, Hp, it.r0, it.h, tt, vh, g0, g1);
}
__device__ __forceinline__ void run_out_gla(const Ctx& c, int cu, int G) {
    int item = cu; OgRegs R; if (item < NITEM) og_load(R, c, item); ldsp Gq = c.L, Gk = c.L + 9216, Gv = c.L + 18432, Gs = c.L + 35840;
    for (; item < NITEM; item += G) { BAR_LDS(); og_stage(R, c, item, Gq, Gk, Gv, Gs); const u32x4 g0 = R.gt[0], g1 = R.gt[1]; if (item + G < NITEM) og_load(R, c, item + G); BAR_LDS(); og_compute(c, item, Gq, Gk, Gv, Gs, g0, g1); }
    BAR_LDS(); }
__device__ __forceinline__ void phase_local(const Ctx& c, int cu, int G) {
    load_wa(c);
    if (cu & 1) { run_local_mlstm(c, cu, G); run_local_gla(c, cu, G); }
    for (int it = cu; it < 512; it += G) sample_mlstm(c, it);
    for (int it = cu; it < 512; it += G) sample_gla(c, it);
    if (!(cu & 1)) { BAR_LDS(); run_local_mlstm(c, cu, G); run_local_gla(c, cu, G); }
}
__device__ __forceinline__ void phase_out(const Ctx& c, int cu, int G) { load_wa(c); run_out_mlstm(c, cu, G); run_out_gla(c, cu, G);
#ifdef MK_X2_OM
    run_out_mlstm(c, cu, G);
#endif
#ifdef MK_X2_OG
    run_out_gla(c, cu, G);
#endif
}
}
#undef BAR_LDS
namespace xa {
using mx::bf16x8; using mx::f32x4; using mx::u32x4; using mx::u32x2; using mx::ldsp; using mx::mma; using mx::frag_row; using mx::frag_tr; using mx::bf2f;
#define BAR_LDS() do { asm volatile("s_waitcnt lgkmcnt(0)" ::: "memory"); __builtin_amdgcn_s_barrier(); asm volatile("" ::: "memory"); } while (0)
constexpr int CP = 528;
constexpr int CB_BYTES = 64 * CP;
constexpr int SC_OFF = 2 * CB_BYTES, PL_OFF = SC_OFF + 4096, PLP = 528;
__device__ __forceinline__ void pa_load(u32x4 (&pre)[4], const mx::Ctx& c, int item, int i, int tid) {
    const int b = item >> 5, h = (item >> 3) & 3; const bf16* p; int pitch;
    if (i < 4) { p = (const bf16*)(c.ws + WSO.kb) + (size_t)(b * 256 + 64 * i) * 1024 + h * 256; pitch = 1024; } else { p = (const bf16*)(c.ws + WSO.vt) + (size_t)((b * 4 + h) * 256 + 64 * (i - 4)) * 256; pitch = 256; }
#pragma unroll
    for (int j = 0; j < 4; ++j) { const int id = tid + 512 * j, s = id >> 5, ch = id & 31; pre[j] = *(const GAS u32x4*)(p + (size_t)s * pitch + ch * 8); }
}
__device__ __forceinline__ void pa_store(ldsp buf, const u32x4 (&pre)[4], int tid) {
#pragma unroll
    for (int j = 0; j < 4; ++j) { const int id = tid + 512 * j, s = id >> 5, ch = id & 31; *(LAS u32x4*)(buf + s * CP + ch * 16) = pre[j]; }
}
__device__ __forceinline__ void prompt_stream(const mx::Ctx& c, int cu, int G) {
    ldsp B0 = c.L, B1 = c.L + CB_BYTES; int item = cu; if (item >= 256) return;
    u32x4 pre[4]; pa_load(pre, c, item, 0, c.tid); pa_store(B0, pre, c.tid); BAR_LDS();
    const bf16* Q = (const bf16*)(c.ws + WSO.q); bf16* O = (bf16*)(c.ws + WSO.o); const int g = c.lane >> 4, li = c.lane & 15;
    for (; item < 256; item += G) {
        const int b = item >> 5, h = (item >> 3) & 3, qb = item & 7, row0 = b * 2048 + qb * 256 + c.wave * 32, nxt = item + G;
        bf16x8 qf[2][8];
#pragma unroll
        for (int mt = 0; mt < 2; ++mt)
#pragma unroll
            for (int ks = 0; ks < 8; ++ks) qf[mt][ks] = __builtin_nontemporal_load((const GAS bf16x8*)(Q + (size_t)(row0 + 16 * mt + li) * 1024 + h * 256 + 32 * ks + 8 * g));
        f32x4 sc[2][16]; u32x4 pf[2][8]; float rinv[2] = {0.f, 0.f};
#pragma unroll
        for (int i = 0; i < 8; ++i) {
            ldsp cur = (i & 1) ? B1 : B0; ldsp oth = (i & 1) ? B0 : B1; const bool have_next = (i < 7) || (nxt < 256);
            if (have_next) pa_load(pre, c, i < 7 ? item : nxt, i < 7 ? i + 1 : 0, c.tid);
            if (i < 4) {
#pragma unroll
                for (int nt = 0; nt < 4; ++nt) { f32x4 a0 = {0.f, 0.f, 0.f, 0.f}, a1 = {0.f, 0.f, 0.f, 0.f};
#pragma unroll
                    for (int ks = 0; ks < 8; ++ks) { const bf16x8 kf = frag_row(cur, CP, 16 * nt, 32 * ks, c.lane); a0 = mma(kf, qf[0][ks], a0); a1 = mma(kf, qf[1][ks], a1); }
                    sc[0][i * 4 + nt] = a0; sc[1][i * 4 + nt] = a1; }
                if (i == 3) {
#pragma unroll
                    for (int mt = 0; mt < 2; ++mt) { float m = sc[mt][0][0];
#pragma unroll
                        for (int tl = 0; tl < 16; ++tl)
#pragma unroll
                            for (int r = 0; r < 4; ++r) m = fmaxf(m, sc[mt][tl][r]);
                        m = fmaxf(m, shx(m, 16)); m = fmaxf(m, shx(m, 32)); float s = 0.f;
#pragma unroll
                        for (int tl = 0; tl < 16; ++tl)
#pragma unroll
                            for (int r = 0; r < 4; ++r) { sc[mt][tl][r] = __expf(sc[mt][tl][r] - m); s += sc[mt][tl][r]; }
                        s += shx(s, 16); s += shx(s, 32); rinv[mt] = 1.f / s;
#pragma unroll
                        for (int ks = 0; ks < 8; ++ks) { pf[mt][ks][0] = pk2(sc[mt][2 * ks][0], sc[mt][2 * ks][1]); pf[mt][ks][1] = pk2(sc[mt][2 * ks][2], sc[mt][2 * ks][3]); pf[mt][ks][2] = pk2(sc[mt][2 * ks + 1][0], sc[mt][2 * ks + 1][1]); pf[mt][ks][3] = pk2(sc[mt][2 * ks + 1][2], sc[mt][2 * ks + 1][3]); } }
                }
            } else {
                const int dc = i - 4;
#pragma unroll
                for (int nt = 0; nt < 4; ++nt) { f32x4 a0 = {0.f, 0.f, 0.f, 0.f}, a1 = {0.f, 0.f, 0.f, 0.f}; ldsp ar = cur + (16 * nt + li) * CP + 8 * g;
#pragma unroll
                    for (int ks = 0; ks < 8; ++ks) { const u32x2 lo = *(const LAS u32x2*)(ar + 64 * ks), hi = *(const LAS u32x2*)(ar + 64 * ks + 32); const u32x4 av = {lo[0], lo[1], hi[0], hi[1]};
                        a0 = mma(__builtin_bit_cast(bf16x8, av), __builtin_bit_cast(bf16x8, pf[0][ks]), a0); a1 = mma(__builtin_bit_cast(bf16x8, av), __builtin_bit_cast(bf16x8, pf[1][ks]), a1); }
                    u32x2 o; o[0] = pk2(a0[0] * rinv[0], a0[1] * rinv[0]); o[1] = pk2(a0[2] * rinv[0], a0[3] * rinv[0]);
                    *(GAS u32x2*)(O + (size_t)(row0 + li) * 1024 + h * 256 + 64 * dc + 16 * nt + 4 * g) = o;
                    o[0] = pk2(a1[0] * rinv[1], a1[1] * rinv[1]); o[1] = pk2(a1[2] * rinv[1], a1[3] * rinv[1]);
                    *(GAS u32x2*)(O + (size_t)(row0 + 16 + li) * 1024 + h * 256 + 64 * dc + 16 * nt + 4 * g) = o; }
            }
            if (have_next) pa_store(oth, pre, c.tid);
            BAR_LDS();
        }
    }
}
__device__ __forceinline__ void sa_load(f32x4 (&pre)[8], const mx::Ctx& c, int item, int i, int tid) {
    const int b = item >> 2, h = item & 3; const float* p = (i < 4 ? c.in[nv::I_CK] : c.in[nv::I_CV]) + ((size_t)(b * 256 + 64 * (i & 3)) * 4 + h) * 256;
#pragma unroll
    for (int j = 0; j < 8; ++j) { const int id = tid + 512 * j, key = id >> 6, c4 = id & 63; pre[j] = __builtin_nontemporal_load((const GAS f32x4*)(p + (size_t)key * 1024 + 4 * c4)); }
}
__device__ __forceinline__ void sa_store(ldsp buf, const f32x4 (&pre)[8], int tid) {
#pragma unroll
    for (int j = 0; j < 8; ++j) { const int id = tid + 512 * j, key = id >> 6, c4 = id & 63; u32x2 o; o[0] = pk2(pre[j][0], pre[j][1]); o[1] = pk2(pre[j][2], pre[j][3]); *(LAS u32x2*)(buf + key * CP + c4 * 8) = o; }
}
__device__ __forceinline__ void sample_stream(const mx::Ctx& c, int cu, int G) {
    ldsp B0 = c.L, B1 = c.L + CB_BYTES; LAS float* SCs = (LAS float*)(c.L + SC_OFF); ldsp Pl = c.L + PL_OFF; int item = cu; if (item >= 512) return;
    for (int i = c.tid; i < 16 * PLP / 4; i += 512) ((LAS unsigned*)Pl)[i] = 0u;
    f32x4 preA[8], preB[8];
    sa_load(preA, c, item, 0, c.tid); sa_load(preB, c, item, 1, c.tid); sa_store(B0, preA, c.tid); BAR_LDS();
    const bf16* Q = (const bf16*)(c.ws + WSO.q); bf16* O = (bf16*)(c.ws + WSO.o); const int g = c.lane >> 4, li = c.lane & 15;
    for (; item < 512; item += G) {
        const int b = item >> 2, h = item & 3, r0 = 16384 + 4 * b, nxt = item + G;
        bf16x8 qf[8];
#pragma unroll
        for (int ks = 0; ks < 8; ++ks) { u32x4 v = {0u, 0u, 0u, 0u}; if (li < 4) v = *(const GAS u32x4*)(Q + (size_t)(r0 + li) * 1024 + h * 256 + 32 * ks + 8 * g); qf[ks] = __builtin_bit_cast(bf16x8, v); }
        f32x4 oacc[2] = {{0.f, 0.f, 0.f, 0.f}, {0.f, 0.f, 0.f, 0.f}};
#pragma unroll
        for (int i = 0; i < 8; ++i) {
            ldsp cur = (i & 1) ? B1 : B0; ldsp oth = (i & 1) ? B0 : B1;
            const bool have1 = (i < 7) || (nxt < 512), have2 = (i < 6) || (nxt < 512);
            if (have2) { if (i & 1) sa_load(preB, c, i < 6 ? item : nxt, i < 6 ? i + 2 : i - 6, c.tid); else sa_load(preA, c, i < 6 ? item : nxt, i < 6 ? i + 2 : i - 6, c.tid); }
            if (i < 4) {
                if (c.wave < 4) { f32x4 acc = {0.f, 0.f, 0.f, 0.f};
#pragma unroll
                    for (int ks = 0; ks < 8; ++ks) acc = mma(frag_row(cur, CP, 16 * c.wave, 32 * ks, c.lane), qf[ks], acc);
                    if (li < 4) *(LAS f32x4*)(SCs + li * 256 + 64 * i + 16 * c.wave + 4 * g) = acc; }
            } else {
                if (i == 4) {
                    if (c.wave < 4) { const f32x4 s = *(const LAS f32x4*)(SCs + c.wave * 256 + 4 * c.lane); const float m = mx::wmax(fmaxf(fmaxf(s[0], s[1]), fmaxf(s[2], s[3])));
                        const float p0 = __expf(s[0] - m), p1 = __expf(s[1] - m), p2 = __expf(s[2] - m), p3 = __expf(s[3] - m); const float inv = 1.f / mx::wsum((p0 + p1) + (p2 + p3));
                        u32x2 o; o[0] = pk2(p0 * inv, p1 * inv); o[1] = pk2(p2 * inv, p3 * inv); *(LAS u32x2*)(Pl + c.wave * PLP + c.lane * 8) = o; }
                    BAR_LDS();
                }
                const int vc = i - 4;
#pragma unroll
                for (int q = 0; q < 2; ++q)
#pragma unroll
                    for (int ks = 0; ks < 2; ++ks) oacc[q] = mma(frag_row(Pl, PLP, 0, 64 * vc + 32 * ks, c.lane), frag_tr(cur, CP, 32 * ks, 16 * (2 * c.wave + q), c.lane), oacc[q]);
                if (i == 7 && g == 0) {
#pragma unroll
                    for (int q = 0; q < 2; ++q)
#pragma unroll
                        for (int r = 0; r < 4; ++r) O[(size_t)(r0 + r) * 1024 + h * 256 + 16 * (2 * c.wave + q) + li] = (bf16)f2bf(oacc[q][r]); }
            }
            if (have1) { if (i & 1) sa_store(oth, preA, c.tid); else sa_store(oth, preB, c.tid); }
            BAR_LDS();
        }
    }
}
__device__ __forceinline__ void phase_attn(const mx::Ctx& c, int cu, int G) {
#ifdef MK_X2_PROMPT
    prompt_stream(c, cu, G); __syncthreads();
#endif
#ifdef MK_X2_SAMPLE
    sample_stream(c, cu, G); __syncthreads();
#endif
    if ((G & 1) == 0) { if (cu & 1) prompt_stream(c, cu >> 1, G >> 1); else sample_stream(c, cu >> 1, G >> 1); }
    else { prompt_stream(c, cu, G); __syncthreads(); sample_stream(c, cu, G); }
}
}
namespace sg {
using mx::bf16x8; using mx::f32x4; using mx::u32x2; using mx::ldsp; using mx::mma;
template <int MODE> __device__ __forceinline__ void small_gemm(ldsp L, unsigned char* ws, const bf16* A, const bf16* Bt, int K, float alpha, const float* base0, int tile, int tid, int lane, int wave, float* yout = nullptr) {
    const int rt = tile >> 4, ct = tile & 15, row0 = PROWS + 32 * rt, col0 = 64 * ct, kw = K >> 3, kbeg = wave * kw, nks = kw >> 5;
    f32x4 acc[2][4];
#pragma unroll
    for (int m = 0; m < 2; ++m)
#pragma unroll
        for (int n = 0; n < 4; ++n) acc[m][n] = (f32x4){0.f, 0.f, 0.f, 0.f};
    const bf16* ap = A + (size_t)(row0 + (lane & 15)) * K + kbeg + 8 * (lane >> 4); const bf16* bp = Bt + (size_t)(col0 + (lane & 15)) * K + kbeg + 8 * (lane >> 4);
#pragma unroll 4
    for (int ks = 0; ks < nks; ++ks) { bf16x8 a[2], b[4];
#pragma unroll
        for (int m = 0; m < 2; ++m) a[m] = *(const GAS bf16x8*)(ap + (size_t)(16 * m) * K + 32 * ks);
#pragma unroll
        for (int n = 0; n < 4; ++n) b[n] = *(const GAS bf16x8*)(bp + (size_t)(16 * n) * K + 32 * ks);
#pragma unroll
        for (int m = 0; m < 2; ++m)
#pragma unroll
            for (int n = 0; n < 4; ++n) acc[m][n] = mma(a[m], b[n], acc[m][n]); }
    LAS float* P = (LAS float*)L + wave * 2048;
#pragma unroll
    for (int m = 0; m < 2; ++m)
#pragma unroll
        for (int n = 0; n < 4; ++n)
#pragma unroll
            for (int r = 0; r < 4; ++r) P[(16 * m + 4 * (lane >> 4) + r) * 64 + 16 * n + (lane & 15)] = acc[m][n][r];
    __syncthreads();
    { const int r = tid >> 4, c4 = (tid & 15) * 4; f32x4 s = {0.f, 0.f, 0.f, 0.f};
#pragma unroll
      for (int w = 0; w < 8; ++w) s += *(const LAS f32x4*)((LAS float*)L + w * 2048 + r * 64 + c4);
      const int row = row0 + r, col = col0 + c4;
      if (MODE == 0) { bf16* XBp = (bf16*)(ws + WSO.xb) + (size_t)row * DM + col; f32x4 bs;
          if (base0) bs = *(const GAS f32x4*)(base0 + (size_t)(row - PROWS) * DM + col);
          else { const u32x2 w = *(const GAS u32x2*)XBp; bs[0] = __uint_as_float(w[0] << 16); bs[1] = __uint_as_float(w[0] & 0xffff0000u); bs[2] = __uint_as_float(w[1] << 16); bs[3] = __uint_as_float(w[1] & 0xffff0000u); }
          const f32x4 o = bs + s * alpha; u32x2 pk; pk.x = pk2(o[0], o[1]); pk.y = pk2(o[2], o[3]); *(GAS u32x2*)XBp = pk;
          float q = (o[0] * o[0] + o[1] * o[1]) + (o[2] * o[2] + o[3] * o[3]); q += shx(q, 1); q += shx(q, 2); q += shx(q, 4); q += shx(q, 8);
          if ((tid & 15) == 0) ((float*)(ws + WSO.ssq))[(size_t)row * 16 + ct] = q; }
      else if (MODE == 2) { const bf16* XBp = (const bf16*)(ws + WSO.xb) + (size_t)row * DM + col; const u32x2 w = *(const GAS u32x2*)XBp;
          const f32x4 bs = {__uint_as_float(w[0] << 16), __uint_as_float(w[0] & 0xffff0000u), __uint_as_float(w[1] << 16), __uint_as_float(w[1] & 0xffff0000u)}; const f32x4 o = bs + s * alpha;
          float q = (o[0] * o[0] + o[1] * o[1]) + (o[2] * o[2] + o[3] * o[3]); q += shx(q, 1); q += shx(q, 2); q += shx(q, 4); q += shx(q, 8);
          float* SSQ = (float*)(ws + WSO.ssq); if ((tid & 15) == 0) __hip_atomic_store((unsigned*)(SSQ + (size_t)row * 16 + ct), __float_as_uint(q), __ATOMIC_RELAXED, __HIP_MEMORY_SCOPE_AGENT);
          asm volatile("s_waitcnt vmcnt(0)" ::: "memory"); unsigned* cnt = (unsigned*)(ws + WSO.ctl) + pg8::CW_PANEL + 64 * (64 + rt);
          if (lane == 0) __hip_atomic_fetch_add(cnt, 1u, __ATOMIC_RELAXED, __HIP_MEMORY_SCOPE_AGENT);
          pg8::panel_wait(cnt, 128u, wave, lane);
          float ss = 0.f; { const unsigned long long* sp = (const unsigned long long*)(SSQ + (size_t)row * 16);
#pragma unroll
              for (int j = 0; j < 8; ++j) { const unsigned long long v = __hip_atomic_load(sp + j, __ATOMIC_RELAXED, __HIP_MEMORY_SCOPE_AGENT); ss += __uint_as_float((unsigned)v) + __uint_as_float((unsigned)(v >> 32)); } }
          const float rs = rsqrtf(ss * (1.0f / DM) + 1e-6f); const f32x4 gv = *(const GAS f32x4*)(base0 + col);
          *(GAS f32x4*)(yout + (size_t)row * DM + col) = o * rs * gv; }
      else { const GAS f32x4* sp = (const GAS f32x4*)((const float*)(ws + WSO.ssq) + (size_t)row * 16); const f32x4 s0 = sp[0], s1 = sp[1], s2 = sp[2], s3 = sp[3];
          const float ss = ((s0[0] + s0[1]) + (s0[2] + s0[3])) + ((s1[0] + s1[1]) + (s1[2] + s1[3])) + ((s2[0] + s2[1]) + (s2[2] + s2[3])) + ((s3[0] + s3[1]) + (s3[2] + s3[3]));
          const float rs = rsqrtf(ss * (1.0f / DM) + 1e-6f); u32x2 pk; pk.x = pk2(s[0] * rs, s[1] * rs); pk.y = pk2(s[2] * rs, s[3] * rs); *(GAS u32x2*)((bf16*)(ws + WSO.q) + (size_t)row * DM + col) = pk; } }
    __syncthreads();
}
}
#define MK_PROGRAM launch_mk(hs, 0, MK_NSTEPS, li, stream);
#ifndef MK_SP2_SINGLE
#define MK_SP2_SINGLE true
#endif
#ifndef MK_SEQ0
#define MK_SEQ0 0x00DCBA9876543210ull
#define MK_SEQ1 0ull
#define MK_REPBITS 0u
#define MK_NSTEPS 14
#endif

__global__ void __launch_bounds__(NWAVES * 64, 2) mk_fwd(Args args) {
    extern __shared__ __attribute__((aligned(16))) unsigned char lds[];
    volatile LAS unsigned* MISC = (volatile LAS unsigned*)((LAS unsigned char*)lds + MISC_OFF);
    gu32* ctl = (gu32*)(args.ws + WSO.ctl);
    for (int u = threadIdx.x; u < (LDS_BYTES - LDSCTL_OFF) / 4; u += NWAVES * 64) ((LAS unsigned*)((LAS unsigned char*)lds + LDSCTL_OFF))[u] = 0u;
    __syncthreads();
    XcdBarrier bar = xcd_barrier_post((unsigned*)(ctl + CW_BAR) + args.li * XCD_BAR_WORDS, MISC + 8);
    constexpr nv::Ws w = WSO; const int wave_s = __builtin_amdgcn_readfirstlane((int)threadIdx.x >> 6);
    for (int pi = args.ph_lo; pi < args.ph_hi; ++pi) {
        const int ph = (int)(((pi < 16 ? MK_SEQ0 : MK_SEQ1) >> (4 * (pi & 15))) & 15ull); const int rep = (int)((MK_REPBITS >> pi) & 1u);
        int tid_ = wave_s * 64 + (int)__builtin_amdgcn_mbcnt_hi(~0u, __builtin_amdgcn_mbcnt_lo(~0u, 0u)); asm volatile("" : "+v"(tid_));     unsigned char* ws = args.ws; asm volatile("" : "+s"(ws)); int zoff_ = 0; asm volatile("" : "+s"(zoff_)); const float* const* inp = args.in + zoff_;     float* outp = args.out; asm volatile("" : "+s"(outp));
        Frame F; F.lds = (LAS unsigned char*)lds; F.tid = tid_; F.lane = F.tid & 63; F.wave = __builtin_amdgcn_readfirstlane(F.tid >> 6);
        F.G = gridDim.x; { const int bx = blockIdx.x; F.vcu = (F.G % 8 == 0) ? (bx % 8) * (F.G / 8) + bx / 8 : bx; }
        const float* SSQ = (const float*)(ws + w.ssq);
        switch (ph) {
#ifndef MK_NO_PRO
        case PH_PROLOGUE: p0_prologue(F, inp, ws); break;
#endif
#ifndef MK_NO_UP
        case PH_UP1: case PH_UP2: {
            pg8::Gemm g{(const pg8::bf16_t*)(ws + w.xb), (const pg8::bf16_t*)(ws + (ph == PH_UP1 ? w.wgu1 : w.wgu2)), MROWS, 2 * DFF, DM}; pg8::StaticOrder S; S.init(MROWS, 2 * DFF, F.G, (int)blockIdx.x);
            PG8_LAS float* rsl = (PG8_LAS float*)(F.lds + RSL_OFF); pg8::rstd_to_lds(rsl, SSQ, S, F.tid);
            pg8::EpiSwigluL E{(pg8::bf16_t*)(ws + w.r1), rsl, DFF, 0};
            pg8::gemm_phase<pg8::EpiSwigluL, pg8::StaticOrder, true, true>(F.lds + RING_OFF, g, S, E, F.tid);
            if (ph == PH_UP1) {
                pg8::Gemm g2{(const pg8::bf16_t*)(ws + w.memb), (const pg8::bf16_t*)(ws + w.wkv), MEMROWS, 2 * DM, DM}; pg8::StaticOrder S2;
                const int rem = ((MROWS / 256) * (2 * DFF / 256)) % F.G; S2.init(MEMROWS, 2 * DM, F.G, ((int)blockIdx.x + F.G - rem) % F.G);
                pg8::EpiKV E2{outp + OUTO.mk, outp + OUTO.mv, (pg8::bf16_t*)(ws + w.kb), (pg8::bf16_t*)(ws + w.vt), (const float*)(ws + w.mssq)};
                pg8::gemm_phase<pg8::EpiKV, pg8::StaticOrder, true, true>(F.lds + RING_OFF, g2, S2, E2, F.tid);
            }
            break; }
#endif
#ifndef MK_NO_RES
        case PH_DOWN1: case PH_WOUT: case PH_WO: case PH_DOWN2: {
            const bool down = (ph == PH_DOWN1 || ph == PH_DOWN2);
            const size_t aoff = down ? w.r1 : (ph == PH_WOUT ? w.ymix : w.o), boff = ph == PH_DOWN1 ? w.wd1 : ph == PH_DOWN2 ? w.wd2 : ph == PH_WOUT ? w.wout : w.wo;
            const int KK = down ? DFF : DM; const float alpha = (rep && ph != PH_DOWN1) ? 0.f : (down ? 0.5f : 1.0f);
            pg8::Gemm g{(const pg8::bf16_t*)(ws + aoff), (const pg8::bf16_t*)(ws + boff), PROWS, DM, KK}; pg8::StaticOrder S; S.init(PROWS, DM, F.G, (int)blockIdx.x);
#ifdef MK_FUSED_FINAL
            if (ph == PH_DOWN2 && !rep && F.G == 256) {
                pg8::EpiResidFinal EF{(const pg8::bf16_t*)(ws + w.xb), (float*)(ws + w.ssq), outp + OUTO.yp, inp[nv::I_FING], (unsigned*)(ws + w.ctl) + pg8::CW_PANEL, alpha, 0};
                pg8::gemm_phase<pg8::EpiResidFinal, pg8::StaticOrder, false, true>(F.lds + RING_OFF, g, S, EF, F.tid);
                sg::small_gemm<2>(F.lds, ws, (const bf16*)(ws + aoff), (const bf16*)(ws + boff), KK, alpha, inp[nv::I_FING], (int)blockIdx.x, F.tid, F.lane, F.wave, outp + OUTO.yp);
                break; }
#endif
            pg8::EpiResid E{inp[nv::I_XP], inp[nv::I_XS], (float*)(ws + w.xf), (pg8::bf16_t*)(ws + w.xb), (float*)(ws + w.ssq), alpha, ph == PH_DOWN1 ? 1 : 0};
            pg8::gemm_phase<pg8::EpiResid, pg8::StaticOrder, true, MK_SP2_SINGLE>(F.lds + RING_OFF, g, S, E, F.tid);
            for (int tl = (int)blockIdx.x; tl < 256; tl += F.G) sg::small_gemm<0>(F.lds, ws, (const bf16*)(ws + aoff), (const bf16*)(ws + boff), KK, alpha, nullptr, tl, F.tid, F.lane, F.wave);
#ifdef MK_X2_SMALL
            for (int tl = (int)blockIdx.x; tl < 256; tl += F.G) sg::small_gemm<0>(F.lds, ws, (const bf16*)(ws + aoff), (const bf16*)(ws + boff), KK, 0.f, nullptr, tl, F.tid, F.lane, F.wave);
#endif
            break; }
#endif
#ifndef MK_NO_WIN
        case PH_WIN: {
            pg8::Gemm g{(const pg8::bf16_t*)(ws + w.xb), (const pg8::bf16_t*)(ws + w.win), MROWS, WIN_N, DM}; pg8::StaticOrder S; S.init(MROWS, WIN_N, F.G, (int)blockIdx.x);
            PG8_LAS float* rsl = (PG8_LAS float*)(F.lds + RSL_OFF); pg8::rstd_to_lds(rsl, SSQ, S, F.tid);
            pg8::EpiZL E{(pg8::bf16_t*)(ws + w.r1), (float*)(ws + w.zg), rsl};
            pg8::gemm_phase<pg8::EpiZL, pg8::StaticOrder, true, true>(F.lds + RING_OFF, g, S, E, F.tid);
            break; }
#endif
#ifndef MK_NO_Q
        case PH_Q: {
            pg8::Gemm g{(const pg8::bf16_t*)(ws + w.xb), (const pg8::bf16_t*)(ws + w.wq), PROWS, DM, DM}; pg8::StaticOrder S; S.init(PROWS, DM, F.G, (int)blockIdx.x);
            pg8::EpiQ E{(pg8::bf16_t*)(ws + w.q), SSQ};
            pg8::gemm_phase<pg8::EpiQ, pg8::StaticOrder, true, MK_SP2_SINGLE>(F.lds + RING_OFF, g, S, E, F.tid);
            for (int tl = (int)blockIdx.x; tl < 256; tl += F.G) sg::small_gemm<1>(F.lds, ws, (const bf16*)(ws + w.xb), (const bf16*)(ws + w.wq), DM, 1.f, nullptr, tl, F.tid, F.lane, F.wave);
            break; }
#endif
#ifndef MK_NO_MIX
        case PH_MIX_LOCAL: case PH_MIX_SCAN: case PH_MIX_OUT: {
            mx::Ctx c{(const bf16*)(ws + w.r1), (const float*)(ws + w.zg), ws, inp, outp, F.lds, F.tid, F.lane, F.wave, 0};
            if (ph == PH_MIX_LOCAL) m2::phase_local(c, (int)blockIdx.x, F.G); else if (ph == PH_MIX_SCAN) mx::scan_phase(c, (int)blockIdx.x * 512 + F.tid, F.G * 512); else m2::phase_out(c, (int)blockIdx.x, F.G);
            break; }
#endif
#ifndef MK_NO_ATTN
        case PH_ATTN: {
            mx::Ctx c{(const bf16*)(ws + w.r1), (const float*)(ws + w.zg), ws, inp, outp, F.lds, F.tid, F.lane, F.wave, 0};
            xa::phase_attn(c, (int)blockIdx.x, F.G);
            break; }
#endif
#ifndef MK_NO_FIN
        case PH_FINAL: p_final(F, inp, outp, ws); break;
#endif
        default: break;
        }
        if (pi + 1 < args.ph_hi) { XcdBarrier b2 = bar; asm volatile("" : "+s"(b2.bar), "+s"(b2.x)); xcd_barrier(b2);
#ifdef MK_X2_BARRIER
            xcd_barrier(b2);
#endif
        }
    }
}

struct HostState { int grid; Args a; };
static void launch_mk(HostState& hs, int lo, int hi, int& li, hipStream_t stream) {
    hs.a.ph_lo = lo; hs.a.ph_hi = hi; hs.a.li = li++;
    hipLaunchKernelGGL(mk_fwd, dim3(hs.grid), dim3(NWAVES * 64), LDS_BYTES, stream, hs.a);
    const hipError_t le = hipPeekAtLastError(); if (le != hipSuccess) fprintf(stderr, "kernel_launch: launch [%d,%d) failed: %s\n", lo, hi, hipGetErrorName(le));
}
extern "C" void kernel_launch(void* const* d_in, const int* in_sizes, int n_in, void* d_out, int out_size, void* d_ws, size_t ws_size, hipStream_t stream) {
    static HostState hs; static int ready = 0;
    if (ready == 0) {
        if (n_in != 33 || (long)out_size != OUTO.total || ws_size < WSO.total) { fprintf(stderr, "kernel_launch: unexpected n_in %d / out_size %d / ws %zu (need %zu)\n", n_in, out_size, ws_size, (size_t)WSO.total); ready = -1; return; }
        int dev = 0, cus = 0;
        if (hipGetDevice(&dev) != hipSuccess || hipDeviceGetAttribute(&cus, hipDeviceAttributeMultiprocessorCount, dev) != hipSuccess) { ready = -1; return; }
        if (hipFuncSetAttribute((const void*)mk_fwd, hipFuncAttributeMaxDynamicSharedMemorySize, LDS_BYTES) != hipSuccess) { fprintf(stderr, "kernel_launch: hipFuncSetAttribute failed\n"); ready = -1; return; }
        (void)hipGetLastError();
        hs.grid = cus; ready = 1;
    }
    if (ready < 0) return;
    memset(&hs.a, 0, sizeof(hs.a));
    for (int i = 0; i < 33; ++i) hs.a.in[i] = (const float*)d_in[i];
    hs.a.out = (float*)d_out; hs.a.ws = (unsigned char*)d_ws;
    if (hipMemsetAsync((char*)d_ws + WSO.ctl, 0, CTL_ZERO_BYTES, stream) != hipSuccess) { fprintf(stderr, "kernel_launch: memset failed\n"); return; }
    int li = 0;
    MK_PROGRAM
}
```

```cpp
#include <hip/hip_runtime.h>
#include <cstdio>
#include <cstdint>
#include <cstring>
#include <cmath>
#ifdef __HIPCC__
#define SHD __host__ __device__ __forceinline__
#else
#define SHD inline
#include <cmath>
#endif
namespace nv {
typedef unsigned short bf16_t;
SHD float bf2f(bf16_t v) { union { unsigned u; float f; } x; x.u = (unsigned)v << 16; return x.f; }
SHD bf16_t f2bf(float f) { union { unsigned u; float f; } x; x.f = f; return (bf16_t)((x.u + 0x7fffu + ((x.u >> 16) & 1u)) >> 16); }
struct Dm { int D, B, T, SB, ST, MLH, DK, DV, GH, GDK, GDV, RANK, NMEM, XH, XDH, FF, DIN, pad; float eps, tau; };
SHD long rows_of(const Dm& d) { return (long)d.B * d.T + (long)d.SB * d.ST; }
constexpr int ZGP = 32, NSSQ = 16;
}

namespace nv {
struct Ws {
  size_t ctl, wgu1, wd1, win, wout, wq, wkv, wo, wgu2, wd2, ssq, mssq, memb, kb, vt, xb, xf, zg, r1, r2, ymix, total;
  size_t q, o, hr, pn, al, fd, iw, mt, s, st2;
  size_t cloc, nloc, mloc, sloc, gdec, cst, nst, mst, sst;
};
constexpr int WIN_NPAD = 256;
struct Carver { size_t c; constexpr size_t al(size_t bytes) { const size_t p = c; c += (bytes + 255) / 256 * 256; return p; } };
constexpr Ws carve_ws(const Dm& d) { Ws w{}; const size_t M = (size_t)d.B * d.T + (size_t)d.SB * d.ST; Carver a{0};
  const size_t ZWc = (size_t)(2 * d.MLH * d.DK + 2 * d.MLH * d.DV + 2 * d.GH * d.GDK + 2 * d.GH * d.GDV); const size_t D = d.D, FF = d.FF; const size_t winN = (ZWc + ZGP + WIN_NPAD - 1) / WIN_NPAD * WIN_NPAD;
  w.ctl = a.al(1 << 20); w.wgu1 = a.al(2 * FF * D * 2); w.wd1 = a.al(D * FF * 2); w.win = a.al(winN * D * 2); w.wout = a.al(D * D * 2); w.wq = a.al(D * D * 2); w.wkv = a.al(2 * D * D * 2); w.wo = a.al(D * D * 2); w.wgu2 = a.al(2 * FF * D * 2); w.wd2 = a.al(D * FF * 2);
  w.ssq = a.al(M * NSSQ * 4); w.mssq = a.al((size_t)d.B * d.NMEM * 4); w.memb = a.al((size_t)d.B * d.NMEM * D * 2); w.kb = a.al((size_t)d.B * d.NMEM * D * 2); w.vt = a.al((size_t)d.B * d.NMEM * D * 2);
  w.xb = a.al(M * D * 2); w.xf = a.al(M * D * 4); w.zg = a.al(M * ZGP * 4);
  size_t r1 = M * FF * 2; if (M * ZWc * 2 > r1) r1 = M * ZWc * 2; if (2 * M * D * 2 + 256 > r1) r1 = 2 * M * D * 2 + 256; w.r1 = a.al(r1); w.q = w.r1; w.o = w.r1 + (M * D * 2 + 255) / 256 * 256;
  const size_t NCH = (size_t)d.B * (d.T / 64 > 0 ? d.T / 64 : 1);
  const size_t r2s = a.c; w.r2 = a.c;
  w.cloc = a.al(NCH * d.MLH * d.DK * d.DV * 4); w.sloc = a.al(NCH * d.GH * d.GDK * d.GDV * 4); w.cst = a.al(NCH * d.MLH * d.DK * d.DV * 2); w.sst = a.al(NCH * d.GH * d.GDK * d.GDV * 2);
  w.nloc = a.al(NCH * d.MLH * d.DK * 4); w.mloc = a.al(NCH * d.MLH * 2 * 4); w.gdec = a.al(NCH * d.GH * d.GDK * 4); w.nst = a.al(NCH * d.MLH * d.DK * 4); w.mst = a.al(NCH * d.MLH * 4);
  const size_t opt_end = a.c;
  a.c = r2s; w.hr = a.al(M * D * 4); w.pn = a.al(M * d.MLH * d.DK * 4); w.al = a.al(M * d.GH * d.GDK * 4); w.fd = a.al(M * d.MLH * 4); w.iw = a.al(M * d.MLH * 4); w.mt = a.al(M * d.MLH * 4); const size_t nv1_end = a.c;
  a.c = r2s; w.s = a.al(M * d.XH * d.NMEM * 4); w.st2 = a.al(M * d.XH * 2 * 4); const size_t nv2_end = a.c;
  a.c = opt_end > nv1_end ? opt_end : nv1_end; if (nv2_end > a.c) a.c = nv2_end;
  w.ymix = a.al(M * D * 2); w.total = a.c; return w; }
struct OutOff { long yp, ys, mk, mv, cp, np, mp, sp, cs, ns, ms, ss, total; };
constexpr OutOff out_off(const Dm& d) { OutOff o{}; long c = 0; o.yp = c; c += (long)d.B * d.T * d.D; o.ys = c; c += (long)d.SB * d.ST * d.D; o.mk = c; c += (long)d.B * d.NMEM * d.D; o.mv = c; c += (long)d.B * d.NMEM * d.D;
  o.cp = c; c += (long)d.B * d.MLH * d.DK * d.DV; o.np = c; c += (long)d.B * d.MLH * d.DK; o.mp = c; c += (long)d.B * d.MLH; o.sp = c; c += (long)d.B * d.GH * d.GDK * d.GDV;
  o.cs = c; c += (long)d.SB * d.MLH * d.DK * d.DV; o.ns = c; c += (long)d.SB * d.MLH * d.DK; o.ms = c; c += (long)d.SB * d.MLH; o.ss = c; c += (long)d.SB * d.GH * d.GDK * d.GDV; o.total = c; return o; }
enum In { I_XP, I_XS, I_MEM, I_CK, I_CV, I_SC, I_SN, I_SM, I_SS, I_F1G, I_F1WG, I_F1WU, I_F1WD, I_MIXG, I_WIN, I_BI, I_BF, I_MLOG, I_WA2, I_BA, I_GLOG, I_WOUT, I_XG, I_MEMG, I_WQ, I_WK, I_WV, I_WO, I_F2G, I_F2WG, I_F2WU, I_F2WD, I_FING };
}
__device__ __forceinline__ int my_lane() { int l = (int)__builtin_amdgcn_mbcnt_hi(~0u, __builtin_amdgcn_mbcnt_lo(~0u, 0u)); asm volatile("" : "+v"(l)); return l; }
__device__ __forceinline__ float shx(float v, int mask) { return __builtin_bit_cast(float, __builtin_amdgcn_ds_bpermute((my_lane() ^ mask) << 2, __builtin_bit_cast(int, v))); }
__device__ __forceinline__ float shl(float v, int src) { return __builtin_bit_cast(float, __builtin_amdgcn_ds_bpermute(src << 2, __builtin_bit_cast(int, v))); }
#ifndef MK_WGM
#define MK_WGM 8
#endif
namespace pg8 {
#define PG8_LAS __attribute__((address_space(3)))
typedef unsigned short bf16_t;
typedef short bf16x8 __attribute__((ext_vector_type(8)));
typedef float f32x4 __attribute__((ext_vector_type(4)));
typedef unsigned u32x4 __attribute__((ext_vector_type(4)));
constexpr int BM = 256, BK = 64, HALF = 128, HTB = HALF * BK * 2  , STAGE_BYTES = 8 * HTB, NXCD = 8, WGM = MK_WGM;

__host__ __device__ __forceinline__ int lds_byte(int r, int c) { const int st = (r >> 4) * 2 + (c >> 5), rr = r & 15, cc = c & 31, ob = rr * 64 + cc * 2; return st * 1024 + (ob ^ (((ob >> 9) & 1) << 5)); }
__host__ __device__ __forceinline__ void stage_rc(int b, int& R, int& C) { const int st = b / 1024, sb = b % 1024, swz = sb ^ (((sb >> 9) & 1) << 5); R = (st >> 1) * 16 + swz / 64; C = (st & 1) * 32 + (swz % 64) / 2; }
__host__ __device__ __forceinline__ int perm32(int rho) { const int n = rho >> 4, i = rho & 15; return 8 * (i >> 2) + 4 * n + (i & 3); }

struct Unit { int pm, pn, idx; };
struct Gemm { const bf16_t* A; const bf16_t* Bt; int M, N, K; };

struct StaticOrder {
    int nM, nN, nwg, G, c;
    __host__ __device__ void init(int M, int N, int G_, int c_) { nM = M / BM; nN = N / BM; nwg = nM * nN; G = G_; c = c_; }
    __host__ __device__ bool next(int i, Unit& u) const {
        const long L = (long)i * G + c; if (L >= nwg) return false;
        int wgid = (int)L; { const int q = nwg / NXCD, r = nwg % NXCD, xcd = wgid % NXCD, off = wgid / NXCD; wgid = (xcd < r ? xcd * (q + 1) : r * (q + 1) + (xcd - r) * q) + off; }
        const int nig = WGM * nN, gid = wgid / nig, fm = gid * WGM, gsz = (nM - fm) < WGM ? (nM - fm) : WGM;
        u.pm = fm + ((wgid % nig) % gsz); u.pn = (wgid % nig) / gsz; u.idx = i; return true;
    }
    __device__ __forceinline__ void a_ready(const Unit&) const {}
    __device__ __forceinline__ void done(const Unit&) const {}
};

__device__ __forceinline__ unsigned cvt_pk_bf16(float lo, float hi) { unsigned r; asm volatile("v_cvt_pk_bf16_f32 %0, %1, %2" : "=v"(r) : "v"(lo), "v"(hi)); return r; }
template <class Epi, class Sched, bool ALIGN_EPI = false, bool SP2 = false>
__device__ __forceinline__ void gemm_phase(PG8_LAS unsigned char* lds, const Gemm g, const Sched& S, const Epi& E, const int tid) {
    const int wid = __builtin_amdgcn_readfirstlane(tid >> 6), lane = tid & 63, wr = wid >> 2, wc = wid & 3, fr = lane & 15, fq = lane >> 4;
    const int K = g.K, nt = K / BK;
    unsigned voffA[2], voffB[2];
#pragma unroll
    for (int i = 0; i < 2; ++i) { int R, C; stage_rc(tid * 16 + i * 8192, R, C); const int Rb = Epi::PERM ? ((R & ~31) + perm32(R & 31)) : R;
        voffA[i] = (unsigned)(R * K + C) * 2u; voffB[i] = (unsigned)(Rb * K + C) * 2u; }
    const size_t kstep = (size_t)(BK * 2);
    const size_t hstep = (size_t)HALF * K * 2;
    const size_t tstep = 2 * hstep;
    const unsigned ldsw = (unsigned)wid * 1024u;
    const int aoff = lds_byte(wr * 64 + fr, fq * 8), boff = lds_byte(wc * 32 + fr, fq * 8);
#define PG8_SA(b, h) (((b) * 2 + (h)) * HTB)
#define PG8_SB(b, h) ((4 + (b) * 2 + (h)) * HTB)
#define PG8_STAGE(bufoff, gbase, voff) do { _Pragma("unroll") for (int _i = 0; _i < 2; ++_i) \
        __builtin_amdgcn_global_load_lds((const unsigned*)((const char*)(gbase) + (voff)[_i]), (PG8_LAS unsigned*)(lds + (bufoff) + ldsw + _i * 8192), 16, 0, 0); } while (0)
#define PG8_LDA(dst, b, h) do { _Pragma("unroll") for (int m = 0; m < 4; ++m) _Pragma("unroll") for (int k = 0; k < 2; ++k) dst[m][k] = *(const PG8_LAS bf16x8*)(lds + PG8_SA(b, h) + aoff + m * 2048 + k * 1024); } while (0)
#define PG8_LDB(dst, b, h) do { _Pragma("unroll") for (int n = 0; n < 2; ++n) _Pragma("unroll") for (int k = 0; k < 2; ++k) dst[n][k] = *(const PG8_LAS bf16x8*)(lds + PG8_SB(b, h) + boff + n * 2048 + k * 1024); } while (0)
#define PG8_MMA(ai, bj, At, Bt) do { __builtin_amdgcn_s_setprio(1); _Pragma("unroll") for (int m = 0; m < 4; ++m) _Pragma("unroll") for (int n = 0; n < 2; ++n) _Pragma("unroll") for (int k = 0; k < 2; ++k) \
        acc[ai][bj][m][n] = __builtin_amdgcn_mfma_f32_16x16x32_bf16(Bt[n][k], At[m][k], acc[ai][bj][m][n], 0, 0, 0); __builtin_amdgcn_s_setprio(0); } while (0)
#define PG8_WAIT_V(n) asm volatile("s_waitcnt vmcnt(" #n ")" ::: "memory")
#define PG8_WAIT_L(n) asm volatile("s_waitcnt lgkmcnt(" #n ")" ::: "memory")
#define PG8_BAR __builtin_amdgcn_s_barrier()
#define PG8_SCHED __builtin_amdgcn_sched_barrier(0)
    Unit cur, nxt; int ui = 0;
    if (!S.next(0, cur)) return;
    f32x4 acc[2][2][4][2];
#pragma unroll
    for (int a = 0; a < 2; ++a)
#pragma unroll
        for (int b = 0; b < 2; ++b)
#pragma unroll
            for (int m = 0; m < 4; ++m)
#pragma unroll
                for (int n = 0; n < 2; ++n) acc[a][b][m][n] = (f32x4){0.f, 0.f, 0.f, 0.f};
    bf16x8 At[4][2], B0[2][2], B1[2][2];
    const char* cA = (const char*)g.A + (size_t)cur.pm * tstep; const char* cB = (const char*)g.Bt + (size_t)cur.pn * tstep;
    S.a_ready(cur);
    if constexpr (SP2) {
        PG8_STAGE(PG8_SB(0, 0), cB, voffB); PG8_STAGE(PG8_SB(0, 1), cB + hstep, voffB); PG8_STAGE(PG8_SA(0, 0), cA, voffA); PG8_STAGE(PG8_SA(0, 1), cA + hstep, voffA);
        if (wr == 1) PG8_BAR;
        PG8_WAIT_V(2); PG8_BAR;
        PG8_STAGE(PG8_SB(1, 0), cB + kstep, voffB); PG8_STAGE(PG8_SA(1, 0), cA + kstep, voffA); PG8_STAGE(PG8_SB(1, 1), cB + hstep + kstep, voffB);
        PG8_WAIT_V(6); PG8_BAR;
    } else {
        PG8_STAGE(PG8_SB(0, 0), cB, voffB); PG8_STAGE(PG8_SA(0, 0), cA, voffA); PG8_STAGE(PG8_SB(0, 1), cB + hstep, voffB); PG8_STAGE(PG8_SA(0, 1), cA + hstep, voffA);
        if (wr == 1) PG8_BAR;
        PG8_WAIT_V(4); PG8_BAR;
        PG8_STAGE(PG8_SB(1, 0), cB + kstep, voffB); PG8_STAGE(PG8_SA(1, 0), cA + kstep, voffA); PG8_STAGE(PG8_SB(1, 1), cB + hstep + kstep, voffB);
        PG8_WAIT_V(6); PG8_BAR;
    }
    for (;;) {
        const bool has_next = S.next(ui + 1, nxt);
        const char* nA = has_next ? (const char*)g.A + (size_t)nxt.pm * tstep : cA; const char* nB = has_next ? (const char*)g.Bt + (size_t)nxt.pn * tstep : cB;
        for (int t = 0; t < nt; t += 2) {
            const bool last = (t == nt - 2);
            const char* a1 = cA + (size_t)(t + 1) * kstep;
            const char* a2 = last ? nA : cA + (size_t)(t + 2) * kstep; const char* b2 = last ? nB : cB + (size_t)(t + 2) * kstep;
            const char* a3 = a2 + kstep; const char* b3 = b2 + kstep;
            if (last && has_next) S.a_ready(nxt);
            if constexpr (SP2) {
            PG8_LDB(B0, 0, 0); PG8_LDB(B1, 0, 1); PG8_SCHED; PG8_LDA(At, 0, 0); PG8_STAGE(PG8_SA(1, 1), a1 + hstep, voffA);
            PG8_WAIT_V(8); PG8_WAIT_L(0); PG8_BAR; PG8_MMA(0, 0, At, B0); PG8_MMA(0, 1, At, B1); PG8_BAR; PG8_SCHED;
            PG8_LDA(At, 0, 1); PG8_STAGE(PG8_SB(0, 0), b2, voffB); PG8_STAGE(PG8_SB(0, 1), b2 + hstep, voffB); PG8_STAGE(PG8_SA(0, 0), a2, voffA);
            PG8_WAIT_V(8); PG8_WAIT_L(0); PG8_BAR; PG8_MMA(1, 0, At, B0); PG8_MMA(1, 1, At, B1); PG8_BAR; PG8_SCHED;
            PG8_LDB(B0, 1, 0); PG8_LDB(B1, 1, 1); PG8_SCHED; PG8_LDA(At, 1, 0); PG8_STAGE(PG8_SA(0, 1), a2 + hstep, voffA);
            PG8_WAIT_V(8); PG8_WAIT_L(0); PG8_BAR; PG8_MMA(0, 0, At, B0); PG8_MMA(0, 1, At, B1); PG8_BAR; PG8_SCHED;
            PG8_LDA(At, 1, 1); PG8_STAGE(PG8_SB(1, 0), b3, voffB); PG8_STAGE(PG8_SB(1, 1), b3 + hstep, voffB); PG8_STAGE(PG8_SA(1, 0), a3, voffA);
            PG8_WAIT_V(8); PG8_WAIT_L(0); PG8_BAR; PG8_MMA(1, 0, At, B0); PG8_MMA(1, 1, At, B1); PG8_BAR; PG8_SCHED;
            } else {
            PG8_LDB(B0, 0, 0); PG8_SCHED; PG8_LDA(At, 0, 0); PG8_STAGE(PG8_SA(1, 1), a1 + hstep, voffA);
            PG8_WAIT_L(8); PG8_BAR; PG8_WAIT_L(0); PG8_MMA(0, 0, At, B0); PG8_BAR; PG8_SCHED;
            PG8_LDB(B1, 0, 1); PG8_STAGE(PG8_SB(0, 0), b2, voffB);
            PG8_BAR; PG8_WAIT_L(0); PG8_MMA(0, 1, At, B1); PG8_BAR;
            PG8_LDA(At, 0, 1); PG8_STAGE(PG8_SA(0, 0), a2, voffA);
            PG8_BAR; PG8_WAIT_L(0); PG8_MMA(1, 0, At, B0); PG8_BAR; PG8_SCHED;
            PG8_STAGE(PG8_SB(0, 1), b2 + hstep, voffB);
            PG8_WAIT_V(6); PG8_BAR; PG8_MMA(1, 1, At, B1); PG8_BAR;
            PG8_LDB(B0, 1, 0); PG8_SCHED; PG8_LDA(At, 1, 0); PG8_STAGE(PG8_SA(0, 1), a2 + hstep, voffA);
            PG8_WAIT_L(8); PG8_BAR; PG8_WAIT_L(0); PG8_MMA(0, 0, At, B0); PG8_BAR; PG8_SCHED;
            PG8_LDB(B1, 1, 1); PG8_STAGE(PG8_SB(1, 0), b3, voffB);
            PG8_BAR; PG8_WAIT_L(0); PG8_MMA(0, 1, At, B1); PG8_BAR;
            PG8_LDA(At, 1, 1); PG8_STAGE(PG8_SA(1, 0), a3, voffA);
            PG8_BAR; PG8_WAIT_L(0); PG8_MMA(1, 0, At, B0); PG8_BAR; PG8_SCHED;
            PG8_STAGE(PG8_SB(1, 1), b3 + hstep, voffB);
            PG8_WAIT_V(6); PG8_BAR; PG8_MMA(1, 1, At, B1); PG8_BAR;
            }
        }
        if constexpr (ALIGN_EPI) { if (wr == 0) PG8_BAR; }
        if constexpr (!Epi::AFTER_DRAIN) { E(acc, cur, wr, wc, fr, fq); S.done(cur); }
        if (!has_next) break;
#pragma unroll
        for (int a = 0; a < 2; ++a)
#pragma unroll
            for (int b = 0; b < 2; ++b)
#pragma unroll
                for (int m = 0; m < 4; ++m)
#pragma unroll
                    for (int n = 0; n < 2; ++n) acc[a][b][m][n] = (f32x4){0.f, 0.f, 0.f, 0.f};
        cur = nxt; cA = nA; cB = nB; ++ui;
        if constexpr (ALIGN_EPI) { if (wr == 1) PG8_BAR; }
    }
    PG8_WAIT_V(0);
    if constexpr (!ALIGN_EPI) { if (wr == 0) PG8_BAR; }
    PG8_BAR;
    if constexpr (Epi::AFTER_DRAIN) { E.fused(acc, cur, wr, wc, fr, fq, lds, wid, lane); S.done(cur); }
#undef PG8_SA
#undef PG8_SB
#undef PG8_STAGE
#undef PG8_LDA
#undef PG8_LDB
#undef PG8_MMA
#undef PG8_WAIT_V
#undef PG8_WAIT_L
#undef PG8_BAR
#undef PG8_SCHED
}
}
namespace pg8 {
typedef unsigned u32x2 __attribute__((ext_vector_type(2)));
constexpr int DMODEL = 1024, NSSQ = 16;
constexpr float RMS_EPS = 1e-6f;
__device__ __forceinline__ float row_rstd(const float* ssq, int row, int fq) {
    const f32x4 v = *(const f32x4*)(ssq + (size_t)row * NSSQ + 4 * fq); float s = (v[0] + v[1]) + (v[2] + v[3]); s += shx(s, 16); s += shx(s, 32);
    return rsqrtf(s * (1.0f / DMODEL) + RMS_EPS); }
__device__ __forceinline__ float silu_f(float g) { return g * __builtin_amdgcn_rcpf(1.0f + __expf(-g)); }
struct EpiSwiglu { static constexpr bool PERM = false, AFTER_DRAIN = false;
    bf16_t* H; const float* ssq; int ldh, pad;
    __device__ __forceinline__ void operator()(const f32x4 (&acc)[2][2][4][2], const Unit& u, int wr, int wc, int fr, int fq) const {
#pragma unroll
        for (int ai = 0; ai < 2; ++ai)
#pragma unroll
            for (int m = 0; m < 4; ++m) { const int row = u.pm * BM + ai * HALF + wr * 64 + m * 16 + fr; const float rs = row_rstd(ssq, row, fq);
#pragma unroll
                for (int bj = 0; bj < 2; ++bj) { const f32x4 g = acc[ai][bj][m][0] * rs, up = acc[ai][bj][m][1] * rs; u32x2 w;
                    w.x = cvt_pk_bf16(silu_f(g[0]) * up[0], silu_f(g[1]) * up[1]); w.y = cvt_pk_bf16(silu_f(g[2]) * up[2], silu_f(g[3]) * up[3]);
                    *(u32x2*)(H + (size_t)row * ldh + u.pn * 128 + bj * 64 + wc * 16 + 4 * fq) = w; } asm volatile("" ::: "memory"); }
    }
};
struct EpiResid { static constexpr bool PERM = false, AFTER_DRAIN = false;
    const float* xp; const float* xs; float* XF; bf16_t* XB; float* ssq; float alpha; int first;
    __device__ __forceinline__ void operator()(const f32x4 (&acc)[2][2][4][2], const Unit& u, int wr, int wc, int fr, int fq) const {
#pragma unroll
        for (int ai = 0; ai < 2; ++ai) { u32x2 bw[4][2][2];
#pragma unroll
            for (int m = 0; m < 4; ++m)
#pragma unroll
                for (int bj = 0; bj < 2; ++bj)
#pragma unroll
                    for (int n = 0; n < 2; ++n) bw[m][bj][n] = *(const u32x2*)(XB + (size_t)(u.pm * BM + ai * HALF + wr * 64 + m * 16 + fr) * DMODEL + u.pn * BM + bj * HALF + wc * 32 + n * 16 + 4 * fq);
#pragma unroll
            for (int m = 0; m < 4; ++m) { const int row = u.pm * BM + ai * HALF + wr * 64 + m * 16 + fr; float q = 0.f;
#pragma unroll
                for (int bj = 0; bj < 2; ++bj)
#pragma unroll
                    for (int n = 0; n < 2; ++n) { const int col = u.pn * BM + bj * HALF + wc * 32 + n * 16 + 4 * fq; const u32x2 w0 = bw[m][bj][n];
                        const f32x4 b = {__uint_as_float(w0.x << 16), __uint_as_float(w0.x & 0xffff0000u), __uint_as_float(w0.y << 16), __uint_as_float(w0.y & 0xffff0000u)};
                        const f32x4 o = b + acc[ai][bj][m][n] * alpha;
                        u32x2 w; w.x = cvt_pk_bf16(o[0], o[1]); w.y = cvt_pk_bf16(o[2], o[3]); *(u32x2*)(XB + (size_t)row * DMODEL + col) = w;
                        q += (o[0] * o[0] + o[1] * o[1]) + (o[2] * o[2] + o[3] * o[3]); }
                q += shx(q, 16); q += shx(q, 32);
                if (fq == 0) ssq[(size_t)row * NSSQ + u.pn * 4 + wc] = q; }
            asm volatile("" ::: "memory"); }
    }
};
struct EpiZ { static constexpr bool PERM = true, AFTER_DRAIN = false;
    bf16_t* Z; float* ZG; const float* ssq;
    __device__ __forceinline__ void operator()(const f32x4 (&acc)[2][2][4][2], const Unit& u, int wr, int wc, int fr, int fq) const {
        constexpr int ZW = 3584, ZGP = 32;
#pragma unroll
        for (int ai = 0; ai < 2; ++ai)
#pragma unroll
            for (int m = 0; m < 4; ++m) { const int row = u.pm * BM + ai * HALF + wr * 64 + m * 16 + fr; const float rs = row_rstd(ssq, row, fq);
                if (u.pn < ZW / BM) {
#pragma unroll
                    for (int bj = 0; bj < 2; ++bj) { const f32x4 v0 = acc[ai][bj][m][0] * rs, v1 = acc[ai][bj][m][1] * rs; u32x4 w; w.x = cvt_pk_bf16(v0[0], v0[1]); w.y = cvt_pk_bf16(v0[2], v0[3]); w.z = cvt_pk_bf16(v1[0], v1[1]); w.w = cvt_pk_bf16(v1[2], v1[3]);
                        *(u32x4*)(Z + (size_t)row * ZW + u.pn * BM + bj * HALF + wc * 32 + 8 * fq) = w; }
                } else if (wc == 0) { *(f32x4*)(ZG + (size_t)row * ZGP + 8 * fq) = acc[ai][0][m][0] * rs; *(f32x4*)(ZG + (size_t)row * ZGP + 8 * fq + 4) = acc[ai][0][m][1] * rs; } asm volatile("" ::: "memory"); }
    }
};
struct EpiQ { static constexpr bool PERM = true, AFTER_DRAIN = false;
    bf16_t* Q; const float* ssq;
    __device__ __forceinline__ void operator()(const f32x4 (&acc)[2][2][4][2], const Unit& u, int wr, int wc, int fr, int fq) const {
#pragma unroll
        for (int ai = 0; ai < 2; ++ai)
#pragma unroll
            for (int m = 0; m < 4; ++m) { const int row = u.pm * BM + ai * HALF + wr * 64 + m * 16 + fr; const float rs = row_rstd(ssq, row, fq);
#pragma unroll
                for (int bj = 0; bj < 2; ++bj) { const f32x4 v0 = acc[ai][bj][m][0] * rs, v1 = acc[ai][bj][m][1] * rs; u32x4 w; w.x = cvt_pk_bf16(v0[0], v0[1]); w.y = cvt_pk_bf16(v0[2], v0[3]); w.z = cvt_pk_bf16(v1[0], v1[1]); w.w = cvt_pk_bf16(v1[2], v1[3]);
                    *(u32x4*)(Q + (size_t)row * DMODEL + u.pn * BM + bj * HALF + wc * 32 + 8 * fq) = w; } asm volatile("" ::: "memory"); }
    }
};
struct EpiKV { static constexpr bool PERM = false, AFTER_DRAIN = false;
    float* outk; float* outv; bf16_t* KB; bf16_t* VT; const float* mssq;
    __device__ __forceinline__ void operator()(const f32x4 (&acc)[2][2][4][2], const Unit& u, int wr, int wc, int fr, int fq) const {
#pragma unroll
        for (int ai = 0; ai < 2; ++ai)
#pragma unroll
            for (int m = 0; m < 4; ++m) { const int row = u.pm * BM + ai * HALF + wr * 64 + m * 16 + fr; const float rs = rsqrtf(mssq[row] * (1.0f / DMODEL) + RMS_EPS);
#pragma unroll
                for (int bj = 0; bj < 2; ++bj)
#pragma unroll
                    for (int n = 0; n < 2; ++n) { const int cl = bj * HALF + wc * 32 + n * 16 + 4 * fq; const f32x4 o = acc[ai][bj][m][n] * rs;
                        if (u.pn < 4) { const int col = u.pn * BM + cl; __builtin_nontemporal_store(o, (f32x4*)(outk + (size_t)row * DMODEL + col)); u32x2 w; w.x = cvt_pk_bf16(o[0], o[1]); w.y = cvt_pk_bf16(o[2], o[3]); *(u32x2*)(KB + (size_t)row * DMODEL + col) = w; }
                        else { const int h = u.pn - 4, col = h * BM + cl; __builtin_nontemporal_store(o, (f32x4*)(outv + (size_t)row * DMODEL + col)); const int b = row >> 8, mm = row & 255; bf16_t* vt = VT + ((size_t)(b * 4 + h) * 256 + cl) * 256 + mm;
                            const unsigned w0 = cvt_pk_bf16(o[0], o[1]), w1 = cvt_pk_bf16(o[2], o[3]); vt[0] = (bf16_t)(w0 & 0xffffu); vt[256] = (bf16_t)(w0 >> 16); vt[512] = (bf16_t)(w1 & 0xffffu); vt[768] = (bf16_t)(w1 >> 16); } } asm volatile("" ::: "memory"); }
    }
};
template <class Sched> __device__ __forceinline__ void rstd_to_lds(PG8_LAS float* rsl, const float* ssq, const Sched& S, int tid) {
    Unit u;
    for (int i = 0; i < 8; ++i) { if (!S.next(i, u)) break;
        if (tid < 256) { const int row = u.pm * BM + tid; const f32x4* sp = (const f32x4*)(ssq + (size_t)row * NSSQ); const f32x4 s0 = sp[0], s1 = sp[1], s2 = sp[2], s3 = sp[3];
            const float ss = ((s0[0] + s0[1]) + (s0[2] + s0[3])) + ((s1[0] + s1[1]) + (s1[2] + s1[3])) + ((s2[0] + s2[1]) + (s2[2] + s2[3])) + ((s3[0] + s3[1]) + (s3[2] + s3[3]));
            rsl[i * 256 + tid] = rsqrtf(ss * (1.0f / DMODEL) + RMS_EPS); } }
    __syncthreads();
}
struct EpiSwigluL { static constexpr bool PERM = false, AFTER_DRAIN = false;
    bf16_t* H; const PG8_LAS float* rsl; int ldh, pad;
    __device__ __forceinline__ void operator()(const f32x4 (&acc)[2][2][4][2], const Unit& u, int wr, int wc, int fr, int fq) const {
#pragma unroll
        for (int ai = 0; ai < 2; ++ai)
#pragma unroll
            for (int m = 0; m < 4; ++m) { const int lr = ai * HALF + wr * 64 + m * 16 + fr, row = u.pm * BM + lr; const float rs = rsl[u.idx * 256 + lr];
#pragma unroll
                for (int bj = 0; bj < 2; ++bj) { const f32x4 g = acc[ai][bj][m][0] * rs, up = acc[ai][bj][m][1] * rs; u32x2 w;
                    w.x = cvt_pk_bf16(silu_f(g[0]) * up[0], silu_f(g[1]) * up[1]); w.y = cvt_pk_bf16(silu_f(g[2]) * up[2], silu_f(g[3]) * up[3]);
                    *(u32x2*)(H + (size_t)row * ldh + u.pn * 128 + bj * 64 + wc * 16 + 4 * fq) = w; } }
    }
};
struct EpiZL { static constexpr bool PERM = true, AFTER_DRAIN = false;
    bf16_t* Z; float* ZG; const PG8_LAS float* rsl;
    __device__ __forceinline__ void operator()(const f32x4 (&acc)[2][2][4][2], const Unit& u, int wr, int wc, int fr, int fq) const {
        constexpr int ZW = 3584, ZGP = 32;
#pragma unroll
        for (int ai = 0; ai < 2; ++ai)
#pragma unroll
            for (int m = 0; m < 4; ++m) { const int lr = ai * HALF + wr * 64 + m * 16 + fr, row = u.pm * BM + lr; const float rs = rsl[u.idx * 256 + lr];
                if (u.pn < ZW / BM) {
#pragma unroll
                    for (int bj = 0; bj < 2; ++bj) { const f32x4 v0 = acc[ai][bj][m][0] * rs, v1 = acc[ai][bj][m][1] * rs; u32x4 w; w.x = cvt_pk_bf16(v0[0], v0[1]); w.y = cvt_pk_bf16(v0[2], v0[3]); w.z = cvt_pk_bf16(v1[0], v1[1]); w.w = cvt_pk_bf16(v1[2], v1[3]);
                        *(u32x4*)(Z + (size_t)row * ZW + u.pn * BM + bj * HALF + wc * 32 + 8 * fq) = w; }
                } else if (wc == 0) { *(f32x4*)(ZG + (size_t)row * ZGP + 8 * fq) = acc[ai][0][m][0] * rs; *(f32x4*)(ZG + (size_t)row * ZGP + 8 * fq + 4) = acc[ai][0][m][1] * rs; } }
    }
};
constexpr int CW_PANEL = 65536;
__device__ __forceinline__ void panel_wait(unsigned* cnt, unsigned want, int wid, int lane) {
    if (wid == 0) { unsigned spins = 0;
        while ((unsigned)__builtin_amdgcn_readfirstlane(__hip_atomic_load(cnt, __ATOMIC_RELAXED, __HIP_MEMORY_SCOPE_AGENT)) < want) { __builtin_amdgcn_s_sleep(2); if (++spins > (1u << 22)) break; }
        __builtin_amdgcn_fence(__ATOMIC_ACQUIRE, "agent"); }
    asm volatile("s_waitcnt vmcnt(0) lgkmcnt(0)" ::: "memory"); __builtin_amdgcn_s_barrier(); asm volatile("" ::: "memory");
}
__device__ __forceinline__ float row_rstd_sc1(const float* ssq, int row, int fq) {
    const unsigned long long* p = (const unsigned long long*)(ssq + (size_t)row * NSSQ + 4 * fq); const unsigned long long a = __hip_atomic_load(p, __ATOMIC_RELAXED, __HIP_MEMORY_SCOPE_AGENT), b = __hip_atomic_load(p + 1, __ATOMIC_RELAXED, __HIP_MEMORY_SCOPE_AGENT);
    float s = (__uint_as_float((unsigned)a) + __uint_as_float((unsigned)(a >> 32))) + (__uint_as_float((unsigned)b) + __uint_as_float((unsigned)(b >> 32))); s += shx(s, 16); s += shx(s, 32);
    return rsqrtf(s * (1.0f / DMODEL) + RMS_EPS); }
struct EpiResidFinal { static constexpr bool PERM = false, AFTER_DRAIN = true;
    const bf16_t* XB; float* ssq; float* Y; const float* gfin; unsigned* cnt; float alpha; int pad;
    __device__ __forceinline__ void fused(f32x4 (&acc)[2][2][4][2], const Unit& u, int wr, int wc, int fr, int fq, PG8_LAS unsigned char* lds, int wid, int lane) const {
#pragma unroll
        for (int ai = 0; ai < 2; ++ai) { u32x2 bw[4][2][2];
#pragma unroll
            for (int m = 0; m < 4; ++m)
#pragma unroll
                for (int bj = 0; bj < 2; ++bj)
#pragma unroll
                    for (int n = 0; n < 2; ++n) bw[m][bj][n] = *(const u32x2*)(XB + (size_t)(u.pm * BM + ai * HALF + wr * 64 + m * 16 + fr) * DMODEL + u.pn * BM + bj * HALF + wc * 32 + n * 16 + 4 * fq);
#pragma unroll
            for (int m = 0; m < 4; ++m) { const int row = u.pm * BM + ai * HALF + wr * 64 + m * 16 + fr; float q = 0.f;
#pragma unroll
                for (int bj = 0; bj < 2; ++bj)
#pragma unroll
                    for (int n = 0; n < 2; ++n) { const u32x2 w0 = bw[m][bj][n]; const f32x4 b = {__uint_as_float(w0.x << 16), __uint_as_float(w0.x & 0xffff0000u), __uint_as_float(w0.y << 16), __uint_as_float(w0.y & 0xffff0000u)};
                        const f32x4 o = b + acc[ai][bj][m][n] * alpha; q += (o[0] * o[0] + o[1] * o[1]) + (o[2] * o[2] + o[3] * o[3]);
#ifdef MK_DBG_XB
                        { u32x2 w; w.x = cvt_pk_bf16(o[0], o[1]); w.y = cvt_pk_bf16(o[2], o[3]); *(u32x2*)(const_cast<bf16_t*>(XB) + (size_t)row * DMODEL + u.pn * BM + bj * HALF + wc * 32 + n * 16 + 4 * fq) = w; }
#endif
                        }
                q += shx(q, 16); q += shx(q, 32);
                if (fq == 0) __hip_atomic_store((unsigned*)(ssq + (size_t)row * NSSQ + u.pn * 4 + wc), __float_as_uint(q), __ATOMIC_RELAXED, __HIP_MEMORY_SCOPE_AGENT); }
            asm volatile("" ::: "memory"); }
        asm volatile("s_waitcnt vmcnt(0)" ::: "memory");
        if (lane == 0) __hip_atomic_fetch_add(cnt + 64 * u.pm, 1u, __ATOMIC_RELAXED, __HIP_MEMORY_SCOPE_AGENT);
        panel_wait(cnt + 64 * u.pm, 32u, wid, lane);
        f32x4 gv[2][2];
#pragma unroll
        for (int bj = 0; bj < 2; ++bj)
#pragma unroll
            for (int n = 0; n < 2; ++n) gv[bj][n] = *(const f32x4*)(gfin + u.pn * BM + bj * HALF + wc * 32 + n * 16 + 4 * fq);
#pragma unroll
        for (int ai = 0; ai < 2; ++ai) { u32x2 bw[4][2][2]; float rs[4];
#pragma unroll
            for (int m = 0; m < 4; ++m) { const int row = u.pm * BM + ai * HALF + wr * 64 + m * 16 + fr; rs[m] = row_rstd_sc1(ssq, row, fq);
#pragma unroll
                for (int bj = 0; bj < 2; ++bj)
#pragma unroll
                    for (int n = 0; n < 2; ++n) bw[m][bj][n] = *(const u32x2*)(XB + (size_t)row * DMODEL + u.pn * BM + bj * HALF + wc * 32 + n * 16 + 4 * fq); }
#pragma unroll
            for (int m = 0; m < 4; ++m) { const int row = u.pm * BM + ai * HALF + wr * 64 + m * 16 + fr;
#pragma unroll
                for (int bj = 0; bj < 2; ++bj)
#pragma unroll
                    for (int n = 0; n < 2; ++n) { const u32x2 w0 = bw[m][bj][n]; const f32x4 b = {__uint_as_float(w0.x << 16), __uint_as_float(w0.x & 0xffff0000u), __uint_as_float(w0.y << 16), __uint_as_float(w0.y & 0xffff0000u)};
                        const f32x4 o = b + acc[ai][bj][m][n] * alpha; *(f32x4*)(Y + (size_t)row * DMODEL + u.pn * BM + bj * HALF + wc * 32 + n * 16 + 4 * fq) = o * rs[m] * gv[bj][n]; } }
            asm volatile("" ::: "memory"); }
    }
};
}
#define GAS __attribute__((address_space(1)))
#define LAS __attribute__((address_space(3)))
typedef unsigned short bf16;
typedef unsigned v4u __attribute__((ext_vector_type(4)));
typedef float f32x4 __attribute__((ext_vector_type(4)));
typedef short bf16x8 __attribute__((ext_vector_type(8)));
typedef GAS unsigned gu32;
typedef GAS unsigned long long gu64;
#define RLX_AGENT __ATOMIC_RELAXED, __HIP_MEMORY_SCOPE_AGENT
#define LDS_WAIT() asm volatile("s_waitcnt lgkmcnt(0)" ::: "memory")
#define VM_WAIT() asm volatile("s_waitcnt vmcnt(0)" ::: "memory")
__device__ __forceinline__ unsigned long long rt() { return __builtin_amdgcn_s_memrealtime(); }
__device__ __forceinline__ unsigned f2bf(float f) { unsigned u = __builtin_bit_cast(unsigned, f); return (u + 0x7fffu + ((u >> 16) & 1u)) >> 16; }
__device__ __forceinline__ unsigned pk2(float lo, float hi) { return f2bf(lo) | (f2bf(hi) << 16); }

#define XB_TMO      128
#define XB_XCNT(j)  (256  + 64 * (j))
#define XB_XSUB(j)  (1280 + 64 * (j))
#define XB_XGEN(j)  (2304 + 64 * (j))
#define XB_TOP      3328
#define XB_TOPGEN   3392
#define XCD_BAR_WORDS 3456
#define XB_SPIN_CAP (1u << 18)

__device__ __forceinline__ unsigned xb_ld(unsigned* p)              { return __hip_atomic_load(p, __ATOMIC_RELAXED, __HIP_MEMORY_SCOPE_AGENT); }
__device__ __forceinline__ unsigned xb_add(unsigned* p, unsigned v) { return __hip_atomic_fetch_add(p, v, __ATOMIC_RELAXED, __HIP_MEMORY_SCOPE_AGENT); }
__device__ __forceinline__ unsigned xb_xcc_id() { return (unsigned)__builtin_amdgcn_s_getreg((3 << 11) | 20) & 0xFu; }
#define XB_SPIN(cond, bar) do { unsigned _sp = 0; while (cond) { __builtin_amdgcn_s_sleep(1); \
    if ((++_sp & 255u) == 0u) { if (xb_ld(&(bar)[XB_TMO])) break; if (_sp > XB_SPIN_CAP) { atomicAdd(&(bar)[XB_TMO], 1u); break; } } } } while (0)

struct XcdBarrier {
    unsigned* bar; unsigned x;
    volatile LAS unsigned* st;
};

__device__ __forceinline__ XcdBarrier xcd_barrier_post(unsigned* bar, volatile LAS unsigned* st) {
    XcdBarrier b; b.bar = bar; b.x = xb_xcc_id(); b.st = st;
    if (threadIdx.x == 0) (void)xb_add(&bar[XB_XCNT(b.x)], 1u);
    return b;
}
__device__ __forceinline__ void xcd_barrier_complete(unsigned* bar, unsigned x, unsigned& nloc, unsigned& nx) {
    const unsigned G = gridDim.x * gridDim.y * gridDim.z;
    unsigned sum, cnt, mine, sp = 0u;
    for (;;) {
        sum = 0u; cnt = 0u; mine = 0u;
#pragma unroll
        for (unsigned j = 0; j < 16; ++j) { const unsigned c = xb_ld(&bar[XB_XCNT(j)]); sum += c; cnt += (c > 0u) ? 1u : 0u; mine = (j == x) ? c : mine; }
        if (sum == G) break;
        __builtin_amdgcn_s_sleep(1);
        if ((++sp & 255u) == 0u) { if (xb_ld(&bar[XB_TMO])) break; if (sp > XB_SPIN_CAP) { atomicAdd(&bar[XB_TMO], 1u); break; } }
    }
    nloc = mine > 0u ? mine : 1u; nx = cnt > 0u ? cnt : 1u;
}

__device__ __forceinline__ void xcd_barrier(const XcdBarrier& b) {
    asm volatile("s_waitcnt vmcnt(0)" ::: "memory");
    __syncthreads();
    if (threadIdx.x == 0) {
        unsigned* bar = b.bar;
        __builtin_amdgcn_s_waitcnt(0);
        unsigned nloc = b.st[0], nx = b.st[1];
        if (nloc == 0u) { xcd_barrier_complete(bar, b.x, nloc, nx); b.st[0] = nloc; b.st[1] = nx; }
        const unsigned old = xb_add(&bar[XB_XSUB(b.x)], 1u);
        const unsigned gen = old / nloc;
        if (old + 1u == (gen + 1u) * nloc) {
            __builtin_amdgcn_fence(__ATOMIC_RELEASE, "agent");
            asm volatile("s_waitcnt vmcnt(0)" ::: "memory");
            const unsigned og = xb_add(&bar[XB_TOP], 1u);
            const unsigned tg = og / nx;
            if (og + 1u == (tg + 1u) * nx) xb_add(&bar[XB_TOPGEN], 1u);
            else XB_SPIN(xb_ld(&bar[XB_TOPGEN]) == tg, bar);
            __builtin_amdgcn_fence(__ATOMIC_ACQUIRE, "agent");
            xb_add(&bar[XB_XGEN(b.x)], 1u);
            asm volatile("s_waitcnt vmcnt(0)" ::: "memory");
        } else {
            XB_SPIN(xb_ld(&bar[XB_XGEN(b.x)]) == gen, bar);
            __builtin_amdgcn_fence(__ATOMIC_ACQUIRE, "agent");
            asm volatile("s_waitcnt vmcnt(0)" ::: "memory");
        }
    }
    __syncthreads();
}
constexpr int NWAVES = 8;
constexpr int RING_OFF = 0, RING_BYTES = 131072;
constexpr int LDSCTL_OFF = RING_BYTES, MISC_OFF = LDSCTL_OFF + 320;
constexpr int LDS_BYTES = 147456;
constexpr int RSL_OFF = MISC_OFF + 128;
static_assert(RSL_OFF + 8 * 256 * 4 <= LDS_BYTES, "LDS map");
constexpr int CW_TMO = 0, CW_CODE = 1, CW_BAR = 4096, MAX_LAUNCHES = 16;
constexpr size_t CTL_ZERO_BYTES = 1u << 20;
static_assert((CW_BAR + MAX_LAUNCHES * XCD_BAR_WORDS) * 4 <= (int)CTL_ZERO_BYTES, "barrier regions inside the memset region");
constexpr int MROWS = 16896, PROWS = 16384, DM = 1024, DFF = 2816, ZW = 3584, WIN_N = 3840, MEMROWS = 2048;
enum Phase { PH_PROLOGUE = 0, PH_UP1, PH_DOWN1, PH_WIN, PH_MIX_LOCAL, PH_MIX_SCAN, PH_MIX_OUT, PH_WOUT, PH_Q, PH_ATTN, PH_WO, PH_UP2, PH_DOWN2, PH_FINAL, PH_COUNT };

constexpr nv::Dm FULL_DIMS{1024, 8, 2048, 128, 4, 4, 128, 128, 4, 64, 128, 16, 256, 4, 256, 2816, 3608, 0, 1e-6f, 16.f};
constexpr nv::Ws WSO = nv::carve_ws(FULL_DIMS);
constexpr nv::OutOff OUTO = nv::out_off(FULL_DIMS);
struct Args { const float* in[33]; float* out; unsigned char* ws; int ph_lo, ph_hi, li, pad; };

__device__ __forceinline__ float wave_sum(float v) {
#pragma unroll
    for (int o = 1; o < 64; o <<= 1) v += shx(v, o);
    return v;
}
struct WSrc { const float* W; const float* gain; int col, pitch; float scale; int zero; };
__device__ __forceinline__ WSrc wsrc(int mat, int np, const float* const* in) {
    WSrc s; s.gain = nullptr; s.scale = 1.f; s.zero = 0; s.col = np; s.pitch = DM; s.W = nullptr;
    switch (mat) {
    case 0: case 7: { const int g = np >> 5, i = np & 31; const bool up = i >= 16; s.W = in[mat == 0 ? (up ? nv::I_F1WU : nv::I_F1WG) : (up ? nv::I_F2WU : nv::I_F2WG)]; s.col = 16 * g + (i & 15); s.pitch = DFF; s.gain = in[mat == 0 ? nv::I_F1G : nv::I_F2G]; break; }
    case 1: case 8: s.W = in[mat == 1 ? nv::I_F1WD : nv::I_F2WD]; break;
    case 2: { s.W = in[nv::I_WIN]; s.pitch = 3608; s.gain = in[nv::I_MIXG];
        if (np < 1536) { s.col = np; if (np >= 512 && np < 1024) s.scale = 0.08838834764831845f; }
        else if (np < 3072) { s.col = np + 8; if (np >= 2048 && np < 2304) s.scale = 0.125f; }
        else if (np < 3584) s.col = np + 24;
        else if (np < 3592) s.col = 1536 + (np - 3584);
        else if (np < 3608) s.col = 3080 + (np - 3592);
        else { s.zero = 1; s.col = 0; }
        break; }
    case 3: s.W = in[nv::I_WOUT]; break;
    case 4: s.W = in[nv::I_WQ]; s.gain = in[nv::I_XG]; s.scale = 0.0625f; break;
    case 5: s.W = in[np < DM ? nv::I_WK : nv::I_WV]; s.col = np & (DM - 1); s.gain = in[nv::I_MEMG]; break;
    default: s.W = in[nv::I_WO]; break;
    }
    return s;
}
struct WItem { int mat, K, kb, nb; size_t off; };
__device__ __forceinline__ WItem witem(int g) {
    WItem w; int nnb;
    if (g < 2816) { w.mat = 0; w.K = DM; nnb = 88; w.off = WSO.wgu1; }
    else if ((g -= 2816) < 1408) { w.mat = 1; w.K = DFF; nnb = 16; w.off = WSO.wd1; }
    else if ((g -= 1408) < 1920) { w.mat = 2; w.K = DM; nnb = 60; w.off = WSO.win; }
    else if ((g -= 1920) < 512) { w.mat = 3; w.K = DM; nnb = 16; w.off = WSO.wout; }
    else if ((g -= 512) < 512) { w.mat = 4; w.K = DM; nnb = 16; w.off = WSO.wq; }
    else if ((g -= 512) < 1024) { w.mat = 5; w.K = DM; nnb = 32; w.off = WSO.wkv; }
    else if ((g -= 1024) < 512) { w.mat = 6; w.K = DM; nnb = 16; w.off = WSO.wo; }
    else if ((g -= 512) < 2816) { w.mat = 7; w.K = DM; nnb = 88; w.off = WSO.wgu2; }
    else { g -= 2816; w.mat = 8; w.K = DFF; nnb = 16; w.off = WSO.wd2; }
    w.kb = g / nnb; w.nb = g % nnb; return w; }
constexpr int W_ITEMS = 2816 + 1408 + 1920 + 512 + 512 + 1024 + 512 + 2816 + 1408;
struct WRegs { f32x4 v[8]; };
__device__ __forceinline__ void witem_load(WRegs& R, const float* const* in, int g, int lane) { const WItem w = witem(g); const int k0 = 32 * w.kb, n0 = 64 * w.nb, n4 = lane & 15, kq = lane >> 4; const WSrc s = wsrc(w.mat, n0 + 4 * n4, in);
#pragma unroll
    for (int i = 0; i < 8; ++i) { const int kk = kq + 4 * i; R.v[i] = (f32x4){0.f, 0.f, 0.f, 0.f}; if (!s.zero) R.v[i] = __builtin_nontemporal_load((const GAS f32x4*)(s.W + (size_t)(k0 + kk) * s.pitch + s.col)); } }
__device__ __forceinline__ void witem_store(const WRegs& R, const float* const* in, unsigned char* ws, LAS float* scr, int g, int lane) { const WItem w = witem(g); const int k0 = 32 * w.kb, n0 = 64 * w.nb, n4 = lane & 15, kq = lane >> 4; bf16* WT = (bf16*)(ws + w.off); const WSrc s = wsrc(w.mat, n0 + 4 * n4, in);
#pragma unroll
    for (int i = 0; i < 8; ++i) { const int kk = kq + 4 * i; *(LAS f32x4*)(scr + kk * 68 + 4 * n4) = R.v[i] * (s.gain ? s.gain[k0 + kk] * s.scale : s.scale); }
    LDS_WAIT(); asm volatile("" ::: "memory");
    const int c = lane & 3;
#pragma unroll
    for (int j = 0; j < 4; ++j) { const int n = (lane >> 2) + 16 * j; const LAS float* p = scr + (8 * c) * 68 + n;
        v4u o; o.x = pk2(p[0 * 68], p[1 * 68]); o.y = pk2(p[2 * 68], p[3 * 68]); o.z = pk2(p[4 * 68], p[5 * 68]); o.w = pk2(p[6 * 68], p[7 * 68]);
        *(GAS v4u*)(WT + (size_t)(n0 + n) * w.K + k0 + 8 * c) = o; }
    LDS_WAIT(); asm volatile("" ::: "memory");
}
__device__ __forceinline__ float row_to_bf16(const float* xrow, bf16* orow, int lane) {
    const GAS f32x4* xr = (const GAS f32x4*)xrow + lane; f32x4 v[4]; float s = 0.f;
#pragma unroll
    for (int j = 0; j < 4; ++j) { v[j] = __builtin_nontemporal_load(xr + 64 * j); s += (v[j].x * v[j].x + v[j].y * v[j].y) + (v[j].z * v[j].z + v[j].w * v[j].w); }
    GAS unsigned long long* o8 = (GAS unsigned long long*)orow + lane;
#pragma unroll
    for (int j = 0; j < 4; ++j) o8[64 * j] = (unsigned long long)pk2(v[j].x, v[j].y) | ((unsigned long long)pk2(v[j].z, v[j].w) << 32);
    return wave_sum(s);
}
struct Frame { LAS unsigned char* lds; int tid, lane, wave, vcu, G; };
__device__ __forceinline__ void p0_prologue(const Frame& F, const float* const* in, unsigned char* ws) {
    LAS float* scr = (LAS float*)(F.lds + RING_OFF + F.wave * 16384);
    const int gw = F.vcu * NWAVES + F.wave, NGW = F.G * NWAVES;
    const bool defer = F.G == 256; const int lim = defer ? 8576 : W_ITEMS;
    for (int q = gw; q < lim; q += 2 * NGW) { WRegs A, B; const int q2 = q + NGW; const bool two = q2 < lim;
        const int g = !defer || q < 2816 ? q : q < 4736 ? q + 1408 : q < 5760 ? q + 2432 : q + 2944, g2 = !defer || q2 < 2816 ? q2 : q2 < 4736 ? q2 + 1408 : q2 < 5760 ? q2 + 2432 : q2 + 2944;
        witem_load(A, in, g, F.lane); if (two) witem_load(B, in, g2, F.lane);
        witem_store(A, in, ws, scr, g, F.lane); if (two) witem_store(B, in, ws, scr, g2, F.lane); }
    bf16* XB = (bf16*)(ws + WSO.xb); float* SSQ = (float*)(ws + WSO.ssq);
    for (int m0 = gw; m0 < MROWS; m0 += 2 * NGW) { const int m1 = m0 + NGW;
        const float* s0p = m0 < PROWS ? in[nv::I_XP] + (size_t)m0 * DM : in[nv::I_XS] + (size_t)(m0 - PROWS) * DM; const bool two = m1 < MROWS; const int m1c = two ? m1 : m0;
        const float* s1p = m1c < PROWS ? in[nv::I_XP] + (size_t)m1c * DM : in[nv::I_XS] + (size_t)(m1c - PROWS) * DM;
        f32x4 va[4], vb[4];
#pragma unroll
        for (int j = 0; j < 4; ++j) { va[j] = __builtin_nontemporal_load((const GAS f32x4*)s0p + F.lane + 64 * j); vb[j] = __builtin_nontemporal_load((const GAS f32x4*)s1p + F.lane + 64 * j); }
        float sa = 0.f, sb = 0.f; GAS unsigned long long* oa = (GAS unsigned long long*)(XB + (size_t)m0 * DM) + F.lane; GAS unsigned long long* ob = (GAS unsigned long long*)(XB + (size_t)m1c * DM) + F.lane;
#pragma unroll
        for (int j = 0; j < 4; ++j) { sa += (va[j].x * va[j].x + va[j].y * va[j].y) + (va[j].z * va[j].z + va[j].w * va[j].w); sb += (vb[j].x * vb[j].x + vb[j].y * vb[j].y) + (vb[j].z * vb[j].z + vb[j].w * vb[j].w);
            oa[64 * j] = (unsigned long long)pk2(va[j].x, va[j].y) | ((unsigned long long)pk2(va[j].z, va[j].w) << 32); if (two) ob[64 * j] = (unsigned long long)pk2(vb[j].x, vb[j].y) | ((unsigned long long)pk2(vb[j].z, vb[j].w) << 32); }
        sa = wave_sum(sa); sb = wave_sum(sb);
        if (F.lane < 16) { SSQ[(size_t)m0 * 16 + F.lane] = F.lane == 0 ? sa : 0.f; if (two) SSQ[(size_t)m1 * 16 + F.lane] = F.lane == 0 ? sb : 0.f; } }
    bf16* MEMB = (bf16*)(ws + WSO.memb); float* MSSQ = (float*)(ws + WSO.mssq);
    for (int m = gw; m < MEMROWS; m += NGW) { const float s = row_to_bf16(in[nv::I_MEM] + (size_t)m * DM, MEMB + (size_t)m * DM, F.lane); if (F.lane == 0) MSSQ[m] = s; }
}
__device__ __forceinline__ void convert_range(const Frame& F, const float* const* in, unsigned char* ws, int lo, int hi, int widx, int nw) {
    LAS float* scr = (LAS float*)(F.lds + RING_OFF + F.wave * 16384);
    for (int g = lo + widx; g < hi; g += 2 * nw) { WRegs A, B; const bool two = g + nw < hi; witem_load(A, in, g, F.lane); if (two) witem_load(B, in, g + nw, F.lane);
        witem_store(A, in, ws, scr, g, F.lane); if (two) witem_store(B, in, ws, scr, g + nw, F.lane); }
}
__device__ __forceinline__ void p_final(const Frame& F, const float* const* in, float* out, unsigned char* ws) {
    const int gw = F.vcu * NWAVES + F.wave, NGW = F.G * NWAVES; const bf16* XB = (const bf16*)(ws + WSO.xb); const float* SSQ = (const float*)(ws + WSO.ssq); const float* g = in[nv::I_FING];
    f32x4 gv[4];
#pragma unroll
    for (int j = 0; j < 4; ++j) gv[j] = ((const GAS f32x4*)g)[F.lane + 64 * j];
    for (int m0 = gw; m0 < MROWS; m0 += 2 * NGW) { const int m1 = m0 + NGW < MROWS ? m0 + NGW : m0; unsigned long long xw[2][4]; f32x4 sv[2][4];
#pragma unroll
        for (int q = 0; q < 2; ++q) { const int m = q ? m1 : m0; const GAS f32x4* sp = (const GAS f32x4*)(SSQ + (size_t)m * 16); const GAS unsigned long long* xr = (const GAS unsigned long long*)(XB + (size_t)m * DM) + F.lane;
#pragma unroll
            for (int j = 0; j < 4; ++j) { sv[q][j] = sp[j]; xw[q][j] = __builtin_nontemporal_load(xr + 64 * j); } }
#pragma unroll
        for (int q = 0; q < 2; ++q) { const int m = q ? m1 : m0; if (q == 1 && m1 == m0) break;
        const f32x4 s0 = sv[q][0], s1 = sv[q][1], s2 = sv[q][2], s3 = sv[q][3];
        const float ss = ((s0.x + s0.y) + (s0.z + s0.w)) + ((s1.x + s1.y) + (s1.z + s1.w)) + ((s2.x + s2.y) + (s2.z + s2.w)) + ((s3.x + s3.y) + (s3.z + s3.w));
        const float rs = rsqrtf(ss * (1.0f / DM) + 1e-6f); GAS f32x4* yo = (GAS f32x4*)(out + OUTO.yp + (size_t)m * DM) + F.lane;
#pragma unroll
        for (int j = 0; j < 4; ++j) { const unsigned long long w = xw[q][j]; const unsigned lo = (unsigned)w, hi = (unsigned)(w >> 32);
            const f32x4 x = {__uint_as_float(lo << 16), __uint_as_float(lo & 0xffff0000u), __uint_as_float(hi << 16), __uint_as_float(hi & 0xffff0000u)}; __builtin_nontemporal_store(x * rs * gv[j], yo + 64 * j); } } }
}
namespace mx {
typedef short bf16x8 __attribute__((ext_vector_type(8)));
typedef short s16x4 __attribute__((ext_vector_type(4)));
typedef float f32x4 __attribute__((ext_vector_type(4)));
typedef unsigned u32x4 __attribute__((ext_vector_type(4)));
typedef unsigned u32x2 __attribute__((ext_vector_type(2)));
typedef LAS unsigned char* ldsp;
constexpr int ZQ = 0, ZK = 512, ZV = 1024, ZO = 1536, GQ = 2048, GK = 2304, GV = 2560, GG = 3072, ZWD = 3584, ZGP = 32;
constexpr int KP = 272, VP = 304, GP = 144, HP = 132;
constexpr int NITEM = 1024;
__device__ __forceinline__ float bf2f(unsigned short v) { return __uint_as_float((unsigned)v << 16); }
__device__ __forceinline__ float lsig(float x) { return fminf(x, 0.f) - __logf(1.f + __expf(-fabsf(x))); }
template <int CTRL, int ROW_MASK> __device__ __forceinline__ float dpp_get(float old, float x) { return __builtin_bit_cast(float, __builtin_amdgcn_update_dpp(__builtin_bit_cast(int, old), __builtin_bit_cast(int, x), CTRL, ROW_MASK, 0xF, false)); }
__device__ __forceinline__ float wscan_add(float v, int) {
    v += dpp_get<0x111, 0xF>(0.f, v); v += dpp_get<0x112, 0xF>(0.f, v); v += dpp_get<0x114, 0xF>(0.f, v); v += dpp_get<0x118, 0xF>(0.f, v);
    v += dpp_get<0x142, 0xA>(0.f, v); v += dpp_get<0x143, 0xC>(0.f, v); return v; }
__device__ __forceinline__ float wscan_max(float v, int) { const float ni = -INFINITY;
    v = fmaxf(v, dpp_get<0x111, 0xF>(ni, v)); v = fmaxf(v, dpp_get<0x112, 0xF>(ni, v)); v = fmaxf(v, dpp_get<0x114, 0xF>(ni, v)); v = fmaxf(v, dpp_get<0x118, 0xF>(ni, v));
    v = fmaxf(v, dpp_get<0x142, 0xA>(ni, v)); v = fmaxf(v, dpp_get<0x143, 0xC>(ni, v)); return v; }
__device__ __forceinline__ float wlast(float v) { return __builtin_bit_cast(float, __builtin_amdgcn_readlane(__builtin_bit_cast(int, v), 63)); }
__device__ __forceinline__ float wmax(float v) { return wlast(wscan_max(v, 0)); }
__device__ __forceinline__ float wsum(float v) { return wlast(wscan_add(v, 0)); }
__device__ __forceinline__ f32x4 mma(bf16x8 a, bf16x8 b, f32x4 c) { return __builtin_amdgcn_mfma_f32_16x16x32_bf16(a, b, c, 0, 0, 0); }
__device__ __forceinline__ bf16x8 frag_row(ldsp base, int pitchB, int row0, int k0, int lane) { return *(const LAS bf16x8*)(base + (row0 + (lane & 15)) * pitchB + (k0 + 8 * (lane >> 4)) * 2); }
__device__ __forceinline__ bf16x8 frag_tr(ldsp base, int pitchB, int k0, int col0, int lane) {
    ldsp p = base + (k0 + 8 * (lane >> 4) + ((lane & 15) >> 2)) * pitchB + (col0 + 4 * (lane & 3)) * 2;
    const s16x4 lo = __builtin_bit_cast(s16x4, __builtin_amdgcn_ds_read_tr16_b64_v4i16((LAS s16x4*)p));
    const s16x4 hi = __builtin_bit_cast(s16x4, __builtin_amdgcn_ds_read_tr16_b64_v4i16((LAS s16x4*)(p + 4 * pitchB)));
    return (bf16x8){lo[0], lo[1], lo[2], lo[3], hi[0], hi[1], hi[2], hi[3]}; }
__device__ __forceinline__ unsigned pkbf(float lo, float hi) { return pk2(lo, hi); }
template <int NCH> __device__ __forceinline__ void stage_tile(ldsp dst, int pb, const bf16* src, size_t gp, int rows, int tid) {
    for (int id = tid; id < rows * NCH; id += 512) { const int s = id / NCH, ch = id % NCH; *(LAS u32x4*)(dst + s * pb + ch * 16) = *(const GAS u32x4*)(src + (size_t)s * gp + ch * 8); } }
struct Ctx { const bf16* Z; const float* ZG; unsigned char* ws; const float* const* in; float* out; ldsp L; int tid, lane, wave, pad; };

__device__ __forceinline__ void scan_phase(const Ctx& c, int gtid, int nthreads) {
    const float* ML = (const float*)(c.ws + WSO.mloc);
    for (int q = gtid; q < 32 * 4096; q += nthreads) { const int bh = q >> 12, e = (q & 4095) * 4, e2 = (q & 4095) * 2, d2 = e2 >> 7;
        const bf16* CL = (const bf16*)(c.ws + WSO.cloc) + (size_t)bh * 32 * 16384 + e; bf16* CS = (bf16*)(c.ws + WSO.cst) + (size_t)bh * 32 * 16384 + e;
        const bf16* SL = (const bf16*)(c.ws + WSO.sloc) + (size_t)bh * 32 * 8192 + e2; bf16* SS = (bf16*)(c.ws + WSO.sst) + (size_t)bh * 32 * 8192 + e2; const float* GD = (const float*)(c.ws + WSO.gdec) + (size_t)bh * 32 * 64 + d2;
        f32x4 C = {0.f, 0.f, 0.f, 0.f}; float m = 0.f, S0 = 0.f, S1 = 0.f;
        for (int c0 = 0; c0 < 32; c0 += 8) { u32x2 lw[8]; unsigned sw[8]; float mlv[8], blv[8], gd[8];
#pragma unroll
            for (int j = 0; j < 8; ++j) { lw[j] = __builtin_nontemporal_load((const GAS u32x2*)(CL + (size_t)(c0 + j) * 16384)); sw[j] = __builtin_nontemporal_load((const GAS unsigned*)(SL + (size_t)(c0 + j) * 8192)); mlv[j] = ML[(bh * 32 + c0 + j) * 2]; blv[j] = ML[(bh * 32 + c0 + j) * 2 + 1]; gd[j] = GD[(c0 + j) * 64]; }
#pragma unroll
            for (int j = 0; j < 8; ++j) { u32x2 o; o.x = pkbf(C[0], C[1]); o.y = pkbf(C[2], C[3]); *(GAS u32x2*)(CS + (size_t)(c0 + j) * 16384) = o; *(GAS unsigned*)(SS + (size_t)(c0 + j) * 8192) = pkbf(S0, S1);
                const float mn = fmaxf(blv[j] + m, mlv[j]), fC = __expf(blv[j] + m - mn), fL = __expf(mlv[j] - mn);
                const f32x4 l = {__uint_as_float(lw[j][0] << 16), __uint_as_float(lw[j][0] & 0xffff0000u), __uint_as_float(lw[j][1] << 16), __uint_as_float(lw[j][1] & 0xffff0000u)}; C = C * fC + l * fL; m = mn;
                S0 = S0 * gd[j] + __uint_as_float(sw[j] << 16); S1 = S1 * gd[j] + __uint_as_float(sw[j] & 0xffff0000u); } }
        *(GAS f32x4*)(c.out + OUTO.cp + (size_t)bh * 16384 + e) = C; float* so = c.out + OUTO.sp + (size_t)bh * 8192 + e2; so[0] = S0; so[1] = S1; }
    for (int q = nthreads - 1 - gtid; q < 32 * 128; q += nthreads) { const int bh = q >> 7, d = q & 127; const float* NL = (const float*)(c.ws + WSO.nloc) + (size_t)bh * 32 * 128 + d; float* NS = (float*)(c.ws + WSO.nst) + (size_t)bh * 32 * 128 + d; float* MS = (float*)(c.ws + WSO.mst) + bh * 32;
        float n = 0.f, m = 0.f;
        for (int c0 = 0; c0 < 32; c0 += 8) { float nl[8], mlv[8], blv[8];
#pragma unroll
            for (int j = 0; j < 8; ++j) { nl[j] = NL[(c0 + j) * 128]; mlv[j] = ML[(bh * 32 + c0 + j) * 2]; blv[j] = ML[(bh * 32 + c0 + j) * 2 + 1]; }
#pragma unroll
            for (int j = 0; j < 8; ++j) { NS[(c0 + j) * 128] = n; if (d == 0) MS[c0 + j] = m; const float mn = fmaxf(blv[j] + m, mlv[j]); n = n * __expf(blv[j] + m - mn) + nl[j] * __expf(mlv[j] - mn); m = mn; } }
        c.out[OUTO.np + bh * 128 + d] = n; if (d == 0) c.out[OUTO.mp + bh] = m; }
}
}
namespace mx {
#define MX_BAR_LDS() do { asm volatile("s_waitcnt lgkmcnt(0)" ::: "memory"); __builtin_amdgcn_s_barrier(); asm volatile("" ::: "memory"); } while (0)
__device__ __forceinline__ void sample_mlstm(const Ctx& c, int item) {
    const int b = item >> 2, h = item & 3, r0 = 16384 + 4 * b;
    LAS float* SQ = (LAS float*)(c.L); LAS float *SK = SQ + 512, *SV = SQ + 1024, *GS = SQ + 1536  , *QK = SQ + 1600  , *PS = SQ + 1632, *RED = SQ + 2048  ;
    const float* C0 = c.in[nv::I_SC] + (size_t)item * 16384; const float* n0 = c.in[nv::I_SN] + item * 128;
    f32x4 cst[8];
#pragma unroll
    for (int j = 0; j < 8; ++j) cst[j] = __builtin_nontemporal_load((const GAS f32x4*)(C0 + ((c.tid >> 5) * 8 + j) * 128 + 4 * (c.tid & 31)));
    { const int t = c.tid >> 7, d = c.tid & 127; const bf16* zr = c.Z + (size_t)(r0 + t) * ZWD + h * 128 + d; SQ[c.tid] = bf2f(zr[ZQ]); SK[c.tid] = bf2f(zr[ZK]); SV[c.tid] = bf2f(zr[ZV]); }
    if (c.tid == 0) { float ip[4], bb[4], a[4]; const float m0 = c.in[nv::I_SM][item]; float run = 0.f;
#pragma unroll
        for (int t = 0; t < 4; ++t) { ip[t] = c.ZG[(r0 + t) * ZGP + h] + c.in[nv::I_BI][h]; run += lsig(c.ZG[(r0 + t) * ZGP + 4 + h] + c.in[nv::I_BF][h]); bb[t] = run; a[t] = run + m0; }
#pragma unroll
        for (int t = 0; t < 4; ++t) { float mt = a[t];
#pragma unroll
            for (int s = 0; s < 4; ++s) if (s <= t) mt = fmaxf(mt, bb[t] - bb[s] + ip[s]);
            GS[t] = __expf(a[t] - mt); GS[4 + t] = mt;
#pragma unroll
            for (int s = 0; s < 4; ++s) GS[8 + t * 4 + s] = (s <= t) ? __expf(bb[t] - bb[s] + ip[s] - mt) : 0.f; } }
    MX_BAR_LDS();
    {
#pragma unroll
        for (int q = 0; q < 2; ++q) { const int p = 2 * c.wave + q, t = p >> 2, s = p & 3; const float v = wsum(SQ[t * 128 + c.lane] * SK[s * 128 + c.lane] + SQ[t * 128 + 64 + c.lane] * SK[s * 128 + 64 + c.lane]); if (c.lane == 0) QK[p] = v; }
        if (c.wave < 4) { const float v = wsum(SQ[c.wave * 128 + c.lane] * n0[c.lane] + SQ[c.wave * 128 + 64 + c.lane] * n0[64 + c.lane]); if (c.lane == 0) QK[16 + c.wave] = v; } }
    {
        const int v4 = c.tid & 31, dg = c.tid >> 5; const float iL = GS[3]; const float wl0 = GS[8 + 12], wl1 = GS[8 + 13], wl2 = GS[8 + 14], wl3 = GS[8 + 15];
        f32x4 p0 = {0.f, 0.f, 0.f, 0.f}, p1 = p0, p2 = p0, p3 = p0; const f32x4 v0 = *(const LAS f32x4*)(SV + 4 * v4), v1 = *(const LAS f32x4*)(SV + 128 + 4 * v4), v2 = *(const LAS f32x4*)(SV + 256 + 4 * v4), v3 = *(const LAS f32x4*)(SV + 384 + 4 * v4);
        float* Co = c.out + OUTO.cs + (size_t)item * 16384;
#pragma unroll
        for (int j = 0; j < 8; ++j) { const int d = dg * 8 + j; const f32x4 cv = cst[j];
            p0 += cv * SQ[d]; p1 += cv * SQ[128 + d]; p2 += cv * SQ[256 + d]; p3 += cv * SQ[384 + d];
            __builtin_nontemporal_store(cv * iL + v0 * (wl0 * SK[d]) + v1 * (wl1 * SK[128 + d]) + v2 * (wl2 * SK[256 + d]) + v3 * (wl3 * SK[384 + d]), (GAS f32x4*)(Co + d * 128 + 4 * v4)); }
        *(LAS f32x4*)(RED + (dg * 4 + 0) * 128 + 4 * v4) = p0; *(LAS f32x4*)(RED + (dg * 4 + 1) * 128 + 4 * v4) = p1; *(LAS f32x4*)(RED + (dg * 4 + 2) * 128 + 4 * v4) = p2; *(LAS f32x4*)(RED + (dg * 4 + 3) * 128 + 4 * v4) = p3;
        if (c.tid < 128) { const int d = c.tid; c.out[OUTO.ns + item * 128 + d] = iL * n0[d] + wl0 * SK[d] + wl1 * SK[128 + d] + wl2 * SK[256 + d] + wl3 * SK[384 + d]; }
        if (c.tid == 0) c.out[OUTO.ms + item] = GS[7]; }
    MX_BAR_LDS();
    float hval;
    { const int t = c.tid >> 7, v = c.tid & 127; float qc = 0.f;
#pragma unroll
      for (int dg = 0; dg < 16; ++dg) qc += RED[(dg * 4 + t) * 128 + v];
      const float wi = GS[t]; float num = wi * qc, den = wi * QK[16 + t];
#pragma unroll
      for (int s = 0; s < 4; ++s) { const float st = QK[t * 4 + s] * GS[8 + t * 4 + s]; num += st * SV[s * 128 + v]; den += st; }
      hval = num / fmaxf(fabsf(den), __expf(-GS[4 + t]));
      const float ss = wsum(hval * hval); if (c.lane == 0) PS[c.wave] = ss; }
    MX_BAR_LDS();
    { const int t = c.tid >> 7, v = c.tid & 127; const float rs = rsqrtf((PS[2 * t] + PS[2 * t + 1]) * (1.0f / 128.0f) + 1e-6f); const float g = bf2f(c.Z[(size_t)(r0 + t) * ZWD + ZO + h * 128 + v]);
      ((bf16*)(c.ws + WSO.ymix))[(size_t)(r0 + t) * 1024 + h * 128 + v] = (bf16)f2bf(hval * rs * c.in[nv::I_MLOG][h * 128 + v] / (1.f + __expf(-g))); }
    MX_BAR_LDS();
}
__device__ __forceinline__ void sample_gla(const Ctx& c, int item) {
    const int b = item >> 2, h = item & 3, r0 = 16384 + 4 * b;
    LAS float* SQ = (LAS float*)(c.L); LAS float *SKH = SQ + 256  , *SKM = SQ + 512  , *BC = SQ + 768, *SV = SQ + 1024  , *AQ = SQ + 1536, *PS = SQ + 1568, *RED = SQ + 2048  ;
    const float* S0 = c.in[nv::I_SS] + (size_t)item * 8192;
    f32x4 sst[4];
#pragma unroll
    for (int j = 0; j < 4; ++j) sst[j] = __builtin_nontemporal_load((const GAS f32x4*)(S0 + ((c.tid >> 5) * 4 + j) * 128 + 4 * (c.tid & 31)));
    if (c.tid < 256) { const int t = c.tid >> 6, d = c.tid & 63; float a = c.in[nv::I_BA][h * 64 + d];
#pragma unroll
        for (int r = 0; r < 16; ++r) a += c.ZG[(r0 + t) * ZGP + 8 + r] * c.in[nv::I_WA2][r * 256 + h * 64 + d];
        BC[c.tid] = lsig(a) * 0.0625f; }
    { const int t = c.tid >> 7, v = c.tid & 127; SV[c.tid] = bf2f(c.Z[(size_t)(r0 + t) * ZWD + GV + h * 128 + v]); }
    MX_BAR_LDS();
    if (c.tid < 64) { float run = 0.f;
#pragma unroll
        for (int t = 0; t < 4; ++t) { run += BC[t * 64 + c.tid]; BC[t * 64 + c.tid] = run; } }
    MX_BAR_LDS();
    if (c.tid < 256) { const int t = c.tid >> 6, d = c.tid & 63; const bf16* zr = c.Z + (size_t)(r0 + t) * ZWD + h * 64 + d; const float bc = BC[c.tid], bl = BC[192 + d], k = bf2f(zr[GK]);
        SQ[c.tid] = bf2f(zr[GQ]) * __expf(bc); SKH[c.tid] = k * __expf(bl - bc); SKM[c.tid] = k * __expf(-bc); }
    MX_BAR_LDS();
#pragma unroll
    for (int q = 0; q < 2; ++q) { const int p = 2 * c.wave + q, t = p >> 2, s = p & 3; const float v = wsum(SQ[t * 64 + c.lane] * SKM[s * 64 + c.lane]); if (c.lane == 0) AQ[p] = (s <= t) ? v : 0.f; }
    { const int v4 = c.tid & 31, dg = c.tid >> 5; f32x4 p0 = {0.f, 0.f, 0.f, 0.f}, p1 = p0, p2 = p0, p3 = p0;
      const f32x4 v0 = *(const LAS f32x4*)(SV + 4 * v4), v1 = *(const LAS f32x4*)(SV + 128 + 4 * v4), v2 = *(const LAS f32x4*)(SV + 256 + 4 * v4), v3 = *(const LAS f32x4*)(SV + 384 + 4 * v4);
      float* So = c.out + OUTO.ss + (size_t)item * 8192;
#pragma unroll
      for (int j = 0; j < 4; ++j) { const int d = dg * 4 + j; const f32x4 sv = sst[j];
          p0 += sv * SQ[d]; p1 += sv * SQ[64 + d]; p2 += sv * SQ[128 + d]; p3 += sv * SQ[192 + d];
          __builtin_nontemporal_store(sv * __expf(BC[192 + d]) + v0 * SKH[d] + v1 * SKH[64 + d] + v2 * SKH[128 + d] + v3 * SKH[192 + d], (GAS f32x4*)(So + d * 128 + 4 * v4)); }
      *(LAS f32x4*)(RED + (dg * 4 + 0) * 128 + 4 * v4) = p0; *(LAS f32x4*)(RED + (dg * 4 + 1) * 128 + 4 * v4) = p1; *(LAS f32x4*)(RED + (dg * 4 + 2) * 128 + 4 * v4) = p2; *(LAS f32x4*)(RED + (dg * 4 + 3) * 128 + 4 * v4) = p3; }
    MX_BAR_LDS();
    float hval;
    { const int t = c.tid >> 7, v = c.tid & 127; float o = 0.f;
#pragma unroll
      for (int dg = 0; dg < 16; ++dg) o += RED[(dg * 4 + t) * 128 + v];
#pragma unroll
      for (int s = 0; s < 4; ++s) o += AQ[t * 4 + s] * SV[s * 128 + v];
      hval = o; const float ss = wsum(hval * hval); if (c.lane == 0) PS[c.wave] = ss; }
    MX_BAR_LDS();
    { const int t = c.tid >> 7, v = c.tid & 127; const float rs = rsqrtf((PS[2 * t] + PS[2 * t + 1]) * (1.0f / 128.0f) + 1e-6f); const float g = bf2f(c.Z[(size_t)(r0 + t) * ZWD + GG + h * 128 + v]);
      ((bf16*)(c.ws + WSO.ymix))[(size_t)(r0 + t) * 1024 + 512 + h * 128 + v] = (bf16)f2bf(hval * rs * c.in[nv::I_GLOG][h * 128 + v] * g / (1.f + __expf(-g))); }
    MX_BAR_LDS();
}
}
namespace m2 {
using namespace mx;
#define BAR_LDS() do { asm volatile("s_waitcnt lgkmcnt(0)" ::: "memory"); __builtin_amdgcn_s_barrier(); asm volatile("" ::: "memory"); } while (0)
constexpr int WA_OFF = 110592;
constexpr int GN_OFF = 131584;
constexpr int PRIV_OFF = 75776, PRIV_BYTES = 4224, PSQ_OFF = 109568;
__device__ __forceinline__ void load_wa(const Ctx& c) {
    LAS float* WA = (LAS float*)(c.L + WA_OFF);
    for (int i = c.tid; i < 1024; i += 512) *(LAS f32x4*)(WA + 4 * i) = *(const GAS f32x4*)(c.in[nv::I_WA2] + 4 * i);
    if (c.tid < 64) *(LAS f32x4*)(WA + 4096 + 4 * c.tid) = *(const GAS f32x4*)(c.in[nv::I_BA] + 4 * c.tid);
    LAS float* GN = (LAS float*)(c.L + GN_OFF);
    if (c.tid < 128) *(LAS f32x4*)(GN + 4 * c.tid) = *(const GAS f32x4*)(c.in[nv::I_MLOG] + 4 * c.tid); else if (c.tid < 256) *(LAS f32x4*)(GN + 4 * c.tid) = *(const GAS f32x4*)(c.in[nv::I_GLOG] + 4 * (c.tid - 128));
    else if (c.tid < 260) GN[1024 + (c.tid - 256)] = c.in[nv::I_BI][c.tid - 256]; else if (c.tid < 264) GN[1028 + (c.tid - 260)] = c.in[nv::I_BF][c.tid - 260];
    BAR_LDS();
}
struct Item { int b, h, ch, r0; };
__device__ __forceinline__ Item decode(int item) { Item it; const int bh = item >> 5; it.ch = item & 31; it.b = bh >> 2; it.h = bh & 3; it.r0 = it.b * 2048 + it.ch * 64; return it; }
struct LmRegs { float zi, zf; u32x4 k[2], v[2]; };
__device__ __forceinline__ void lm_load(LmRegs& R, const Ctx& c, int item) { const Item it = decode(item);
    R.zi = c.ZG[(size_t)(it.r0 + c.lane) * ZGP + it.h]; R.zf = c.ZG[(size_t)(it.r0 + c.lane) * ZGP + 4 + it.h];
#pragma unroll
    for (int j = 0; j < 2; ++j) { const int id = c.tid + 512 * j, s = id >> 4, cc = id & 15; const bf16* zr = c.Z + (size_t)(it.r0 + s) * ZWD + it.h * 128 + cc * 8; R.k[j] = *(const GAS u32x4*)(zr + ZK); R.v[j] = *(const GAS u32x4*)(zr + ZV); } }
__device__ __forceinline__ void lm_stage(const LmRegs& R, const Ctx& c, int item, ldsp Ks, ldsp Vs) { const Item it = decode(item);
    const LAS float* GB = (const LAS float*)(c.L + GN_OFF) + 1024; const float ip = R.zi + GB[it.h], lf = lsig(R.zf + GB[4 + it.h]); const float bc = wscan_add(lf, c.lane), bL = wlast(bc), g = bL - bc + ip, ml = wmax(g), w = __expf(g - ml);
    if (c.tid == 0) { float* M = (float*)(c.ws + WSO.mloc); M[item * 2] = ml; M[item * 2 + 1] = bL; }
#pragma unroll
    for (int j = 0; j < 2; ++j) { const int id = c.tid + 512 * j, s = id >> 4, cc = id & 15; const float wv = shl(w, s); *(LAS u32x4*)(Ks + s * KP + cc * 16) = R.k[j]; u32x4 o;
#pragma unroll
        for (int q = 0; q < 4; ++q) o[q] = pkbf(bf2f((unsigned short)(R.v[j][q] & 0xffffu)) * wv, bf2f((unsigned short)(R.v[j][q] >> 16)) * wv);
        *(LAS u32x4*)(Vs + s * VP + cc * 16) = o; }
    { const int s = (c.tid >> 1) & 63; const float wv = shl(w, s); if (c.tid < 128) { u32x4 o = {0u, 0u, 0u, 0u}; if ((c.tid & 1) == 0) o[0] = pkbf(wv, 0.f); *(LAS u32x4*)(Vs + s * VP + 256 + (c.tid & 1) * 16) = o; } } }
__device__ __forceinline__ void lm_compute(const Ctx& c, int item, ldsp Ks, ldsp Vs) {
    const int d0 = 16 * c.wave; const bf16x8 b0 = frag_tr(Ks, KP, 0, d0, c.lane), b1 = frag_tr(Ks, KP, 32, d0, c.lane);
    bf16* CL = (bf16*)(c.ws + WSO.cloc) + (size_t)item * 16384; float* NL = (float*)(c.ws + WSO.nloc) + (size_t)item * 128;
#pragma unroll
    for (int vt = 0; vt < 9; ++vt) { f32x4 acc = {0.f, 0.f, 0.f, 0.f}; acc = mma(frag_tr(Vs, VP, 0, 16 * vt, c.lane), b0, acc); acc = mma(frag_tr(Vs, VP, 32, 16 * vt, c.lane), b1, acc);
        if (vt < 8) { u32x2 o; o[0] = pkbf(acc[0], acc[1]); o[1] = pkbf(acc[2], acc[3]); *(GAS u32x2*)(CL + (d0 + (c.lane & 15)) * 128 + 16 * vt + 4 * (c.lane >> 4)) = o; }
        else if ((c.lane >> 4) == 0) NL[d0 + (c.lane & 15)] = acc[0]; } }
__device__ __forceinline__ void run_local_mlstm(const Ctx& c, int cu, int G) {
    int item = cu; LmRegs R; if (item < NITEM) lm_load(R, c, item); int set = 0;
    for (; item < NITEM; item += G) { ldsp Ks = c.L + set * 36864, Vs = Ks + 17408; lm_stage(R, c, item, Ks, Vs); if (item + G < NITEM) lm_load(R, c, item + G); BAR_LDS(); lm_compute(c, item, Ks, Vs); set ^= 1; }
    BAR_LDS(); }
__device__ __forceinline__ void gla_bc_wave(const Ctx& c, const f32x4 (&ga)[4], int h, float (&bc)[8]) {
    const LAS float* WA = (const LAS float*)(c.L + WA_OFF) + h * 64 + c.wave * 8; const LAS float* BA = (const LAS float*)(c.L + WA_OFF) + 4096 + h * 64 + c.wave * 8;
#pragma unroll
    for (int j = 0; j < 8; ++j) { float a = BA[j];
#pragma unroll
        for (int q = 0; q < 4; ++q) { a += ga[q][0] * WA[(4 * q) * 256 + j]; a += ga[q][1] * WA[(4 * q + 1) * 256 + j]; a += ga[q][2] * WA[(4 * q + 2) * 256 + j]; a += ga[q][3] * WA[(4 * q + 3) * 256 + j]; }
        bc[j] = wscan_add(lsig(a) * 0.0625f, c.lane); } }
struct LgRegs { f32x4 ga[4]; u32x4 k; u32x4 v[2]; };
__device__ __forceinline__ void lg_load(LgRegs& R, const Ctx& c, int item) { const Item it = decode(item);
#pragma unroll
    for (int q = 0; q < 4; ++q) R.ga[q] = *(const GAS f32x4*)(c.ZG + (size_t)(it.r0 + c.lane) * ZGP + 8 + 4 * q);
    R.k = *(const GAS u32x4*)(c.Z + (size_t)(it.r0 + c.lane) * ZWD + GK + it.h * 64 + c.wave * 8);
#pragma unroll
    for (int j = 0; j < 2; ++j) { const int id = c.tid + 512 * j, s = id >> 4, cc = id & 15; R.v[j] = *(const GAS u32x4*)(c.Z + (size_t)(it.r0 + s) * ZWD + GV + it.h * 128 + cc * 8); } }
__device__ __forceinline__ void lg_stage(const LgRegs& R, const Ctx& c, int item, ldsp Gk, ldsp Gv) { const Item it = decode(item); float bc[8]; gla_bc_wave(c, R.ga, it.h, bc); u32x4 o;
#pragma unroll
    for (int q = 0; q < 4; ++q) { const float bl0 = wlast(bc[2 * q]), bl1 = wlast(bc[2 * q + 1]);
        o[q] = pkbf(bf2f((unsigned short)(R.k[q] & 0xffffu)) * __expf(bl0 - bc[2 * q]), bf2f((unsigned short)(R.k[q] >> 16)) * __expf(bl1 - bc[2 * q + 1]));
        if (c.lane == 63) { float* GD = (float*)(c.ws + WSO.gdec) + item * 64 + c.wave * 8 + 2 * q; GD[0] = __expf(bl0); GD[1] = __expf(bl1); } }
    *(LAS u32x4*)(Gk + c.lane * GP + c.wave * 16) = o;
#pragma unroll
    for (int j = 0; j < 2; ++j) { const int id = c.tid + 512 * j, s = id >> 4, cc = id & 15; *(LAS u32x4*)(Gv + s * KP + cc * 16) = R.v[j]; } }
__device__ __forceinline__ void lg_compute(const Ctx& c, int item, ldsp Gk, ldsp Gv) {
    const int d0 = 16 * (c.wave & 3), vt0 = (c.wave >> 2) * 4; const bf16x8 b0 = frag_tr(Gk, GP, 0, d0, c.lane), b1 = frag_tr(Gk, GP, 32, d0, c.lane); bf16* SL = (bf16*)(c.ws + WSO.sloc) + (size_t)item * 8192;
#pragma unroll
    for (int q = 0; q < 4; ++q) { const int vt = vt0 + q; f32x4 acc = {0.f, 0.f, 0.f, 0.f}; acc = mma(frag_tr(Gv, KP, 0, 16 * vt, c.lane), b0, acc); acc = mma(frag_tr(Gv, KP, 32, 16 * vt, c.lane), b1, acc);
        u32x2 o; o[0] = pkbf(acc[0], acc[1]); o[1] = pkbf(acc[2], acc[3]); *(GAS u32x2*)(SL + (d0 + (c.lane & 15)) * 128 + 16 * vt + 4 * (c.lane >> 4)) = o; } }
__device__ __forceinline__ void run_local_gla(const Ctx& c, int cu, int G) {
    int item = cu; LgRegs R; if (item < NITEM) lg_load(R, c, item); int set = 0;
    for (; item < NITEM; item += G) { ldsp Gk = c.L + set * 26624, Gv = Gk + 9216; lg_stage(R, c, item, Gk, Gv); if (item + G < NITEM) lg_load(R, c, item + G); BAR_LDS(); lg_compute(c, item, Gk, Gv); set ^= 1; }
    BAR_LDS(); }
template <bool ML> __device__ __forceinline__ void tail_out(const Ctx& c, const LAS float* Hp, int r0, int h, int tt, int vh, u32x4 g0, u32x4 g1) {
    LAS float* PSQ = (LAS float*)(c.L + PSQ_OFF); const int t = c.lane >> 2, c0 = (c.lane & 3) * 16; float hv[16]; float ss = 0.f;
#pragma unroll
    for (int j = 0; j < 16; ++j) { hv[j] = Hp[t * 66 + c0 + j]; ss += hv[j] * hv[j]; }
    ss += shx(ss, 1); ss += shx(ss, 2); if ((c.lane & 3) == 0) PSQ[c.wave * 16 + t] = ss;
    const int row = r0 + 16 * tt + t, col = h * 128 + 64 * vh + c0;
    const LAS float* gn = (const LAS float*)(c.L + GN_OFF) + (ML ? 0 : 512) + col; const f32x4 n0 = *(const LAS f32x4*)gn, n1 = *(const LAS f32x4*)(gn + 4), n2 = *(const LAS f32x4*)(gn + 8), n3 = *(const LAS f32x4*)(gn + 12);
    const float gnv[16] = {n0[0], n0[1], n0[2], n0[3], n1[0], n1[1], n1[2], n1[3], n2[0], n2[1], n2[2], n2[3], n3[0], n3[1], n3[2], n3[3]};
    BAR_LDS();
    const float rs = rsqrtf((PSQ[c.wave * 16 + t] + PSQ[(c.wave ^ 4) * 16 + t]) * (1.0f / 128.0f) + 1e-6f);
    bf16* yo = (bf16*)(c.ws + WSO.ymix) + (size_t)row * 1024 + (ML ? 0 : 512) + col; u32x4 o[2];
#pragma unroll
    for (int q = 0; q < 2; ++q)
#pragma unroll
        for (int j = 0; j < 4; ++j) { const unsigned gw = q ? g1[j] : g0[j]; const float ga = bf2f((unsigned short)(gw & 0xffffu)), gb = bf2f((unsigned short)(gw >> 16));
            const float a0 = ML ? 1.f / (1.f + __expf(-ga)) : ga / (1.f + __expf(-ga)), a1 = ML ? 1.f / (1.f + __expf(-gb)) : gb / (1.f + __expf(-gb));
            o[q][j] = pkbf(a0 * hv[8 * q + 2 * j] * rs * gnv[8 * q + 2 * j], a1 * hv[8 * q + 2 * j + 1] * rs * gnv[8 * q + 2 * j + 1]); }
    *(GAS u32x4*)yo = o[0]; *(GAS u32x4*)(yo + 8) = o[1];
}
template <bool ML> __device__ __forceinline__ void gate_load(u32x4 (&gt)[2], const Ctx& c, const Item& it) { const int tt = c.wave & 3, vh = c.wave >> 2, t = c.lane >> 2, c0 = (c.lane & 3) * 16;
    const bf16* gp = c.Z + (size_t)(it.r0 + 16 * tt + t) * ZWD + (ML ? ZO : GG) + it.h * 128 + 64 * vh + c0; gt[0] = *(const GAS u32x4*)gp; gt[1] = *(const GAS u32x4*)(gp + 8); }
struct OmRegs { float zi, zf, mprev, nst; bf16x8 q[4]; u32x4 k[2], v[2], cc[4], gt[2]; };
__device__ __forceinline__ void om_load(OmRegs& R, const Ctx& c, int item) { const Item it = decode(item);
    R.zi = c.ZG[(size_t)(it.r0 + c.lane) * ZGP + it.h]; R.zf = c.ZG[(size_t)(it.r0 + c.lane) * ZGP + 4 + it.h]; R.mprev = ((const float*)(c.ws + WSO.mst))[item]; R.nst = ((const float*)(c.ws + WSO.nst))[item * 128 + (c.tid & 127)];
    const bf16* zr = c.Z + (size_t)it.r0 * ZWD + it.h * 128;
#pragma unroll
    for (int ks = 0; ks < 4; ++ks) R.q[ks] = *(const GAS bf16x8*)(zr + (size_t)(16 * (c.wave & 3) + (c.lane & 15)) * ZWD + ZQ + 32 * ks + 8 * (c.lane >> 4));
#pragma unroll
    for (int j = 0; j < 2; ++j) { const int id = c.tid + 512 * j, s = id >> 4, cc = id & 15; R.k[j] = *(const GAS u32x4*)(zr + (size_t)s * ZWD + ZK + cc * 8); R.v[j] = *(const GAS u32x4*)(zr + (size_t)s * ZWD + ZV + cc * 8); }
    gate_load<true>(R.gt, c, it);
    const bf16* cs = (const bf16*)(c.ws + WSO.cst) + (size_t)item * 16384;
#pragma unroll
    for (int j = 0; j < 4; ++j) { const int id = c.tid + 512 * j; R.cc[j] = __builtin_nontemporal_load((const GAS u32x4*)(cs + id * 8)); } }
__device__ __forceinline__ void om_stage(const OmRegs& R, const Ctx& c, ldsp Ks, ldsp Vs, ldsp Cs) {
#pragma unroll
    for (int j = 0; j < 2; ++j) { const int id = c.tid + 512 * j, s = id >> 4, cc = id & 15; *(LAS u32x4*)(Ks + s * KP + cc * 16) = R.k[j]; *(LAS u32x4*)(Vs + s * VP + cc * 16) = R.v[j]; }
#pragma unroll
    for (int j = 0; j < 4; ++j) { const int id = c.tid + 512 * j, d = id >> 4, cc = id & 15; *(LAS u32x4*)(Cs + d * VP + cc * 16) = R.cc[j]; }
    if (c.tid < 128) { const int s = c.tid >> 1; unsigned zz = 0u; asm volatile("" : "+v"(zz));
        u32x4 o = {zz, zz, zz, zz}; if ((c.tid & 1) == 0) o[0] = zz + 0x3f80u; *(LAS u32x4*)(Vs + s * VP + 256 + (c.tid & 1) * 16) = o;
        u32x4 o2 = {pkbf(R.nst, 0.f), zz, zz, zz}; *(LAS u32x4*)(Cs + c.tid * VP + 256) = o2; u32x4 z = {zz, zz, zz, zz}; *(LAS u32x4*)(Cs + c.tid * VP + 272) = z; } }
__device__ __forceinline__ void om_compute(const OmRegs& R, const Ctx& c, int item, ldsp Ks, ldsp Vs, ldsp Cs) { const Item it = decode(item);
    const int tt = c.wave & 3, vh = c.wave >> 2, g = c.lane >> 4, li = c.lane & 15; ldsp Sp = c.L + PRIV_OFF + c.wave * PRIV_BYTES; LAS float* Hp = (LAS float*)Sp;
    const LAS float* GB = (const LAS float*)(c.L + GN_OFF) + 1024; const float ip = R.zi + GB[it.h], lf = lsig(R.zf + GB[4 + it.h]); const float bc = wscan_add(lf, c.lane), a = bc + R.mprev, u = ip - bc, pm = wscan_max(u, c.lane), mt = fmaxf(a, bc + pm), rt = bc - mt, wi = __expf(a - mt), emt = __expf(-mt);
    float rtv[4], wiv[4], emv[4];
#pragma unroll
    for (int r = 0; r < 4; ++r) { const int t = 16 * tt + 4 * g + r; rtv[r] = shl(rt, t); wiv[r] = shl(wi, t); emv[r] = shl(emt, t); }
#pragma unroll
    for (int st = 0; st < 4; ++st) { const float us = shl(u, 16 * st + li); f32x4 acc = {0.f, 0.f, 0.f, 0.f};
        if (st <= tt) {
#pragma unroll
            for (int ks = 0; ks < 4; ++ks) acc = mma(R.q[ks], frag_row(Ks, KP, 16 * st, 32 * ks, c.lane), acc); }
#pragma unroll
        for (int r = 0; r < 4; ++r) { const int t = 16 * tt + 4 * g + r, s = 16 * st + li; const float v = (s <= t) ? acc[r] * __expf(rtv[r] + us) : 0.f; *(LAS unsigned short*)(Sp + (4 * g + r) * GP + s * 2) = (unsigned short)f2bf(v); } }
    LDS_WAIT();
    const bf16x8 s0 = frag_row(Sp, GP, 0, 0, c.lane), s1 = frag_row(Sp, GP, 0, 32, c.lane);
    f32x4 hv[5];
#pragma unroll
    for (int q = 0; q < 5; ++q) { const int vt = q < 4 ? 4 * vh + q : 8; f32x4 a1 = {0.f, 0.f, 0.f, 0.f}, a2 = {0.f, 0.f, 0.f, 0.f};
        a1 = mma(s0, frag_tr(Vs, VP, 0, 16 * vt, c.lane), a1); a1 = mma(s1, frag_tr(Vs, VP, 32, 16 * vt, c.lane), a1);
#pragma unroll
        for (int ks = 0; ks < 4; ++ks) a2 = mma(R.q[ks], frag_tr(Cs, VP, 32 * ks, 16 * vt, c.lane), a2);
#pragma unroll
        for (int r = 0; r < 4; ++r) hv[q][r] = a1[r] + wiv[r] * a2[r]; }
    LDS_WAIT();
#pragma unroll
    for (int r = 0; r < 4; ++r) { const float den = shl(hv[4][r], 16 * g); const float sc = 1.f / fmaxf(fabsf(den), emv[r]);
#pragma unroll
        for (int q = 0; q < 4; ++q) Hp[(4 * g + r) * 66 + 16 * q + li] = hv[q][r] * sc; }
    LDS_WAIT();
    tail_out<true>(c, Hp, it.r0, it.h, tt, vh, R.gt[0], R.gt[1]);
}
__device__ __forceinline__ void run_out_mlstm(const Ctx& c, int cu, int G) {
    int item = cu; OmRegs R; if (item < NITEM) om_load(R, c, item); ldsp Ks = c.L, Vs = c.L + 17408, Cs = c.L + 36864;
    for (; item < NITEM; item += G) { BAR_LDS(); om_stage(R, c, Ks, Vs, Cs); OmRegs R2 = R; if (item + G < NITEM) om_load(R, c, item + G); BAR_LDS(); om_compute(R2, c, item, Ks, Vs, Cs); }
    BAR_LDS(); }
struct OgRegs { f32x4 ga[4]; u32x4 q, k; u32x4 v[2], s[2], gt[2]; };
__device__ __forceinline__ void og_load(OgRegs& R, const Ctx& c, int item) { const Item it = decode(item);
#pragma unroll
    for (int q = 0; q < 4; ++q) R.ga[q] = *(const GAS f32x4*)(c.ZG + (size_t)(it.r0 + c.lane) * ZGP + 8 + 4 * q);
    const bf16* zr = c.Z + (size_t)(it.r0 + c.lane) * ZWD + it.h * 64 + c.wave * 8; R.q = *(const GAS u32x4*)(zr + GQ); R.k = *(const GAS u32x4*)(zr + GK);
    gate_load<false>(R.gt, c, it);
    const bf16* ss = (const bf16*)(c.ws + WSO.sst) + (size_t)item * 8192;
#pragma unroll
    for (int j = 0; j < 2; ++j) { const int id = c.tid + 512 * j, s = id >> 4, cc = id & 15; R.v[j] = *(const GAS u32x4*)(c.Z + (size_t)(it.r0 + s) * ZWD + GV + it.h * 128 + cc * 8); R.s[j] = __builtin_nontemporal_load((const GAS u32x4*)(ss + id * 8)); } }
__device__ __forceinline__ void og_stage(const OgRegs& R, const Ctx& c, int item, ldsp Gq, ldsp Gk, ldsp Gv, ldsp Gs) { const Item it = decode(item); float bc[8]; gla_bc_wave(c, R.ga, it.h, bc); u32x4 oq, ok;
#pragma unroll
    for (int q = 0; q < 4; ++q) { const float e0 = bc[2 * q], e1 = bc[2 * q + 1];
        oq[q] = pkbf(bf2f((unsigned short)(R.q[q] & 0xffffu)) * __expf(e0), bf2f((unsigned short)(R.q[q] >> 16)) * __expf(e1));
        ok[q] = pkbf(bf2f((unsigned short)(R.k[q] & 0xffffu)) * __expf(-e0), bf2f((unsigned short)(R.k[q] >> 16)) * __expf(-e1)); }
    *(LAS u32x4*)(Gq + c.lane * GP + c.wave * 16) = oq; *(LAS u32x4*)(Gk + c.lane * GP + c.wave * 16) = ok;
#pragma unroll
    for (int j = 0; j < 2; ++j) { const int id = c.tid + 512 * j, s = id >> 4, cc = id & 15; *(LAS u32x4*)(Gv + s * KP + cc * 16) = R.v[j]; *(LAS u32x4*)(Gs + s * KP + cc * 16) = R.s[j]; } }
__device__ __forceinline__ void og_compute(const Ctx& c, int item, ldsp Gq, ldsp Gk, ldsp Gv, ldsp Gs, u32x4 g0, u32x4 g1) { const Item it = decode(item);
    const int tt = c.wave & 3, vh = c.wave >> 2, g = c.lane >> 4, li = c.lane & 15; ldsp Ap = c.L + PRIV_OFF + c.wave * PRIV_BYTES; LAS float* Hp = (LAS float*)Ap;
    const bf16x8 q0 = frag_row(Gq, GP, 16 * tt, 0, c.lane), q1 = frag_row(Gq, GP, 16 * tt, 32, c.lane);
#pragma unroll
    for (int st = 0; st < 4; ++st) { f32x4 acc = {0.f, 0.f, 0.f, 0.f};
        if (st <= tt) { acc = mma(q0, frag_row(Gk, GP, 16 * st, 0, c.lane), acc); acc = mma(q1, frag_row(Gk, GP, 16 * st, 32, c.lane), acc); }
#pragma unroll
        for (int r = 0; r < 4; ++r) { const int t = 16 * tt + 4 * g + r, s = 16 * st + li; *(LAS unsigned short*)(Ap + (4 * g + r) * GP + s * 2) = (unsigned short)f2bf((s <= t) ? acc[r] : 0.f); } }
    LDS_WAIT();
    const bf16x8 a0 = frag_row(Ap, GP, 0, 0, c.lane), a1 = frag_row(Ap, GP, 0, 32, c.lane); f32x4 hv[4];
#pragma unroll
    for (int q = 0; q < 4; ++q) { const int vt = 4 * vh + q; f32x4 acc = {0.f, 0.f, 0.f, 0.f};
        acc = mma(a0, frag_tr(Gv, KP, 0, 16 * vt, c.lane), acc); acc = mma(a1, frag_tr(Gv, KP, 32, 16 * vt, c.lane), acc);
        acc = mma(q0, frag_tr(Gs, KP, 0, 16 * vt, c.lane), acc); acc = mma(q1, frag_tr(Gs, KP, 32, 16 * vt, c.lane), acc); hv[q] = acc; }
    LDS_WAIT();
#pragma unroll
    for (int q = 0; q < 4; ++q)
#pragma unroll
        for (int r = 0; r < 4; ++r) Hp[(4 * g + r) * 66 + 16 * q + li] = hv[q][r];
    LDS_WAIT();
    tail_out<false>(c, Hp, it.r0, it.h, tt, vh, g0, g1);
}
__device__ __forceinline__ void run_out_gla(const Ctx& c, int cu, int G) {
    int item = cu; OgRegs R; if (item < NITEM) og_load(R, c, item); ldsp Gq = c.L, Gk = c.L + 9216, Gv = c.L + 18432, Gs = c.L + 35840;
    for (; item < NITEM; item += G) { BAR_LDS(); og_stage(R, c, item, Gq, Gk, Gv, Gs); const u32x4 g0 = R.gt[0], g1 = R.gt[1]; if (item + G < NITEM) og_load(R, c, item + G); BAR_LDS(); og_compute(c, item, Gq, Gk, Gv, Gs, g0, g1); }
    BAR_LDS(); }
__device__ __forceinline__ void phase_local(const Ctx& c, int cu, int G) {
    load_wa(c);
    if (cu & 1) { run_local_mlstm(c, cu, G); run_local_gla(c, cu, G); }
    for (int it = cu; it < 512; it += G) sample_mlstm(c, it);
    for (int it = cu; it < 512; it += G) sample_gla(c, it);
    if (!(cu & 1)) { BAR_LDS(); run_local_mlstm(c, cu, G); run_local_gla(c, cu, G); }
}
__device__ __forceinline__ void phase_out(const Ctx& c, int cu, int G) { load_wa(c); run_out_mlstm(c, cu, G); run_out_gla(c, cu, G);
#ifdef MK_X2_OM
    run_out_mlstm(c, cu, G);
#endif
#ifdef MK_X2_OG
    run_out_gla(c, cu, G);
#endif
}
}
#undef BAR_LDS
namespace xa {
using mx::bf16x8; using mx::f32x4; using mx::u32x4; using mx::u32x2; using mx::ldsp; using mx::mma; using mx::frag_row; using mx::frag_tr; using mx::bf2f;
#define BAR_LDS() do { asm volatile("s_waitcnt lgkmcnt(0)" ::: "memory"); __builtin_amdgcn_s_barrier(); asm volatile("" ::: "memory"); } while (0)
constexpr int CP = 528;
constexpr int CB_BYTES = 64 * CP;
constexpr int SC_OFF = 2 * CB_BYTES, PL_OFF = SC_OFF + 4096, PLP = 528;
__device__ __forceinline__ void pa_load(u32x4 (&pre)[4], const mx::Ctx& c, int item, int i, int tid) {
    const int b = item >> 5, h = (item >> 3) & 3; const bf16* p; int pitch;
    if (i < 4) { p = (const bf16*)(c.ws + WSO.kb) + (size_t)(b * 256 + 64 * i) * 1024 + h * 256; pitch = 1024; } else { p = (const bf16*)(c.ws + WSO.vt) + (size_t)((b * 4 + h) * 256 + 64 * (i - 4)) * 256; pitch = 256; }
#pragma unroll
    for (int j = 0; j < 4; ++j) { const int id = tid + 512 * j, s = id >> 5, ch = id & 31; pre[j] = *(const GAS u32x4*)(p + (size_t)s * pitch + ch * 8); }
}
__device__ __forceinline__ void pa_store(ldsp buf, const u32x4 (&pre)[4], int tid) {
#pragma unroll
    for (int j = 0; j < 4; ++j) { const int id = tid + 512 * j, s = id >> 5, ch = id & 31; *(LAS u32x4*)(buf + s * CP + ch * 16) = pre[j]; }
}
__device__ __forceinline__ void prompt_stream(const mx::Ctx& c, int cu, int G) {
    ldsp B0 = c.L, B1 = c.L + CB_BYTES; int item = cu; if (item >= 256) return;
    u32x4 pre[4]; pa_load(pre, c, item, 0, c.tid); pa_store(B0, pre, c.tid); BAR_LDS();
    const bf16* Q = (const bf16*)(c.ws + WSO.q); bf16* O = (bf16*)(c.ws + WSO.o); const int g = c.lane >> 4, li = c.lane & 15;
    for (; item < 256; item += G) {
        const int b = item >> 5, h = (item >> 3) & 3, qb = item & 7, row0 = b * 2048 + qb * 256 + c.wave * 32, nxt = item + G;
        bf16x8 qf[2][8];
#pragma unroll
        for (int mt = 0; mt < 2; ++mt)
#pragma unroll
            for (int ks = 0; ks < 8; ++ks) qf[mt][ks] = __builtin_nontemporal_load((const GAS bf16x8*)(Q + (size_t)(row0 + 16 * mt + li) * 1024 + h * 256 + 32 * ks + 8 * g));
        f32x4 sc[2][16]; u32x4 pf[2][8]; float rinv[2] = {0.f, 0.f};
#pragma unroll
        for (int i = 0; i < 8; ++i) {
            ldsp cur = (i & 1) ? B1 : B0; ldsp oth = (i & 1) ? B0 : B1; const bool have_next = (i < 7) || (nxt < 256);
            if (have_next) pa_load(pre, c, i < 7 ? item : nxt, i < 7 ? i + 1 : 0, c.tid);
            if (i < 4) {
#pragma unroll
                for (int nt = 0; nt < 4; ++nt) { f32x4 a0 = {0.f, 0.f, 0.f, 0.f}, a1 = {0.f, 0.f, 0.f, 0.f};
#pragma unroll
                    for (int ks = 0; ks < 8; ++ks) { const bf16x8 kf = frag_row(cur, CP, 16 * nt, 32 * ks, c.lane); a0 = mma(kf, qf[0][ks], a0); a1 = mma(kf, qf[1][ks], a1); }
                    sc[0][i * 4 + nt] = a0; sc[1][i * 4 + nt] = a1; }
                if (i == 3) {
#pragma unroll
                    for (int mt = 0; mt < 2; ++mt) { float m = sc[mt][0][0];
#pragma unroll
                        for (int tl = 0; tl < 16; ++tl)
#pragma unroll
                            for (int r = 0; r < 4; ++r) m = fmaxf(m, sc[mt][tl][r]);
                        m = fmaxf(m, shx(m, 16)); m = fmaxf(m, shx(m, 32)); float s = 0.f;
#pragma unroll
                        for (int tl = 0; tl < 16; ++tl)
#pragma unroll
                            for (int r = 0; r < 4; ++r) { sc[mt][tl][r] = __expf(sc[mt][tl][r] - m); s += sc[mt][tl][r]; }
                        s += shx(s, 16); s += shx(s, 32); rinv[mt] = 1.f / s;
#pragma unroll
                        for (int ks = 0; ks < 8; ++ks) { pf[mt][ks][0] = pk2(sc[mt][2 * ks][0], sc[mt][2 * ks][1]); pf[mt][ks][1] = pk2(sc[mt][2 * ks][2], sc[mt][2 * ks][3]); pf[mt][ks][2] = pk2(sc[mt][2 * ks + 1][0], sc[mt][2 * ks + 1][1]); pf[mt][ks][3] = pk2(sc[mt][2 * ks + 1][2], sc[mt][2 * ks + 1][3]); } }
                }
            } else {
                const int dc = i - 4;
#pragma unroll
                for (int nt = 0; nt < 4; ++nt) { f32x4 a0 = {0.f, 0.f, 0.f, 0.f}, a1 = {0.f, 0.f, 0.f, 0.f}; ldsp ar = cur + (16 * nt + li) * CP + 8 * g;
#pragma unroll
                    for (int ks = 0; ks < 8; ++ks) { const u32x2 lo = *(const LAS u32x2*)(ar + 64 * ks), hi = *(const LAS u32x2*)(ar + 64 * ks + 32); const u32x4 av = {lo[0], lo[1], hi[0], hi[1]};
                        a0 = mma(__builtin_bit_cast(bf16x8, av), __builtin_bit_cast(bf16x8, pf[0][ks]), a0); a1 = mma(__builtin_bit_cast(bf16x8, av), __builtin_bit_cast(bf16x8, pf[1][ks]), a1); }
                    u32x2 o; o[0] = pk2(a0[0] * rinv[0], a0[1] * rinv[0]); o[1] = pk2(a0[2] * rinv[0], a0[3] * rinv[0]);
                    *(GAS u32x2*)(O + (size_t)(row0 + li) * 1024 + h * 256 + 64 * dc + 16 * nt + 4 * g) = o;
                    o[0] = pk2(a1[0] * rinv[1], a1[1] * rinv[1]); o[1] = pk2(a1[2] * rinv[1], a1[3] * rinv[1]);
                    *(GAS u32x2*)(O + (size_t)(row0 + 16 + li) * 1024 + h * 256 + 64 * dc + 16 * nt + 4 * g) = o; }
            }
            if (have_next) pa_store(oth, pre, c.tid);
            BAR_LDS();
        }
    }
}
__device__ __forceinline__ void sa_load(f32x4 (&pre)[8], const mx::Ctx& c, int item, int i, int tid) {
    const int b = item >> 2, h = item & 3; const float* p = (i < 4 ? c.in[nv::I_CK] : c.in[nv::I_CV]) + ((size_t)(b * 256 + 64 * (i & 3)) * 4 + h) * 256;
#pragma unroll
    for (int j = 0; j < 8; ++j) { const int id = tid + 512 * j, key = id >> 6, c4 = id & 63; pre[j] = __builtin_nontemporal_load((const GAS f32x4*)(p + (size_t)key * 1024 + 4 * c4)); }
}
__device__ __forceinline__ void sa_store(ldsp buf, const f32x4 (&pre)[8], int tid) {
#pragma unroll
    for (int j = 0; j < 8; ++j) { const int id = tid + 512 * j, key = id >> 6, c4 = id & 63; u32x2 o; o[0] = pk2(pre[j][0], pre[j][1]); o[1] = pk2(pre[j][2], pre[j][3]); *(LAS u32x2*)(buf + key * CP + c4 * 8) = o; }
}
__device__ __forceinline__ void sample_stream(const mx::Ctx& c, int cu, int G) {
    ldsp B0 = c.L, B1 = c.L + CB_BYTES; LAS float* SCs = (LAS float*)(c.L + SC_OFF); ldsp Pl = c.L + PL_OFF; int item = cu; if (item >= 512) return;
    for (int i = c.tid; i < 16 * PLP / 4; i += 512) ((LAS unsigned*)Pl)[i] = 0u;
    f32x4 preA[8], preB[8];
    sa_load(preA, c, item, 0, c.tid); sa_load(preB, c, item, 1, c.tid); sa_store(B0, preA, c.tid); BAR_LDS();
    const bf16* Q = (const bf16*)(c.ws + WSO.q); bf16* O = (bf16*)(c.ws + WSO.o); const int g = c.lane >> 4, li = c.lane & 15;
    for (; item < 512; item += G) {
        const int b = item >> 2, h = item & 3, r0 = 16384 + 4 * b, nxt = item + G;
        bf16x8 qf[8];
#pragma unroll
        for (int ks = 0; ks < 8; ++ks) { u32x4 v = {0u, 0u, 0u, 0u}; if (li < 4) v = *(const GAS u32x4*)(Q + (size_t)(r0 + li) * 1024 + h * 256 + 32 * ks + 8 * g); qf[ks] = __builtin_bit_cast(bf16x8, v); }
        f32x4 oacc[2] = {{0.f, 0.f, 0.f, 0.f}, {0.f, 0.f, 0.f, 0.f}};
#pragma unroll
        for (int i = 0; i < 8; ++i) {
            ldsp cur = (i & 1) ? B1 : B0; ldsp oth = (i & 1) ? B0 : B1;
            const bool have1 = (i < 7) || (nxt < 512), have2 = (i < 6) || (nxt < 512);
            if (have2) { if (i & 1) sa_load(preB, c, i < 6 ? item : nxt, i < 6 ? i + 2 : i - 6, c.tid); else sa_load(preA, c, i < 6 ? item : nxt, i < 6 ? i + 2 : i - 6, c.tid); }
            if (i < 4) {
                if (c.wave < 4) { f32x4 acc = {0.f, 0.f, 0.f, 0.f};
#pragma unroll
                    for (int ks = 0; ks < 8; ++ks) acc = mma(frag_row(cur, CP, 16 * c.wave, 32 * ks, c.lane), qf[ks], acc);
                    if (li < 4) *(LAS f32x4*)(SCs + li * 256 + 64 * i + 16 * c.wave + 4 * g) = acc; }
            } else {
                if (i == 4) {
                    if (c.wave < 4) { const f32x4 s = *(const LAS f32x4*)(SCs + c.wave * 256 + 4 * c.lane); const float m = mx::wmax(fmaxf(fmaxf(s[0], s[1]), fmaxf(s[2], s[3])));
                        const float p0 = __expf(s[0] - m), p1 = __expf(s[1] - m), p2 = __expf(s[2] - m), p3 = __expf(s[3] - m); const float inv = 1.f / mx::wsum((p0 + p1) + (p2 + p3));
                        u32x2 o; o[0] = pk2(p0 * inv, p1 * inv); o[1] = pk2(p2 * inv, p3 * inv); *(LAS u32x2*)(Pl + c.wave * PLP + c.lane * 8) = o; }
                    BAR_LDS();
                }
                const int vc = i - 4;
#pragma unroll
                for (int q = 0; q < 2; ++q)
#pragma unroll
                    for (int ks = 0; ks < 2; ++ks) oacc[q] = mma(frag_row(Pl, PLP, 0, 64 * vc + 32 * ks, c.lane), frag_tr(cur, CP, 32 * ks, 16 * (2 * c.wave + q), c.lane), oacc[q]);
                if (i == 7 && g == 0) {
#pragma unroll
                    for (int q = 0; q < 2; ++q)
#pragma unroll
                        for (int r = 0; r < 4; ++r) O[(size_t)(r0 + r) * 1024 + h * 256 + 16 * (2 * c.wave + q) + li] = (bf16)f2bf(oacc[q][r]); }
            }
            if (have1) { if (i & 1) sa_store(oth, preA, c.tid); else sa_store(oth, preB, c.tid); }
            BAR_LDS();
        }
    }
}
__device__ __forceinline__ void phase_attn(const mx::Ctx& c, int cu, int G) {
#ifdef MK_X2_PROMPT
    prompt_stream(c, cu, G); __syncthreads();
#endif
#ifdef MK_X2_SAMPLE
    sample_stream(c, cu, G); __syncthreads();
#endif
    if ((G & 1) == 0) { if (cu & 1) prompt_stream(c, cu >> 1, G >> 1); else sample_stream(c, cu >> 1, G >> 1); }
    else { prompt_stream(c, cu, G); __syncthreads(); sample_stream(c, cu, G); }
}
}
namespace sg {
using mx::bf16x8; using mx::f32x4; using mx::u32x2; using mx::ldsp; using mx::mma;
template <int MODE> __device__ __forceinline__ void small_gemm(ldsp L, unsigned char* ws, const bf16* A, const bf16* Bt, int K, float alpha, const float* base0, int tile, int tid, int lane, int wave, float* yout = nullptr) {
    const int rt = tile >> 4, ct = tile & 15, row0 = PROWS + 32 * rt, col0 = 64 * ct, kw = K >> 3, kbeg = wave * kw, nks = kw >> 5;
    f32x4 acc[2][4];
#pragma unroll
    for (int m = 0; m < 2; ++m)
#pragma unroll
        for (int n = 0; n < 4; ++n) acc[m][n] = (f32x4){0.f, 0.f, 0.f, 0.f};
    const bf16* ap = A + (size_t)(row0 + (lane & 15)) * K + kbeg + 8 * (lane >> 4); const bf16* bp = Bt + (size_t)(col0 + (lane & 15)) * K + kbeg + 8 * (lane >> 4);
#pragma unroll 4
    for (int ks = 0; ks < nks; ++ks) { bf16x8 a[2], b[4];
#pragma unroll
        for (int m = 0; m < 2; ++m) a[m] = *(const GAS bf16x8*)(ap + (size_t)(16 * m) * K + 32 * ks);
#pragma unroll
        for (int n = 0; n < 4; ++n) b[n] = *(const GAS bf16x8*)(bp + (size_t)(16 * n) * K + 32 * ks);
#pragma unroll
        for (int m = 0; m < 2; ++m)
#pragma unroll
            for (int n = 0; n < 4; ++n) acc[m][n] = mma(a[m], b[n], acc[m][n]); }
    LAS float* P = (LAS float*)L + wave * 2048;
#pragma unroll
    for (int m = 0; m < 2; ++m)
#pragma unroll
        for (int n = 0; n < 4; ++n)
#pragma unroll
            for (int r = 0; r < 4; ++r) P[(16 * m + 4 * (lane >> 4) + r) * 64 + 16 * n + (lane & 15)] = acc[m][n][r];
    __syncthreads();
    { const int r = tid >> 4, c4 = (tid & 15) * 4; f32x4 s = {0.f, 0.f, 0.f, 0.f};
#pragma unroll
      for (int w = 0; w < 8; ++w) s += *(const LAS f32x4*)((LAS float*)L + w * 2048 + r * 64 + c4);
      const int row = row0 + r, col = col0 + c4;
      if (MODE == 0) { bf16* XBp = (bf16*)(ws + WSO.xb) + (size_t)row * DM + col; f32x4 bs;
          if (base0) bs = *(const GAS f32x4*)(base0 + (size_t)(row - PROWS) * DM + col);
          else { const u32x2 w = *(const GAS u32x2*)XBp; bs[0] = __uint_as_float(w[0] << 16); bs[1] = __uint_as_float(w[0] & 0xffff0000u); bs[2] = __uint_as_float(w[1] << 16); bs[3] = __uint_as_float(w[1] & 0xffff0000u); }
          const f32x4 o = bs + s * alpha; u32x2 pk; pk.x = pk2(o[0], o[1]); pk.y = pk2(o[2], o[3]); *(GAS u32x2*)XBp = pk;
          float q = (o[0] * o[0] + o[1] * o[1]) + (o[2] * o[2] + o[3] * o[3]); q += shx(q, 1); q += shx(q, 2); q += shx(q, 4); q += shx(q, 8);
          if ((tid & 15) == 0) ((float*)(ws + WSO.ssq))[(size_t)row * 16 + ct] = q; }
      else if (MODE == 2) { const bf16* XBp = (const bf16*)(ws + WSO.xb) + (size_t)row * DM + col; const u32x2 w = *(const GAS u32x2*)XBp;
          const f32x4 bs = {__uint_as_float(w[0] << 16), __uint_as_float(w[0] & 0xffff0000u), __uint_as_float(w[1] << 16), __uint_as_float(w[1] & 0xffff0000u)}; const f32x4 o = bs + s * alpha;
          float q = (o[0] * o[0] + o[1] * o[1]) + (o[2] * o[2] + o[3] * o[3]); q += shx(q, 1); q += shx(q, 2); q += shx(q, 4); q += shx(q, 8);
          float* SSQ = (float*)(ws + WSO.ssq); if ((tid & 15) == 0) __hip_atomic_store((unsigned*)(SSQ + (size_t)row * 16 + ct), __float_as_uint(q), __ATOMIC_RELAXED, __HIP_MEMORY_SCOPE_AGENT);
          asm volatile("s_waitcnt vmcnt(0)" ::: "memory"); unsigned* cnt = (unsigned*)(ws + WSO.ctl) + pg8::CW_PANEL + 64 * (64 + rt);
          if (lane == 0) __hip_atomic_fetch_add(cnt, 1u, __ATOMIC_RELAXED, __HIP_MEMORY_SCOPE_AGENT);
          pg8::panel_wait(cnt, 128u, wave, lane);
          float ss = 0.f; { const unsigned long long* sp = (const unsigned long long*)(SSQ + (size_t)row * 16);
#pragma unroll
              for (int j = 0; j < 8; ++j) { const unsigned long long v = __hip_atomic_load(sp + j, __ATOMIC_RELAXED, __HIP_MEMORY_SCOPE_AGENT); ss += __uint_as_float((unsigned)v) + __uint_as_float((unsigned)(v >> 32)); } }
          const float rs = rsqrtf(ss * (1.0f / DM) + 1e-6f); const f32x4 gv = *(const GAS f32x4*)(base0 + col);
          *(GAS f32x4*)(yout + (size_t)row * DM + col) = o * rs * gv; }
      else { const GAS f32x4* sp = (const GAS f32x4*)((const float*)(ws + WSO.ssq) + (size_t)row * 16); const f32x4 s0 = sp[0], s1 = sp[1], s2 = sp[2], s3 = sp[3];
          const float ss = ((s0[0] + s0[1]) + (s0[2] + s0[3])) + ((s1[0] + s1[1]) + (s1[2] + s1[3])) + ((s2[0] + s2[1]) + (s2[2] + s2[3])) + ((s3[0] + s3[1]) + (s3[2] + s3[3]));
          const float rs = rsqrtf(ss * (1.0f / DM) + 1e-6f); u32x2 pk; pk.x = pk2(s[0] * rs, s[1] * rs); pk.y = pk2(s[2] * rs, s[3] * rs); *(GAS u32x2*)((bf16*)(ws + WSO.q) + (size_t)row * DM + col) = pk; } }
    __syncthreads();
}
}
#define MK_PROGRAM launch_mk(hs, 0, MK_NSTEPS, li, stream);
#ifndef MK_SP2_SINGLE
#define MK_SP2_SINGLE true
#endif
#ifndef MK_SEQ0
#define MK_SEQ0 0x00DCBA9876543210ull
#define MK_SEQ1 0ull
#define MK_REPBITS 0u
#define MK_NSTEPS 14
#endif

__global__ void __launch_bounds__(NWAVES * 64, 2) mk_fwd(Args args) {
    extern __shared__ __attribute__((aligned(16))) unsigned char lds[];
    volatile LAS unsigned* MISC = (volatile LAS unsigned*)((LAS unsigned char*)lds + MISC_OFF);
    gu32* ctl = (gu32*)(args.ws + WSO.ctl);
    for (int u = threadIdx.x; u < (LDS_BYTES - LDSCTL_OFF) / 4; u += NWAVES * 64) ((LAS unsigned*)((LAS unsigned char*)lds + LDSCTL_OFF))[u] = 0u;
    __syncthreads();
    XcdBarrier bar = xcd_barrier_post((unsigned*)(ctl + CW_BAR) + args.li * XCD_BAR_WORDS, MISC + 8);
    constexpr nv::Ws w = WSO; const int wave_s = __builtin_amdgcn_readfirstlane((int)threadIdx.x >> 6);
    for (int pi = args.ph_lo; pi < args.ph_hi; ++pi) {
        const int ph = (int)(((pi < 16 ? MK_SEQ0 : MK_SEQ1) >> (4 * (pi & 15))) & 15ull); const int rep = (int)((MK_REPBITS >> pi) & 1u);
        int tid_ = wave_s * 64 + (int)__builtin_amdgcn_mbcnt_hi(~0u, __builtin_amdgcn_mbcnt_lo(~0u, 0u)); asm volatile("" : "+v"(tid_));     unsigned char* ws = args.ws; asm volatile("" : "+s"(ws)); int zoff_ = 0; asm volatile("" : "+s"(zoff_)); const float* const* inp = args.in + zoff_;     float* outp = args.out; asm volatile("" : "+s"(outp));
        Frame F; F.lds = (LAS unsigned char*)lds; F.tid = tid_; F.lane = F.tid & 63; F.wave = __builtin_amdgcn_readfirstlane(F.tid >> 6);
        F.G = gridDim.x; { const int bx = blockIdx.x; F.vcu = (F.G % 8 == 0) ? (bx % 8) * (F.G / 8) + bx / 8 : bx; }
        const float* SSQ = (const float*)(ws + w.ssq);
        switch (ph) {
#ifndef MK_NO_PRO
        case PH_PROLOGUE: p0_prologue(F, inp, ws);
            break;
#endif
#ifndef MK_NO_UP
        case PH_UP1: case PH_UP2: {
            pg8::Gemm g{(const pg8::bf16_t*)(ws + w.xb), (const pg8::bf16_t*)(ws + (ph == PH_UP1 ? w.wgu1 : w.wgu2)), MROWS, 2 * DFF, DM}; pg8::StaticOrder S; S.init(MROWS, 2 * DFF, F.G, (int)blockIdx.x);
            PG8_LAS float* rsl = (PG8_LAS float*)(F.lds + RSL_OFF); pg8::rstd_to_lds(rsl, SSQ, S, F.tid);
            pg8::EpiSwigluL E{(pg8::bf16_t*)(ws + w.r1), rsl, DFF, 0};
            pg8::gemm_phase<pg8::EpiSwigluL, pg8::StaticOrder, true, true>(F.lds + RING_OFF, g, S, E, F.tid);
            if (ph == PH_UP1) {
                pg8::Gemm g2{(const pg8::bf16_t*)(ws + w.memb), (const pg8::bf16_t*)(ws + w.wkv), MEMROWS, 2 * DM, DM}; pg8::StaticOrder S2;
                const int rem = ((MROWS / 256) * (2 * DFF / 256)) % F.G; S2.init(MEMROWS, 2 * DM, F.G, ((int)blockIdx.x + F.G - rem) % F.G);
                pg8::EpiKV E2{outp + OUTO.mk, outp + OUTO.mv, (pg8::bf16_t*)(ws + w.kb), (pg8::bf16_t*)(ws + w.vt), (const float*)(ws + w.mssq)};
                pg8::gemm_phase<pg8::EpiKV, pg8::StaticOrder, true, true>(F.lds + RING_OFF, g2, S2, E2, F.tid);
            }
            {
                const int used = ph == PH_UP1 ? ((MROWS / 256) * (2 * DFF / 256) + (MEMROWS / 256) * (2 * DM / 256)) % F.G : ((MROWS / 256) * (2 * DFF / 256)) % F.G;
                if (F.G == 256 && (int)blockIdx.x >= used && !rep) { const int nw = (F.G - used) * NWAVES, widx = ((int)blockIdx.x - used) * NWAVES + F.wave;
                    if (ph == PH_UP1) convert_range(F, inp, ws, 2816, 4224, widx, nw); else convert_range(F, inp, ws, 11520, 12928, widx, nw); } }
            break; }
#endif
#ifndef MK_NO_RES
        case PH_DOWN1: case PH_WOUT: case PH_WO: case PH_DOWN2: {
            const bool down = (ph == PH_DOWN1 || ph == PH_DOWN2);
            const size_t aoff = down ? w.r1 : (ph == PH_WOUT ? w.ymix : w.o), boff = ph == PH_DOWN1 ? w.wd1 : ph == PH_DOWN2 ? w.wd2 : ph == PH_WOUT ? w.wout : w.wo;
            const int KK = down ? DFF : DM; const float alpha = (rep && ph != PH_DOWN1) ? 0.f : (down ? 0.5f : 1.0f);
            pg8::Gemm g{(const pg8::bf16_t*)(ws + aoff), (const pg8::bf16_t*)(ws + boff), PROWS, DM, KK}; pg8::StaticOrder S; S.init(PROWS, DM, F.G, (int)blockIdx.x);
#ifdef MK_FUSED_FINAL
            if (ph == PH_DOWN2 && !rep && F.G == 256) {
                pg8::EpiResidFinal EF{(const pg8::bf16_t*)(ws + w.xb), (float*)(ws + w.ssq), outp + OUTO.yp, inp[nv::I_FING], (unsigned*)(ws + w.ctl) + pg8::CW_PANEL, alpha, 0};
                pg8::gemm_phase<pg8::EpiResidFinal, pg8::StaticOrder, false, true>(F.lds + RING_OFF, g, S, EF, F.tid);
                sg::small_gemm<2>(F.lds, ws, (const bf16*)(ws + aoff), (const bf16*)(ws + boff), KK, alpha, inp[nv::I_FING], (int)blockIdx.x, F.tid, F.lane, F.wave, outp + OUTO.yp);
                break; }
#endif
            pg8::EpiResid E{inp[nv::I_XP], inp[nv::I_XS], (float*)(ws + w.xf), (pg8::bf16_t*)(ws + w.xb), (float*)(ws + w.ssq), alpha, ph == PH_DOWN1 ? 1 : 0};
            pg8::gemm_phase<pg8::EpiResid, pg8::StaticOrder, true, MK_SP2_SINGLE>(F.lds + RING_OFF, g, S, E, F.tid);
            for (int tl = (int)blockIdx.x; tl < 256; tl += F.G) sg::small_gemm<0>(F.lds, ws, (const bf16*)(ws + aoff), (const bf16*)(ws + boff), KK, alpha, nullptr, tl, F.tid, F.lane, F.wave);
#ifdef MK_X2_SMALL
            for (int tl = (int)blockIdx.x; tl < 256; tl += F.G) sg::small_gemm<0>(F.lds, ws, (const bf16*)(ws + aoff), (const bf16*)(ws + boff), KK, 0.f, nullptr, tl, F.tid, F.lane, F.wave);
#endif
            break; }
#endif
#ifndef MK_NO_WIN
        case PH_WIN: {
            pg8::Gemm g{(const pg8::bf16_t*)(ws + w.xb), (const pg8::bf16_t*)(ws + w.win), MROWS, WIN_N, DM}; pg8::StaticOrder S; S.init(MROWS, WIN_N, F.G, (int)blockIdx.x);
            PG8_LAS float* rsl = (PG8_LAS float*)(F.lds + RSL_OFF); pg8::rstd_to_lds(rsl, SSQ, S, F.tid);
            pg8::EpiZL E{(pg8::bf16_t*)(ws + w.r1), (float*)(ws + w.zg), rsl};
            pg8::gemm_phase<pg8::EpiZL, pg8::StaticOrder, true, true>(F.lds + RING_OFF, g, S, E, F.tid);
            {
                const int used = ((MROWS / 256) * (WIN_N / 256)) % F.G;
                if (F.G == 256 && (int)blockIdx.x >= used && !rep) { const int nw = (F.G - used) * NWAVES, widx = ((int)blockIdx.x - used) * NWAVES + F.wave;
                    convert_range(F, inp, ws, 6144, 7168, widx, nw); convert_range(F, inp, ws, 8192, 8704, widx, nw); } }
            break; }
#endif
#ifndef MK_NO_Q
        case PH_Q: {
            pg8::Gemm g{(const pg8::bf16_t*)(ws + w.xb), (const pg8::bf16_t*)(ws + w.wq), PROWS, DM, DM}; pg8::StaticOrder S; S.init(PROWS, DM, F.G, (int)blockIdx.x);
            pg8::EpiQ E{(pg8::bf16_t*)(ws + w.q), SSQ};
            pg8::gemm_phase<pg8::EpiQ, pg8::StaticOrder, true, MK_SP2_SINGLE>(F.lds + RING_OFF, g, S, E, F.tid);
            for (int tl = (int)blockIdx.x; tl < 256; tl += F.G) sg::small_gemm<1>(F.lds, ws, (const bf16*)(ws + w.xb), (const bf16*)(ws + w.wq), DM, 1.f, nullptr, tl, F.tid, F.lane, F.wave);
            break; }
#endif
#ifndef MK_NO_MIX
        case PH_MIX_LOCAL: case PH_MIX_SCAN: case PH_MIX_OUT: {
            mx::Ctx c{(const bf16*)(ws + w.r1), (const float*)(ws + w.zg), ws, inp, outp, F.lds, F.tid, F.lane, F.wave, 0};
            if (ph == PH_MIX_LOCAL) m2::phase_local(c, (int)blockIdx.x, F.G); else if (ph == PH_MIX_SCAN) mx::scan_phase(c, (int)blockIdx.x * 512 + F.tid, F.G * 512); else m2::phase_out(c, (int)blockIdx.x, F.G);
            break; }
#endif
#ifndef MK_NO_ATTN
        case PH_ATTN: {
            mx::Ctx c{(const bf16*)(ws + w.r1), (const float*)(ws + w.zg), ws, inp, outp, F.lds, F.tid, F.lane, F.wave, 0};
            xa::phase_attn(c, (int)blockIdx.x, F.G);
            break; }
#endif
#ifndef MK_NO_FIN
        case PH_FINAL: p_final(F, inp, outp, ws); break;
#endif
        default: break;
        }
        if (pi + 1 < args.ph_hi) { XcdBarrier b2 = bar; asm volatile("" : "+s"(b2.bar), "+s"(b2.x)); xcd_barrier(b2);
#ifdef MK_X2_BARRIER
            xcd_barrier(b2);
#endif
        }
    }
}

struct HostState { int grid; Args a; };
static void launch_mk(HostState& hs, int lo, int hi, int& li, hipStream_t stream) {
    hs.a.ph_lo = lo; hs.a.ph_hi = hi; hs.a.li = li++;
    hipLaunchKernelGGL(mk_fwd, dim3(hs.grid), dim3(NWAVES * 64), LDS_BYTES, stream, hs.a);
    const hipError_t le = hipPeekAtLastError(); if (le != hipSuccess) fprintf(stderr, "kernel_launch: launch [%d,%d) failed: %s\n", lo, hi, hipGetErrorName(le));
}
extern "C" void kernel_launch(void* const* d_in, const int* in_sizes, int n_in, void* d_out, int out_size, void* d_ws, size_t ws_size, hipStream_t stream) {
    static HostState hs; static int ready = 0;
    if (ready == 0) {
        if (n_in != 33 || (long)out_size != OUTO.total || ws_size < WSO.total) { fprintf(stderr, "kernel_launch: unexpected n_in %d / out_size %d / ws %zu (need %zu)\n", n_in, out_size, ws_size, (size_t)WSO.total); ready = -1; return; }
        int dev = 0, cus = 0;
        if (hipGetDevice(&dev) != hipSuccess || hipDeviceGetAttribute(&cus, hipDeviceAttributeMultiprocessorCount, dev) != hipSuccess) { ready = -1; return; }
        if (hipFuncSetAttribute((const void*)mk_fwd, hipFuncAttributeMaxDynamicSharedMemorySize, LDS_BYTES) != hipSuccess) { fprintf(stderr, "kernel_launch: hipFuncSetAttribute failed\n"); ready = -1; return; }
        (void)hipGetLastError();
        hs.grid = cus; ready = 1;
    }
    if (ready < 0) return;
    memset(&hs.a, 0, sizeof(hs.a));
    for (int i = 0; i < 33; ++i) hs.a.in[i] = (const float*)d_in[i];
    hs.a.out = (float*)d_out; hs.a.ws = (unsigned char*)d_ws;
    if (hipMemsetAsync((char*)d_ws + WSO.ctl, 0, CTL_ZERO_BYTES, stream) != hipSuccess) { fprintf(stderr, "kernel_launch: memset failed\n"); return; }
    int li = 0;
    MK_PROGRAM
}
```

```cpp
#define MK_WGM 4
#include <hip/hip_runtime.h>
#include <cstdio>
#include <cstdint>
#include <cstring>
#include <cmath>
#ifdef __HIPCC__
#define SHD __host__ __device__ __forceinline__
#else
#define SHD inline
#include <cmath>
#endif
namespace nv {
typedef unsigned short bf16_t;
SHD float bf2f(bf16_t v) { union { unsigned u; float f; } x; x.u = (unsigned)v << 16; return x.f; }
SHD bf16_t f2bf(float f) { union { unsigned u; float f; } x; x.f = f; return (bf16_t)((x.u + 0x7fffu + ((x.u >> 16) & 1u)) >> 16); }
struct Dm { int D, B, T, SB, ST, MLH, DK, DV, GH, GDK, GDV, RANK, NMEM, XH, XDH, FF, DIN, pad; float eps, tau; };
SHD long rows_of(const Dm& d) { return (long)d.B * d.T + (long)d.SB * d.ST; }
constexpr int ZGP = 32, NSSQ = 16;
}

namespace nv {
struct Ws {
  size_t ctl, wgu1, wd1, win, wout, wq, wkv, wo, wgu2, wd2, ssq, mssq, memb, kb, vt, xb, xf, zg, r1, r2, ymix, total;
  size_t q, o, hr, pn, al, fd, iw, mt, s, st2;
  size_t cloc, nloc, mloc, sloc, gdec, cst, nst, mst, sst;
};
constexpr int WIN_NPAD = 256;
struct Carver { size_t c; constexpr size_t al(size_t bytes) { const size_t p = c; c += (bytes + 255) / 256 * 256; return p; } };
constexpr Ws carve_ws(const Dm& d) { Ws w{}; const size_t M = (size_t)d.B * d.T + (size_t)d.SB * d.ST; Carver a{0};
  const size_t ZWc = (size_t)(2 * d.MLH * d.DK + 2 * d.MLH * d.DV + 2 * d.GH * d.GDK + 2 * d.GH * d.GDV); const size_t D = d.D, FF = d.FF; const size_t winN = (ZWc + ZGP + WIN_NPAD - 1) / WIN_NPAD * WIN_NPAD;
  w.ctl = a.al(1 << 20); w.wgu1 = a.al(2 * FF * D * 2); w.wd1 = a.al(D * FF * 2); w.win = a.al(winN * D * 2); w.wout = a.al(D * D * 2); w.wq = a.al(D * D * 2); w.wkv = a.al(2 * D * D * 2); w.wo = a.al(D * D * 2); w.wgu2 = a.al(2 * FF * D * 2); w.wd2 = a.al(D * FF * 2);
  w.ssq = a.al(M * NSSQ * 4); w.mssq = a.al((size_t)d.B * d.NMEM * 4); w.memb = a.al((size_t)d.B * d.NMEM * D * 2); w.kb = a.al((size_t)d.B * d.NMEM * D * 2); w.vt = a.al((size_t)d.B * d.NMEM * D * 2);
  w.xb = a.al(M * D * 2); w.xf = a.al(M * D * 4); w.zg = a.al(M * ZGP * 4);
  size_t r1 = M * FF * 2; if (M * ZWc * 2 > r1) r1 = M * ZWc * 2; if (2 * M * D * 2 + 256 > r1) r1 = 2 * M * D * 2 + 256; w.r1 = a.al(r1); w.q = w.r1; w.o = w.r1 + (M * D * 2 + 255) / 256 * 256;
  const size_t NCH = (size_t)d.B * (d.T / 64 > 0 ? d.T / 64 : 1);
  const size_t r2s = a.c; w.r2 = a.c;
  w.cloc = a.al(NCH * d.MLH * d.DK * d.DV * 4); w.sloc = a.al(NCH * d.GH * d.GDK * d.GDV * 4); w.cst = a.al(NCH * d.MLH * d.DK * d.DV * 2); w.sst = a.al(NCH * d.GH * d.GDK * d.GDV * 2);
  w.nloc = a.al(NCH * d.MLH * d.DK * 4); w.mloc = a.al(NCH * d.MLH * 2 * 4); w.gdec = a.al(NCH * d.GH * d.GDK * 4); w.nst = a.al(NCH * d.MLH * d.DK * 4); w.mst = a.al(NCH * d.MLH * 4);
  const size_t opt_end = a.c;
  a.c = r2s; w.hr = a.al(M * D * 4); w.pn = a.al(M * d.MLH * d.DK * 4); w.al = a.al(M * d.GH * d.GDK * 4); w.fd = a.al(M * d.MLH * 4); w.iw = a.al(M * d.MLH * 4); w.mt = a.al(M * d.MLH * 4); const size_t nv1_end = a.c;
  a.c = r2s; w.s = a.al(M * d.XH * d.NMEM * 4); w.st2 = a.al(M * d.XH * 2 * 4); const size_t nv2_end = a.c;
  a.c = opt_end > nv1_end ? opt_end : nv1_end; if (nv2_end > a.c) a.c = nv2_end;
  w.ymix = a.al(M * D * 2); w.total = a.c; return w; }
struct OutOff { long yp, ys, mk, mv, cp, np, mp, sp, cs, ns, ms, ss, total; };
constexpr OutOff out_off(const Dm& d) { OutOff o{}; long c = 0; o.yp = c; c += (long)d.B * d.T * d.D; o.ys = c; c += (long)d.SB * d.ST * d.D; o.mk = c; c += (long)d.B * d.NMEM * d.D; o.mv = c; c += (long)d.B * d.NMEM * d.D;
  o.cp = c; c += (long)d.B * d.MLH * d.DK * d.DV; o.np = c; c += (long)d.B * d.MLH * d.DK; o.mp = c; c += (long)d.B * d.MLH; o.sp = c; c += (long)d.B * d.GH * d.GDK * d.GDV;
  o.cs = c; c += (long)d.SB * d.MLH * d.DK * d.DV; o.ns = c; c += (long)d.SB * d.MLH * d.DK; o.ms = c; c += (long)d.SB * d.MLH; o.ss = c; c += (long)d.SB * d.GH * d.GDK * d.GDV; o.total = c; return o; }
enum In { I_XP, I_XS, I_MEM, I_CK, I_CV, I_SC, I_SN, I_SM, I_SS, I_F1G, I_F1WG, I_F1WU, I_F1WD, I_MIXG, I_WIN, I_BI, I_BF, I_MLOG, I_WA2, I_BA, I_GLOG, I_WOUT, I_XG, I_MEMG, I_WQ, I_WK, I_WV, I_WO, I_F2G, I_F2WG, I_F2WU, I_F2WD, I_FING };
}
__device__ __forceinline__ int my_lane() { int l = (int)__builtin_amdgcn_mbcnt_hi(~0u, __builtin_amdgcn_mbcnt_lo(~0u, 0u)); asm volatile("" : "+v"(l)); return l; }
__device__ __forceinline__ float shx(float v, int mask) { return __builtin_bit_cast(float, __builtin_amdgcn_ds_bpermute((my_lane() ^ mask) << 2, __builtin_bit_cast(int, v))); }
__device__ __forceinline__ float shl(float v, int src) { return __builtin_bit_cast(float, __builtin_amdgcn_ds_bpermute(src << 2, __builtin_bit_cast(int, v))); }
#ifndef MK_WGM
#define MK_WGM 8
#endif
namespace pg8 {
#define PG8_LAS __attribute__((address_space(3)))
typedef unsigned short bf16_t;
typedef short bf16x8 __attribute__((ext_vector_type(8)));
typedef float f32x4 __attribute__((ext_vector_type(4)));
typedef unsigned u32x4 __attribute__((ext_vector_type(4)));
constexpr int BM = 256, BK = 64, HALF = 128, HTB = HALF * BK * 2  , STAGE_BYTES = 8 * HTB, NXCD = 8, WGM = MK_WGM;

__host__ __device__ __forceinline__ int lds_byte(int r, int c) { const int st = (r >> 4) * 2 + (c >> 5), rr = r & 15, cc = c & 31, ob = rr * 64 + cc * 2; return st * 1024 + (ob ^ (((ob >> 9) & 1) << 5)); }
__host__ __device__ __forceinline__ void stage_rc(int b, int& R, int& C) { const int st = b / 1024, sb = b % 1024, swz = sb ^ (((sb >> 9) & 1) << 5); R = (st >> 1) * 16 + swz / 64; C = (st & 1) * 32 + (swz % 64) / 2; }
__host__ __device__ __forceinline__ int perm32(int rho) { const int n = rho >> 4, i = rho & 15; return 8 * (i >> 2) + 4 * n + (i & 3); }

struct Unit { int pm, pn, idx; };
struct Gemm { const bf16_t* A; const bf16_t* Bt; int M, N, K; };

struct StaticOrder {
    int nM, nN, nwg, G, c;
    __host__ __device__ void init(int M, int N, int G_, int c_) { nM = M / BM; nN = N / BM; nwg = nM * nN; G = G_; c = c_; }
    __host__ __device__ bool next(int i, Unit& u) const {
        const long L = (long)i * G + c; if (L >= nwg) return false;
        int wgid = (int)L; { const int q = nwg / NXCD, r = nwg % NXCD, xcd = wgid % NXCD, off = wgid / NXCD; wgid = (xcd < r ? xcd * (q + 1) : r * (q + 1) + (xcd - r) * q) + off; }
        const int nig = WGM * nN, ngr = nM / WGM > 0 ? nM / WGM : 1, g0 = wgid / nig, gid = g0 < ngr - 1 ? g0 : ngr - 1, fm = gid * WGM, gsz = gid == ngr - 1 ? nM - fm : WGM, loc = wgid - gid * nig;
        u.pm = fm + loc % gsz; u.pn = loc / gsz; u.idx = i; return true;
    }
    __device__ __forceinline__ void a_ready(const Unit&) const {}
    __device__ __forceinline__ void done(const Unit&) const {}
    __device__ __forceinline__ const char* pa(const Gemm& g, const Unit& u, size_t tstep) const { return (const char*)g.A + (size_t)u.pm * tstep; }
    __device__ __forceinline__ const char* pb(const Gemm& g, const Unit& u, size_t tstep) const { return (const char*)g.Bt + (size_t)u.pn * tstep; }
};
constexpr int PM2 = 4096;
struct MergedOrder {
    StaticOrder a, b; const char* A2; const char* B2;
    __device__ bool next(int i, Unit& u) const {
        const int na = (a.nwg - a.c + a.G - 1) / a.G;
        const long Lb = (long)na * a.G + a.c - a.nwg;
        if (Lb < b.nwg) {
            if (i == 0) { StaticOrder t = b; t.c = (int)Lb; t.G = 1 << 30; if (!t.next(0, u)) return false; u.pm += PM2; u.idx = 0; return true; }
            if (!a.next(i - 1, u)) return false;
            u.idx = i; return true; }
        return a.next(i, u);
    }
    __device__ __forceinline__ void a_ready(const Unit&) const {}
    __device__ __forceinline__ void done(const Unit&) const {}
    __device__ __forceinline__ const char* pa(const Gemm& g, const Unit& u, size_t tstep) const { return u.pm >= PM2 ? A2 + (size_t)(u.pm - PM2) * tstep : (const char*)g.A + (size_t)u.pm * tstep; }
    __device__ __forceinline__ const char* pb(const Gemm& g, const Unit& u, size_t tstep) const { return u.pm >= PM2 ? B2 + (size_t)u.pn * tstep : (const char*)g.Bt + (size_t)u.pn * tstep; }
};

__device__ __forceinline__ unsigned cvt_pk_bf16(float lo, float hi) { unsigned r; asm("v_cvt_pk_bf16_f32 %0, %1, %2" : "=v"(r) : "v"(lo), "v"(hi)); return r; }
template <class Epi, class Sched, bool ALIGN_EPI = false, bool SP2 = false>
__device__ __forceinline__ void gemm_phase(PG8_LAS unsigned char* lds, const Gemm g, const Sched& S, const Epi& E, const int tid) {
    const int wid = __builtin_amdgcn_readfirstlane(tid >> 6), lane = tid & 63, wr = wid >> 2, wc = wid & 3, fr = lane & 15, fq = lane >> 4;
    const int K = g.K, nt = K / BK;
    unsigned voffA[2], voffB[2];
#pragma unroll
    for (int i = 0; i < 2; ++i) { int R, C; stage_rc(tid * 16 + i * 8192, R, C); const int Rb = Epi::PERM ? ((R & ~31) + perm32(R & 31)) : R;
        voffA[i] = (unsigned)(R * K + C) * 2u; voffB[i] = (unsigned)(Rb * K + C) * 2u; }
    const size_t kstep = (size_t)(BK * 2);
    const size_t hstep = (size_t)HALF * K * 2;
    const size_t tstep = 2 * hstep;
    const unsigned ldsw = (unsigned)wid * 1024u;
    const int aoff = lds_byte(wr * 64 + fr, fq * 8), boff = lds_byte(wc * 32 + fr, fq * 8);
#define PG8_SA(b, h) (((b) * 2 + (h)) * HTB)
#define PG8_SB(b, h) ((4 + (b) * 2 + (h)) * HTB)
#define PG8_STAGE(bufoff, gbase, voff) do { _Pragma("unroll") for (int _i = 0; _i < 2; ++_i) \
        __builtin_amdgcn_global_load_lds((const unsigned*)((const char*)(gbase) + (voff)[_i]), (PG8_LAS unsigned*)(lds + (bufoff) + ldsw + _i * 8192), 16, 0, 0); } while (0)
#define PG8_LDA(dst, b, h) do { _Pragma("unroll") for (int m = 0; m < 4; ++m) _Pragma("unroll") for (int k = 0; k < 2; ++k) dst[m][k] = *(const PG8_LAS bf16x8*)(lds + PG8_SA(b, h) + aoff + m * 2048 + k * 1024); } while (0)
#define PG8_LDB(dst, b, h) do { _Pragma("unroll") for (int n = 0; n < 2; ++n) _Pragma("unroll") for (int k = 0; k < 2; ++k) dst[n][k] = *(const PG8_LAS bf16x8*)(lds + PG8_SB(b, h) + boff + n * 2048 + k * 1024); } while (0)
#define PG8_MMA(ai, bj, At, Bt) do { __builtin_amdgcn_s_setprio(1); _Pragma("unroll") for (int m = 0; m < 4; ++m) _Pragma("unroll") for (int n = 0; n < 2; ++n) _Pragma("unroll") for (int k = 0; k < 2; ++k) \
        acc[ai][bj][m][n] = __builtin_amdgcn_mfma_f32_16x16x32_bf16(Bt[n][k], At[m][k], acc[ai][bj][m][n], 0, 0, 0); __builtin_amdgcn_s_setprio(0); } while (0)
#define PG8_WAIT_V(n) asm volatile("s_waitcnt vmcnt(" #n ")" ::: "memory")
#define PG8_WAIT_L(n) asm volatile("s_waitcnt lgkmcnt(" #n ")" ::: "memory")
#define PG8_BAR __builtin_amdgcn_s_barrier()
#define PG8_SCHED __builtin_amdgcn_sched_barrier(0)
    Unit cur, nxt; int ui = 0;
    if (!S.next(0, cur)) return;
    f32x4 acc[2][2][4][2];
#pragma unroll
    for (int a = 0; a < 2; ++a)
#pragma unroll
        for (int b = 0; b < 2; ++b)
#pragma unroll
            for (int m = 0; m < 4; ++m)
#pragma unroll
                for (int n = 0; n < 2; ++n) acc[a][b][m][n] = (f32x4){0.f, 0.f, 0.f, 0.f};
    bf16x8 At[4][2], B0[2][2], B1[2][2];
    const char* cA = S.pa(g, cur, tstep); const char* cB = S.pb(g, cur, tstep);
    S.a_ready(cur);
    if constexpr (SP2) {
        PG8_STAGE(PG8_SB(0, 0), cB, voffB); PG8_STAGE(PG8_SB(0, 1), cB + hstep, voffB); PG8_STAGE(PG8_SA(0, 0), cA, voffA); PG8_STAGE(PG8_SA(0, 1), cA + hstep, voffA);
        if (wr == 1) PG8_BAR;
        PG8_WAIT_V(2); PG8_BAR;
        PG8_STAGE(PG8_SB(1, 0), cB + kstep, voffB); PG8_STAGE(PG8_SA(1, 0), cA + kstep, voffA); PG8_STAGE(PG8_SB(1, 1), cB + hstep + kstep, voffB);
        PG8_WAIT_V(6); PG8_BAR;
    } else {
        PG8_STAGE(PG8_SB(0, 0), cB, voffB); PG8_STAGE(PG8_SA(0, 0), cA, voffA); PG8_STAGE(PG8_SB(0, 1), cB + hstep, voffB); PG8_STAGE(PG8_SA(0, 1), cA + hstep, voffA);
        if (wr == 1) PG8_BAR;
        PG8_WAIT_V(4); PG8_BAR;
        PG8_STAGE(PG8_SB(1, 0), cB + kstep, voffB); PG8_STAGE(PG8_SA(1, 0), cA + kstep, voffA); PG8_STAGE(PG8_SB(1, 1), cB + hstep + kstep, voffB);
        PG8_WAIT_V(6); PG8_BAR;
    }
    for (;;) {
        const bool has_next = S.next(ui + 1, nxt);
        const char* nA = has_next ? S.pa(g, nxt, tstep) : cA; const char* nB = has_next ? S.pb(g, nxt, tstep) : cB;
        for (int t = 0; t < nt; t += 2) {
            const bool last = (t == nt - 2);
            const char* a1 = cA + (size_t)(t + 1) * kstep;
            const char* a2 = last ? nA : cA + (size_t)(t + 2) * kstep; const char* b2 = last ? nB : cB + (size_t)(t + 2) * kstep;
            const char* a3 = a2 + kstep; const char* b3 = b2 + kstep;
            if (last && has_next) S.a_ready(nxt);
            if constexpr (SP2) {
            PG8_LDB(B0, 0, 0); PG8_LDB(B1, 0, 1); PG8_SCHED; PG8_LDA(At, 0, 0); PG8_STAGE(PG8_SA(1, 1), a1 + hstep, voffA);
            PG8_WAIT_V(8); PG8_WAIT_L(0); PG8_BAR; PG8_MMA(0, 0, At, B0); PG8_MMA(0, 1, At, B1); PG8_BAR; PG8_SCHED;
            PG8_LDA(At, 0, 1); PG8_STAGE(PG8_SB(0, 0), b2, voffB); PG8_STAGE(PG8_SB(0, 1), b2 + hstep, voffB); PG8_STAGE(PG8_SA(0, 0), a2, voffA);
            PG8_WAIT_V(8); PG8_WAIT_L(0); PG8_BAR; PG8_MMA(1, 0, At, B0); PG8_MMA(1, 1, At, B1); PG8_BAR; PG8_SCHED;
            PG8_LDB(B0, 1, 0); PG8_LDB(B1, 1, 1); PG8_SCHED; PG8_LDA(At, 1, 0); PG8_STAGE(PG8_SA(0, 1), a2 + hstep, voffA);
            PG8_WAIT_V(8); PG8_WAIT_L(0); PG8_BAR; PG8_MMA(0, 0, At, B0); PG8_MMA(0, 1, At, B1); PG8_BAR; PG8_SCHED;
            PG8_LDA(At, 1, 1); PG8_STAGE(PG8_SB(1, 0), b3, voffB); PG8_STAGE(PG8_SB(1, 1), b3 + hstep, voffB); PG8_STAGE(PG8_SA(1, 0), a3, voffA);
            PG8_WAIT_V(8); PG8_WAIT_L(0); PG8_BAR; PG8_MMA(1, 0, At, B0); PG8_MMA(1, 1, At, B1); PG8_BAR; PG8_SCHED;
            } else {
            PG8_LDB(B0, 0, 0); PG8_SCHED; PG8_LDA(At, 0, 0); PG8_STAGE(PG8_SA(1, 1), a1 + hstep, voffA);
            PG8_WAIT_L(8); PG8_BAR; PG8_WAIT_L(0); PG8_MMA(0, 0, At, B0); PG8_BAR; PG8_SCHED;
            PG8_LDB(B1, 0, 1); PG8_STAGE(PG8_SB(0, 0), b2, voffB);
            PG8_BAR; PG8_WAIT_L(0); PG8_MMA(0, 1, At, B1); PG8_BAR;
            PG8_LDA(At, 0, 1); PG8_STAGE(PG8_SA(0, 0), a2, voffA);
            PG8_BAR; PG8_WAIT_L(0); PG8_MMA(1, 0, At, B0); PG8_BAR; PG8_SCHED;
            PG8_STAGE(PG8_SB(0, 1), b2 + hstep, voffB);
            PG8_WAIT_V(6); PG8_BAR; PG8_MMA(1, 1, At, B1); PG8_BAR;
            PG8_LDB(B0, 1, 0); PG8_SCHED; PG8_LDA(At, 1, 0); PG8_STAGE(PG8_SA(0, 1), a2 + hstep, voffA);
            PG8_WAIT_L(8); PG8_BAR; PG8_WAIT_L(0); PG8_MMA(0, 0, At, B0); PG8_BAR; PG8_SCHED;
            PG8_LDB(B1, 1, 1); PG8_STAGE(PG8_SB(1, 0), b3, voffB);
            PG8_BAR; PG8_WAIT_L(0); PG8_MMA(0, 1, At, B1); PG8_BAR;
            PG8_LDA(At, 1, 1); PG8_STAGE(PG8_SA(1, 0), a3, voffA);
            PG8_BAR; PG8_WAIT_L(0); PG8_MMA(1, 0, At, B0); PG8_BAR; PG8_SCHED;
            PG8_STAGE(PG8_SB(1, 1), b3 + hstep, voffB);
            PG8_WAIT_V(6); PG8_BAR; PG8_MMA(1, 1, At, B1); PG8_BAR;
            }
        }
        if constexpr (ALIGN_EPI) { if (wr == 0) PG8_BAR; }
#ifdef MK_PT_ID
        if (tid == 0) *(volatile PG8_LAS unsigned*)(lds + 131072 + 320 + 76) = (unsigned)__builtin_amdgcn_s_memrealtime();
#endif
        if constexpr (!Epi::AFTER_DRAIN) { E(acc, cur, wr, wc, fr, fq); S.done(cur); }
        if (!has_next) break;
#pragma unroll
        for (int a = 0; a < 2; ++a)
#pragma unroll
            for (int b = 0; b < 2; ++b)
#pragma unroll
                for (int m = 0; m < 4; ++m)
#pragma unroll
                    for (int n = 0; n < 2; ++n) acc[a][b][m][n] = (f32x4){0.f, 0.f, 0.f, 0.f};
        cur = nxt; cA = nA; cB = nB; ++ui;
        if constexpr (ALIGN_EPI) { if (wr == 1) PG8_BAR; }
    }
    PG8_WAIT_V(0);
    if constexpr (!ALIGN_EPI) { if (wr == 0) PG8_BAR; }
    PG8_BAR;
    if constexpr (Epi::AFTER_DRAIN) { E.fused(acc, cur, wr, wc, fr, fq, lds, wid, lane); S.done(cur); }
#undef PG8_SA
#undef PG8_SB
#undef PG8_STAGE
#undef PG8_LDA
#undef PG8_LDB
#undef PG8_MMA
#undef PG8_WAIT_V
#undef PG8_WAIT_L
#undef PG8_BAR
#undef PG8_SCHED
}
}
namespace pg8 {
typedef unsigned u32x2 __attribute__((ext_vector_type(2)));
constexpr int DMODEL = 1024, NSSQ = 16;
constexpr float RMS_EPS = 1e-6f;
__device__ __forceinline__ float sum_fq(float q) {
    const unsigned a = __builtin_bit_cast(unsigned, q); const auto r = __builtin_amdgcn_permlane16_swap(a, a, false, false);
    const float s = __builtin_bit_cast(float, (unsigned)r[0]) + __builtin_bit_cast(float, (unsigned)r[1]);
    const unsigned b = __builtin_bit_cast(unsigned, s); const auto r2 = __builtin_amdgcn_permlane32_swap(b, b, false, false);
    return __builtin_bit_cast(float, (unsigned)r2[0]) + __builtin_bit_cast(float, (unsigned)r2[1]); }
__device__ __forceinline__ float row_rstd(const float* ssq, int row, int fq) {
    const f32x4 v = *(const f32x4*)(ssq + (size_t)row * NSSQ + 4 * fq); float s = (v[0] + v[1]) + (v[2] + v[3]); s += shx(s, 16); s += shx(s, 32);
    return rsqrtf(s * (1.0f / DMODEL) + RMS_EPS); }
__device__ __forceinline__ float silu_f(float g) { return g * __builtin_amdgcn_rcpf(1.0f + __expf(-g)); }
struct EpiSwiglu { static constexpr bool PERM = false, AFTER_DRAIN = false;
    bf16_t* H; const float* ssq; int ldh, pad;
    __device__ __forceinline__ void operator()(const f32x4 (&acc)[2][2][4][2], const Unit& u, int wr, int wc, int fr, int fq) const {
#pragma unroll
        for (int ai = 0; ai < 2; ++ai)
#pragma unroll
            for (int m = 0; m < 4; ++m) { const int row = u.pm * BM + ai * HALF + wr * 64 + m * 16 + fr; const float rs = row_rstd(ssq, row, fq);
#pragma unroll
                for (int bj = 0; bj < 2; ++bj) { const f32x4 g = acc[ai][bj][m][0] * rs, up = acc[ai][bj][m][1] * rs; u32x2 w;
                    w.x = cvt_pk_bf16(silu_f(g[0]) * up[0], silu_f(g[1]) * up[1]); w.y = cvt_pk_bf16(silu_f(g[2]) * up[2], silu_f(g[3]) * up[3]);
                    *(u32x2*)(H + (size_t)row * ldh + u.pn * 128 + bj * 64 + wc * 16 + 4 * fq) = w; } asm volatile("" ::: "memory"); }
    }
};
#ifndef MK_RESID_OLD
struct EpiResid { static constexpr bool PERM = true, AFTER_DRAIN = false;
    const float* xp; const float* xs; float* XF; bf16_t* XB; float* ssq; float alpha; int first;
    __device__ __forceinline__ void operator()(const f32x4 (&acc)[2][2][4][2], const Unit& u, int wr, int wc, int fr, int fq) const {
#pragma unroll
        for (int ai = 0; ai < 2; ++ai) { u32x4 bw[4][2];
#pragma unroll
            for (int m = 0; m < 4; ++m)
#pragma unroll
                for (int bj = 0; bj < 2; ++bj) bw[m][bj] = *(const u32x4*)(XB + (size_t)(u.pm * BM + ai * HALF + wr * 64 + m * 16 + fr) * DMODEL + u.pn * BM + bj * HALF + wc * 32 + 8 * fq);
#pragma unroll
            for (int m = 0; m < 4; ++m) { const int row = u.pm * BM + ai * HALF + wr * 64 + m * 16 + fr; float q = 0.f;
#pragma unroll
                for (int bj = 0; bj < 2; ++bj) { const u32x4 w0 = bw[m][bj];
                    const f32x4 b0 = {__uint_as_float(w0.x << 16), __uint_as_float(w0.x & 0xffff0000u), __uint_as_float(w0.y << 16), __uint_as_float(w0.y & 0xffff0000u)};
                    const f32x4 b1 = {__uint_as_float(w0.z << 16), __uint_as_float(w0.z & 0xffff0000u), __uint_as_float(w0.w << 16), __uint_as_float(w0.w & 0xffff0000u)};
                    const f32x4 o0 = b0 + acc[ai][bj][m][0] * alpha, o1 = b1 + acc[ai][bj][m][1] * alpha;
                    u32x4 w; w.x = cvt_pk_bf16(o0[0], o0[1]); w.y = cvt_pk_bf16(o0[2], o0[3]); w.z = cvt_pk_bf16(o1[0], o1[1]); w.w = cvt_pk_bf16(o1[2], o1[3]);
                    *(u32x4*)(XB + (size_t)row * DMODEL + u.pn * BM + bj * HALF + wc * 32 + 8 * fq) = w;
                    q += ((o0[0] * o0[0] + o0[1] * o0[1]) + (o0[2] * o0[2] + o0[3] * o0[3])) + ((o1[0] * o1[0] + o1[1] * o1[1]) + (o1[2] * o1[2] + o1[3] * o1[3])); }
                q = sum_fq(q);
                if (fq == 0) ssq[(size_t)row * NSSQ + u.pn * 4 + wc] = q; }
            asm volatile("" ::: "memory"); }
    }
};
#else
struct EpiResid { static constexpr bool PERM = false, AFTER_DRAIN = false;
    const float* xp; const float* xs; float* XF; bf16_t* XB; float* ssq; float alpha; int first;
    __device__ __forceinline__ void operator()(const f32x4 (&acc)[2][2][4][2], const Unit& u, int wr, int wc, int fr, int fq) const {
#pragma unroll
        for (int ai = 0; ai < 2; ++ai) { u32x2 bw[4][2][2];
#pragma unroll
            for (int m = 0; m < 4; ++m)
#pragma unroll
                for (int bj = 0; bj < 2; ++bj)
#pragma unroll
                    for (int n = 0; n < 2; ++n) bw[m][bj][n] = *(const u32x2*)(XB + (size_t)(u.pm * BM + ai * HALF + wr * 64 + m * 16 + fr) * DMODEL + u.pn * BM + bj * HALF + wc * 32 + n * 16 + 4 * fq);
#pragma unroll
            for (int m = 0; m < 4; ++m) { const int row = u.pm * BM + ai * HALF + wr * 64 + m * 16 + fr; float q = 0.f;
#pragma unroll
                for (int bj = 0; bj < 2; ++bj)
#pragma unroll
                    for (int n = 0; n < 2; ++n) { const int col = u.pn * BM + bj * HALF + wc * 32 + n * 16 + 4 * fq; const u32x2 w0 = bw[m][bj][n];
                        const f32x4 b = {__uint_as_float(w0.x << 16), __uint_as_float(w0.x & 0xffff0000u), __uint_as_float(w0.y << 16), __uint_as_float(w0.y & 0xffff0000u)};
                        const f32x4 o = b + acc[ai][bj][m][n] * alpha;
                        u32x2 w; w.x = cvt_pk_bf16(o[0], o[1]); w.y = cvt_pk_bf16(o[2], o[3]); *(u32x2*)(XB + (size_t)row * DMODEL + col) = w;
                        q += (o[0] * o[0] + o[1] * o[1]) + (o[2] * o[2] + o[3] * o[3]); }
                q += shx(q, 16); q += shx(q, 32);
                if (fq == 0) ssq[(size_t)row * NSSQ + u.pn * 4 + wc] = q; }
            asm volatile("" ::: "memory"); }
    }
};
#endif
struct EpiZ { static constexpr bool PERM = true, AFTER_DRAIN = false;
    bf16_t* Z; float* ZG; const float* ssq;
    __device__ __forceinline__ void operator()(const f32x4 (&acc)[2][2][4][2], const Unit& u, int wr, int wc, int fr, int fq) const {
        constexpr int ZW = 3584, ZGP = 32;
#pragma unroll
        for (int ai = 0; ai < 2; ++ai)
#pragma unroll
            for (int m = 0; m < 4; ++m) { const int row = u.pm * BM + ai * HALF + wr * 64 + m * 16 + fr; const float rs = row_rstd(ssq, row, fq);
                if (u.pn < ZW / BM) {
#pragma unroll
                    for (int bj = 0; bj < 2; ++bj) { const f32x4 v0 = acc[ai][bj][m][0] * rs, v1 = acc[ai][bj][m][1] * rs; u32x4 w; w.x = cvt_pk_bf16(v0[0], v0[1]); w.y = cvt_pk_bf16(v0[2], v0[3]); w.z = cvt_pk_bf16(v1[0], v1[1]); w.w = cvt_pk_bf16(v1[2], v1[3]);
                        *(u32x4*)(Z + (size_t)row * ZW + u.pn * BM + bj * HALF + wc * 32 + 8 * fq) = w; }
                } else if (wc == 0) { *(f32x4*)(ZG + (size_t)row * ZGP + 8 * fq) = acc[ai][0][m][0] * rs; *(f32x4*)(ZG + (size_t)row * ZGP + 8 * fq + 4) = acc[ai][0][m][1] * rs; } asm volatile("" ::: "memory"); }
    }
};
struct EpiQ { static constexpr bool PERM = true, AFTER_DRAIN = false;
    bf16_t* Q; const PG8_LAS float* rsl;
    __device__ __forceinline__ void operator()(const f32x4 (&acc)[2][2][4][2], const Unit& u, int wr, int wc, int fr, int fq) const {
#pragma unroll
        for (int ai = 0; ai < 2; ++ai)
#pragma unroll
            for (int m = 0; m < 4; ++m) { const int lr = ai * HALF + wr * 64 + m * 16 + fr, row = u.pm * BM + lr; const float rs = rsl[u.idx * 256 + lr];
#pragma unroll
                for (int bj = 0; bj < 2; ++bj) { const f32x4 v0 = acc[ai][bj][m][0] * rs, v1 = acc[ai][bj][m][1] * rs; u32x4 w; w.x = cvt_pk_bf16(v0[0], v0[1]); w.y = cvt_pk_bf16(v0[2], v0[3]); w.z = cvt_pk_bf16(v1[0], v1[1]); w.w = cvt_pk_bf16(v1[2], v1[3]);
                    *(u32x4*)(Q + (size_t)row * DMODEL + u.pn * BM + bj * HALF + wc * 32 + 8 * fq) = w; } asm volatile("" ::: "memory"); }
    }
};
#ifdef MK_KV_F32
#define KVST32(v, p) __builtin_nontemporal_store(v, p)
#else
#define KVST32(v, p) do { } while (0)
#endif
struct EpiKV { static constexpr bool PERM = false, AFTER_DRAIN = false;
    float* outk; float* outv; bf16_t* KB; bf16_t* VT; const PG8_LAS float* rsl;
    template <int CTRL> static __device__ __forceinline__ unsigned qx(unsigned x) { return (unsigned)__builtin_amdgcn_update_dpp(0, (int)x, CTRL, 0xF, 0xF, false); }
    __device__ __forceinline__ void operator()(const f32x4 (&acc)[2][2][4][2], const Unit& u, int wr, int wc, int fr, int fq) const {
        const int idx = u.idx; const unsigned sel1 = (fr & 1) ? 0x03020706u : 0x05040100u; const bool up2 = (fr & 2) != 0;
#pragma unroll
        for (int ai = 0; ai < 2; ++ai)
#pragma unroll
            for (int m = 0; m < 4; ++m) { const int lr = ai * HALF + wr * 64 + m * 16 + fr, row = u.pm * BM + lr; const float rs = rsl[idx * 256 + lr];
#pragma unroll
                for (int bj = 0; bj < 2; ++bj)
#pragma unroll
                    for (int n = 0; n < 2; ++n) { const int cl = bj * HALF + wc * 32 + n * 16 + 4 * fq; const f32x4 o = acc[ai][bj][m][n] * rs;
                        if (u.pn < 4) { const int col = u.pn * BM + cl; KVST32(o, (f32x4*)(outk + (size_t)row * DMODEL + col)); u32x2 w; w.x = cvt_pk_bf16(o[0], o[1]); w.y = cvt_pk_bf16(o[2], o[3]); *(u32x2*)(KB + (size_t)row * DMODEL + col) = w; }
                        else { const int h = u.pn - 4, col = h * BM + cl; KVST32(o, (f32x4*)(outv + (size_t)row * DMODEL + col));
                            const unsigned w0 = cvt_pk_bf16(o[0], o[1]), w1 = cvt_pk_bf16(o[2], o[3]);
                            const unsigned n0 = __builtin_amdgcn_perm(qx<0xB1>(w0), w0, sel1), n1 = __builtin_amdgcn_perm(qx<0xB1>(w1), w1, sel1);
                            const unsigned q0 = qx<0x4E>(n0), q1 = qx<0x4E>(n1); u32x2 w; w.x = up2 ? q1 : n0; w.y = up2 ? n1 : q0;
                            const int rowq = row - (fr & 3), b = rowq >> 8, mm = rowq & 255;
                            *(u32x2*)(VT + ((size_t)(b * 4 + h) * 256 + cl + (fr & 3)) * 256 + mm) = w; } } asm volatile("" ::: "memory"); }
    }
};
template <class Sched> __device__ __forceinline__ void rstd_to_lds(PG8_LAS float* rsl, const float* ssq, const Sched& S, int tid, const float* mssq2 = nullptr) {
    Unit u;
    for (int i = 0; i < 8; ++i) { if (!S.next(i, u)) break;
        if (tid < 256 && u.pm < PM2) { const int row = u.pm * BM + tid; const f32x4* sp = (const f32x4*)(ssq + (size_t)row * NSSQ); const f32x4 s0 = sp[0], s1 = sp[1], s2 = sp[2], s3 = sp[3];
            const float ss = ((s0[0] + s0[1]) + (s0[2] + s0[3])) + ((s1[0] + s1[1]) + (s1[2] + s1[3])) + ((s2[0] + s2[1]) + (s2[2] + s2[3])) + ((s3[0] + s3[1]) + (s3[2] + s3[3]));
            rsl[i * 256 + tid] = rsqrtf(ss * (1.0f / DMODEL) + RMS_EPS); }
        else if (tid < 256 && mssq2) rsl[i * 256 + tid] = rsqrtf(mssq2[(u.pm - PM2) * BM + tid] * (1.0f / DMODEL) + RMS_EPS); }
    __syncthreads();
}
#ifndef MK_SWIGLU_NARROW
struct EpiSwigluL { static constexpr bool PERM = false, AFTER_DRAIN = false;
    bf16_t* H; const PG8_LAS float* rsl; int ldh, pad;
    __device__ __forceinline__ void operator()(const f32x4 (&acc)[2][2][4][2], const Unit& u, int wr, int wc, int fr, int fq) const {
        const int coff = (fq & 1) ? 64 + 4 * (fq - 1) : 4 * fq;
#pragma unroll
        for (int ai = 0; ai < 2; ++ai)
#pragma unroll
            for (int m = 0; m < 4; ++m) { const int lr = ai * HALF + wr * 64 + m * 16 + fr, row = u.pm * BM + lr; const float rs = rsl[u.idx * 256 + lr]; u32x2 w[2];
                const float c1 = rs * -1.4426950408889634f, rs2 = rs * rs;
#pragma unroll
                for (int bj = 0; bj < 2; ++bj) { const f32x4 g = acc[ai][bj][m][0], up = acc[ai][bj][m][1]; const f32x4 a = g * c1;
                    f32x4 d = {__builtin_amdgcn_exp2f(a[0]), __builtin_amdgcn_exp2f(a[1]), __builtin_amdgcn_exp2f(a[2]), __builtin_amdgcn_exp2f(a[3])}; d = d + 1.0f;
                    const f32x4 r = {__builtin_amdgcn_rcpf(d[0]), __builtin_amdgcn_rcpf(d[1]), __builtin_amdgcn_rcpf(d[2]), __builtin_amdgcn_rcpf(d[3])};
                    const f32x4 o = ((g * up) * rs2) * r;
                    w[bj].x = cvt_pk_bf16(o[0], o[1]); w[bj].y = cvt_pk_bf16(o[2], o[3]); }
                const auto rx = __builtin_amdgcn_permlane16_swap(w[0].x, w[1].x, false, false); const auto ry = __builtin_amdgcn_permlane16_swap(w[0].y, w[1].y, false, false);
                u32x4 o; o.x = (unsigned)rx[0]; o.y = (unsigned)ry[0]; o.z = (unsigned)rx[1]; o.w = (unsigned)ry[1];
                *(u32x4*)(H + (size_t)row * ldh + u.pn * 128 + wc * 16 + coff) = o; }
    }
};
#else
struct EpiSwigluL { static constexpr bool PERM = false, AFTER_DRAIN = false;
    bf16_t* H; const PG8_LAS float* rsl; int ldh, pad;
    __device__ __forceinline__ void operator()(const f32x4 (&acc)[2][2][4][2], const Unit& u, int wr, int wc, int fr, int fq) const {
#pragma unroll
        for (int ai = 0; ai < 2; ++ai)
#pragma unroll
            for (int m = 0; m < 4; ++m) { const int lr = ai * HALF + wr * 64 + m * 16 + fr, row = u.pm * BM + lr; const float rs = rsl[u.idx * 256 + lr];
#pragma unroll
                for (int bj = 0; bj < 2; ++bj) { const f32x4 g = acc[ai][bj][m][0] * rs, up = acc[ai][bj][m][1] * rs; u32x2 w;
                    w.x = cvt_pk_bf16(silu_f(g[0]) * up[0], silu_f(g[1]) * up[1]); w.y = cvt_pk_bf16(silu_f(g[2]) * up[2], silu_f(g[3]) * up[3]);
                    *(u32x2*)(H + (size_t)row * ldh + u.pn * 128 + bj * 64 + wc * 16 + 4 * fq) = w; } }
    }
};
#endif
struct EpiUpKV { static constexpr bool PERM = false, AFTER_DRAIN = false;
    EpiSwigluL a; EpiKV b;
    __device__ __forceinline__ void operator()(const f32x4 (&acc)[2][2][4][2], const Unit& u, int wr, int wc, int fr, int fq) const {
        if (u.pm >= PM2) { Unit v = u; v.pm -= PM2; b(acc, v, wr, wc, fr, fq); } else a(acc, u, wr, wc, fr, fq);
    }
};
struct EpiZL { static constexpr bool PERM = true, AFTER_DRAIN = false;
    bf16_t* Z; float* ZG; const PG8_LAS float* rsl;
    __device__ __forceinline__ void operator()(const f32x4 (&acc)[2][2][4][2], const Unit& u, int wr, int wc, int fr, int fq) const {
        constexpr int ZW = 3584, ZGP = 32;
#pragma unroll
        for (int ai = 0; ai < 2; ++ai)
#pragma unroll
            for (int m = 0; m < 4; ++m) { const int lr = ai * HALF + wr * 64 + m * 16 + fr, row = u.pm * BM + lr; const float rs = rsl[u.idx * 256 + lr];
                if (u.pn < ZW / BM) {
#pragma unroll
                    for (int bj = 0; bj < 2; ++bj) { const f32x4 v0 = acc[ai][bj][m][0] * rs, v1 = acc[ai][bj][m][1] * rs; u32x4 w; w.x = cvt_pk_bf16(v0[0], v0[1]); w.y = cvt_pk_bf16(v0[2], v0[3]); w.z = cvt_pk_bf16(v1[0], v1[1]); w.w = cvt_pk_bf16(v1[2], v1[3]);
                        *(u32x4*)(Z + (size_t)row * ZW + u.pn * BM + bj * HALF + wc * 32 + 8 * fq) = w; }
                } else if (wc == 0) { *(f32x4*)(ZG + (size_t)row * ZGP + 8 * fq) = acc[ai][0][m][0] * rs; *(f32x4*)(ZG + (size_t)row * ZGP + 8 * fq + 4) = acc[ai][0][m][1] * rs; } }
    }
};
constexpr int CW_PANEL = 65536;
__device__ __forceinline__ void panel_wait(unsigned* cnt, unsigned want, int wid, int lane) {
    if (wid == 0) { unsigned spins = 0;
        while ((unsigned)__builtin_amdgcn_readfirstlane(__hip_atomic_load(cnt, __ATOMIC_RELAXED, __HIP_MEMORY_SCOPE_AGENT)) < want) { __builtin_amdgcn_s_sleep(2); if (++spins > (1u << 22)) break; }
        __builtin_amdgcn_fence(__ATOMIC_ACQUIRE, "agent"); }
    asm volatile("s_waitcnt vmcnt(0) lgkmcnt(0)" ::: "memory"); __builtin_amdgcn_s_barrier(); asm volatile("" ::: "memory");
}
__device__ __forceinline__ float row_rstd_sc1(const float* ssq, int row, int fq) {
    const unsigned long long* p = (const unsigned long long*)(ssq + (size_t)row * NSSQ + 4 * fq); const unsigned long long a = __hip_atomic_load(p, __ATOMIC_RELAXED, __HIP_MEMORY_SCOPE_AGENT), b = __hip_atomic_load(p + 1, __ATOMIC_RELAXED, __HIP_MEMORY_SCOPE_AGENT);
    float s = (__uint_as_float((unsigned)a) + __uint_as_float((unsigned)(a >> 32))) + (__uint_as_float((unsigned)b) + __uint_as_float((unsigned)(b >> 32))); s += shx(s, 16); s += shx(s, 32);
    return rsqrtf(s * (1.0f / DMODEL) + RMS_EPS); }
struct EpiResidFinal { static constexpr bool PERM = false, AFTER_DRAIN = true;
    const bf16_t* XB; float* ssq; float* Y; const float* gfin; unsigned* cnt; float alpha; int pad;
    __device__ __forceinline__ void fused(f32x4 (&acc)[2][2][4][2], const Unit& u, int wr, int wc, int fr, int fq, PG8_LAS unsigned char* lds, int wid, int lane) const {
#pragma unroll
        for (int ai = 0; ai < 2; ++ai) { u32x2 bw[4][2][2];
#pragma unroll
            for (int m = 0; m < 4; ++m)
#pragma unroll
                for (int bj = 0; bj < 2; ++bj)
#pragma unroll
                    for (int n = 0; n < 2; ++n) bw[m][bj][n] = *(const u32x2*)(XB + (size_t)(u.pm * BM + ai * HALF + wr * 64 + m * 16 + fr) * DMODEL + u.pn * BM + bj * HALF + wc * 32 + n * 16 + 4 * fq);
#pragma unroll
            for (int m = 0; m < 4; ++m) { const int row = u.pm * BM + ai * HALF + wr * 64 + m * 16 + fr; float q = 0.f;
#pragma unroll
                for (int bj = 0; bj < 2; ++bj)
#pragma unroll
                    for (int n = 0; n < 2; ++n) { const u32x2 w0 = bw[m][bj][n]; const f32x4 b = {__uint_as_float(w0.x << 16), __uint_as_float(w0.x & 0xffff0000u), __uint_as_float(w0.y << 16), __uint_as_float(w0.y & 0xffff0000u)};
                        const f32x4 o = b + acc[ai][bj][m][n] * alpha; q += (o[0] * o[0] + o[1] * o[1]) + (o[2] * o[2] + o[3] * o[3]);
#ifdef MK_DBG_XB
                        { u32x2 w; w.x = cvt_pk_bf16(o[0], o[1]); w.y = cvt_pk_bf16(o[2], o[3]); *(u32x2*)(const_cast<bf16_t*>(XB) + (size_t)row * DMODEL + u.pn * BM + bj * HALF + wc * 32 + n * 16 + 4 * fq) = w; }
#endif
                        }
                q += shx(q, 16); q += shx(q, 32);
                if (fq == 0) __hip_atomic_store((unsigned*)(ssq + (size_t)row * NSSQ + u.pn * 4 + wc), __float_as_uint(q), __ATOMIC_RELAXED, __HIP_MEMORY_SCOPE_AGENT); }
            asm volatile("" ::: "memory"); }
        asm volatile("s_waitcnt vmcnt(0)" ::: "memory");
        if (lane == 0) __hip_atomic_fetch_add(cnt + 64 * u.pm, 1u, __ATOMIC_RELAXED, __HIP_MEMORY_SCOPE_AGENT);
        panel_wait(cnt + 64 * u.pm, 32u, wid, lane);
        f32x4 gv[2][2];
#pragma unroll
        for (int bj = 0; bj < 2; ++bj)
#pragma unroll
            for (int n = 0; n < 2; ++n) gv[bj][n] = *(const f32x4*)(gfin + u.pn * BM + bj * HALF + wc * 32 + n * 16 + 4 * fq);
#pragma unroll
        for (int ai = 0; ai < 2; ++ai) { u32x2 bw[4][2][2]; float rs[4];
#pragma unroll
            for (int m = 0; m < 4; ++m) { const int row = u.pm * BM + ai * HALF + wr * 64 + m * 16 + fr; rs[m] = row_rstd_sc1(ssq, row, fq);
#pragma unroll
                for (int bj = 0; bj < 2; ++bj)
#pragma unroll
                    for (int n = 0; n < 2; ++n) bw[m][bj][n] = *(const u32x2*)(XB + (size_t)row * DMODEL + u.pn * BM + bj * HALF + wc * 32 + n * 16 + 4 * fq); }
#pragma unroll
            for (int m = 0; m < 4; ++m) { const int row = u.pm * BM + ai * HALF + wr * 64 + m * 16 + fr;
#pragma unroll
                for (int bj = 0; bj < 2; ++bj)
#pragma unroll
                    for (int n = 0; n < 2; ++n) { const u32x2 w0 = bw[m][bj][n]; const f32x4 b = {__uint_as_float(w0.x << 16), __uint_as_float(w0.x & 0xffff0000u), __uint_as_float(w0.y << 16), __uint_as_float(w0.y & 0xffff0000u)};
                        const f32x4 o = b + acc[ai][bj][m][n] * alpha; *(f32x4*)(Y + (size_t)row * DMODEL + u.pn * BM + bj * HALF + wc * 32 + n * 16 + 4 * fq) = o * rs[m] * gv[bj][n]; } }
            asm volatile("" ::: "memory"); }
    }
};
}
#define GAS __attribute__((address_space(1)))
#define LAS __attribute__((address_space(3)))
typedef unsigned short bf16;
typedef unsigned v4u __attribute__((ext_vector_type(4)));
typedef float f32x4 __attribute__((ext_vector_type(4)));
typedef short bf16x8 __attribute__((ext_vector_type(8)));
typedef GAS unsigned gu32;
typedef GAS unsigned long long gu64;
#define RLX_AGENT __ATOMIC_RELAXED, __HIP_MEMORY_SCOPE_AGENT
#define LDS_WAIT() asm volatile("s_waitcnt lgkmcnt(0)" ::: "memory")
#define VM_WAIT() asm volatile("s_waitcnt vmcnt(0)" ::: "memory")
__device__ __forceinline__ unsigned long long rt() { return __builtin_amdgcn_s_memrealtime(); }
__device__ __forceinline__ unsigned f2bf(float f) { unsigned u = __builtin_bit_cast(unsigned, f); return (u + 0x7fffu + ((u >> 16) & 1u)) >> 16; }
__device__ __forceinline__ unsigned pk2(float lo, float hi) { return f2bf(lo) | (f2bf(hi) << 16); }

#define XB_TMO      128
#define XB_XCNT(j)  (256  + 64 * (j))
#define XB_XSUB(j)  (1280 + 64 * (j))
#define XB_XGEN(j)  (2304 + 64 * (j))
#define XB_TOP      3328
#define XB_TOPGEN   3392
#define XCD_BAR_WORDS 3456
#define XB_SPIN_CAP (1u << 18)

__device__ __forceinline__ unsigned xb_ld(unsigned* p)              { return __hip_atomic_load(p, __ATOMIC_RELAXED, __HIP_MEMORY_SCOPE_AGENT); }
__device__ __forceinline__ unsigned xb_add(unsigned* p, unsigned v) { return __hip_atomic_fetch_add(p, v, __ATOMIC_RELAXED, __HIP_MEMORY_SCOPE_AGENT); }
__device__ __forceinline__ unsigned xb_xcc_id() { return (unsigned)__builtin_amdgcn_s_getreg((3 << 11) | 20) & 0xFu; }
#define XB_SPIN(cond, bar) do { unsigned _sp = 0; while (cond) { __builtin_amdgcn_s_sleep(1); \
    if ((++_sp & 255u) == 0u) { if (xb_ld(&(bar)[XB_TMO])) break; if (_sp > XB_SPIN_CAP) { atomicAdd(&(bar)[XB_TMO], 1u); break; } } } } while (0)

struct XcdBarrier {
    unsigned* bar; unsigned x;
    volatile LAS unsigned* st;
};

__device__ __forceinline__ XcdBarrier xcd_barrier_post(unsigned* bar, volatile LAS unsigned* st) {
    XcdBarrier b; b.bar = bar; b.x = xb_xcc_id(); b.st = st;
    if (threadIdx.x == 0) (void)xb_add(&bar[XB_XCNT(b.x)], 1u);
    return b;
}
__device__ __forceinline__ void xcd_barrier_complete(unsigned* bar, unsigned x, unsigned& nloc, unsigned& nx) {
    const unsigned G = gridDim.x * gridDim.y * gridDim.z;
    unsigned sum, cnt, mine, sp = 0u;
    for (;;) {
        sum = 0u; cnt = 0u; mine = 0u;
#pragma unroll
        for (unsigned j = 0; j < 16; ++j) { const unsigned c = xb_ld(&bar[XB_XCNT(j)]); sum += c; cnt += (c > 0u) ? 1u : 0u; mine = (j == x) ? c : mine; }
        if (sum == G) break;
        __builtin_amdgcn_s_sleep(1);
        if ((++sp & 255u) == 0u) { if (xb_ld(&bar[XB_TMO])) break; if (sp > XB_SPIN_CAP) { atomicAdd(&bar[XB_TMO], 1u); break; } }
    }
    nloc = mine > 0u ? mine : 1u; nx = cnt > 0u ? cnt : 1u;
}

__device__ __forceinline__ void xcd_barrier(const XcdBarrier& b) {
    asm volatile("s_waitcnt vmcnt(0)" ::: "memory");
    __syncthreads();
    if (threadIdx.x == 0) {
        unsigned* bar = b.bar;
        __builtin_amdgcn_s_waitcnt(0);
        unsigned nloc = b.st[0], nx = b.st[1];
        if (nloc == 0u) { xcd_barrier_complete(bar, b.x, nloc, nx); b.st[0] = nloc; b.st[1] = nx; }
        const unsigned old = xb_add(&bar[XB_XSUB(b.x)], 1u);
        const unsigned gen = old / nloc;
        if (old + 1u == (gen + 1u) * nloc) {
            __builtin_amdgcn_fence(__ATOMIC_RELEASE, "agent");
            asm volatile("s_waitcnt vmcnt(0)" ::: "memory");
            const unsigned og = xb_add(&bar[XB_TOP], 1u);
            const unsigned tg = og / nx;
            if (og + 1u == (tg + 1u) * nx) xb_add(&bar[XB_TOPGEN], 1u);
            else XB_SPIN(xb_ld(&bar[XB_TOPGEN]) == tg, bar);
            __builtin_amdgcn_fence(__ATOMIC_ACQUIRE, "agent");
            xb_add(&bar[XB_XGEN(b.x)], 1u);
            asm volatile("s_waitcnt vmcnt(0)" ::: "memory");
        } else {
            XB_SPIN(xb_ld(&bar[XB_XGEN(b.x)]) == gen, bar);
            __builtin_amdgcn_fence(__ATOMIC_ACQUIRE, "agent");
            asm volatile("s_waitcnt vmcnt(0)" ::: "memory");
        }
    }
    __syncthreads();
}
constexpr int NWAVES = 8;
constexpr int RING_OFF = 0, RING_BYTES = 131072;
constexpr int LDSCTL_OFF = RING_BYTES, MISC_OFF = LDSCTL_OFF + 320;
constexpr int LDS_BYTES = 147456;
constexpr int RSL_OFF = MISC_OFF + 128;
static_assert(RSL_OFF + 8 * 256 * 4 <= LDS_BYTES, "LDS map");
constexpr int CW_TMO = 0, CW_CODE = 1, CW_FLAG = 2, CW_DONE = 3, CW_BAR = 4096, MAX_LAUNCHES = 1; constexpr unsigned CTL_MAGIC = 0x5EEDC0DEu;
constexpr size_t CTL_ZERO_BYTES = 1u << 15;
static_assert((CW_BAR + MAX_LAUNCHES * XCD_BAR_WORDS) * 4 <= (int)CTL_ZERO_BYTES, "barrier regions inside the memset region");
constexpr int MROWS = 16896, PROWS = 16384, DM = 1024, DFF = 2816, ZW = 3584, WIN_N = 3840, MEMROWS = 2048;
enum Phase { PH_PROLOGUE = 0, PH_UP1, PH_DOWN1, PH_WIN, PH_MIX_LOCAL, PH_MIX_SCAN, PH_MIX_OUT, PH_WOUT, PH_Q, PH_ATTN, PH_WO, PH_UP2, PH_DOWN2, PH_FINAL, PH_COUNT };

constexpr nv::Dm FULL_DIMS{1024, 8, 2048, 128, 4, 4, 128, 128, 4, 64, 128, 16, 256, 4, 256, 2816, 3608, 0, 1e-6f, 16.f};
constexpr nv::Ws WSO = nv::carve_ws(FULL_DIMS);
constexpr nv::OutOff OUTO = nv::out_off(FULL_DIMS);
struct Args { const float* in[33]; float* out; unsigned char* ws; int ph_lo, ph_hi, li, pad; };

__device__ __forceinline__ float wave_sum(float v) {
#pragma unroll
    for (int o = 1; o < 64; o <<= 1) v += shx(v, o);
    return v;
}
struct WSrc { const float* W; const float* gain; int col, pitch; float scale; int zero; };
__device__ __forceinline__ WSrc wsrc(int mat, int np, const float* const* in) {
    WSrc s; s.gain = nullptr; s.scale = 1.f; s.zero = 0; s.col = np; s.pitch = DM; s.W = nullptr;
    switch (mat) {
    case 0: case 7: { const int g = np >> 5, i = np & 31; const bool up = i >= 16; s.W = in[mat == 0 ? (up ? nv::I_F1WU : nv::I_F1WG) : (up ? nv::I_F2WU : nv::I_F2WG)]; s.col = 16 * g + (i & 15); s.pitch = DFF; s.gain = in[mat == 0 ? nv::I_F1G : nv::I_F2G]; break; }
    case 1: case 8: s.W = in[mat == 1 ? nv::I_F1WD : nv::I_F2WD]; break;
    case 2: { s.W = in[nv::I_WIN]; s.pitch = 3608; s.gain = in[nv::I_MIXG];
        if (np < 1536) { s.col = np; if (np >= 512 && np < 1024) s.scale = 0.08838834764831845f; }
        else if (np < 3072) { s.col = np + 8; if (np >= 2048 && np < 2304) s.scale = 0.125f; }
        else if (np < 3584) s.col = np + 24;
        else if (np < 3592) s.col = 1536 + (np - 3584);
        else if (np < 3608) s.col = 3080 + (np - 3592);
        else { s.zero = 1; s.col = 0; }
        break; }
    case 3: s.W = in[nv::I_WOUT]; break;
    case 4: s.W = in[nv::I_WQ]; s.gain = in[nv::I_XG]; s.scale = 0.0625f; break;
    case 5: s.W = in[np < DM ? nv::I_WK : nv::I_WV]; s.col = np & (DM - 1); s.gain = in[nv::I_MEMG]; break;
    default: s.W = in[nv::I_WO]; break;
    }
    return s;
}
struct WItem { int mat, K, kb, nb; size_t off; };
__device__ __forceinline__ WItem witem(int g) {
    WItem w; int nnb;
    if (g < 2816) { w.mat = 0; w.K = DM; nnb = 88; w.off = WSO.wgu1; }
    else if ((g -= 2816) < 1408) { w.mat = 1; w.K = DFF; nnb = 16; w.off = WSO.wd1; }
    else if ((g -= 1408) < 1920) { w.mat = 2; w.K = DM; nnb = 60; w.off = WSO.win; }
    else if ((g -= 1920) < 512) { w.mat = 3; w.K = DM; nnb = 16; w.off = WSO.wout; }
    else if ((g -= 512) < 512) { w.mat = 4; w.K = DM; nnb = 16; w.off = WSO.wq; }
    else if ((g -= 512) < 1024) { w.mat = 5; w.K = DM; nnb = 32; w.off = WSO.wkv; }
    else if ((g -= 1024) < 512) { w.mat = 6; w.K = DM; nnb = 16; w.off = WSO.wo; }
    else if ((g -= 512) < 2816) { w.mat = 7; w.K = DM; nnb = 88; w.off = WSO.wgu2; }
    else { g -= 2816; w.mat = 8; w.K = DFF; nnb = 16; w.off = WSO.wd2; }
    w.kb = g / nnb; w.nb = g % nnb; return w; }
constexpr int W_ITEMS = 2816 + 1408 + 1920 + 512 + 512 + 1024 + 512 + 2816 + 1408;
struct WRegs { f32x4 v[8]; };
__device__ __forceinline__ void witem_load(WRegs& R, const float* const* in, int g, int lane) { const WItem w = witem(g); const int k0 = 32 * w.kb, n0 = 64 * w.nb, n4 = lane & 15, kq = lane >> 4; const WSrc s = wsrc(w.mat, n0 + 4 * n4, in);
#pragma unroll
    for (int i = 0; i < 8; ++i) { const int kk = kq + 4 * i; R.v[i] = (f32x4){0.f, 0.f, 0.f, 0.f}; if (!s.zero) R.v[i] = __builtin_nontemporal_load((const GAS f32x4*)(s.W + (size_t)(k0 + kk) * s.pitch + s.col)); } }
__device__ __forceinline__ void witem_store(const WRegs& R, const float* const* in, unsigned char* ws, LAS float* scr, int g, int lane) { const WItem w = witem(g); const int k0 = 32 * w.kb, n0 = 64 * w.nb, n4 = lane & 15, kq = lane >> 4; bf16* WT = (bf16*)(ws + w.off); const WSrc s = wsrc(w.mat, n0 + 4 * n4, in);
#pragma unroll
    for (int i = 0; i < 8; ++i) { const int kk = kq + 4 * i; *(LAS f32x4*)(scr + kk * 68 + 4 * n4) = R.v[i] * (s.gain ? s.gain[k0 + kk] * s.scale : s.scale); }
    LDS_WAIT(); asm volatile("" ::: "memory");
    const int c = lane & 3;
#pragma unroll
    for (int j = 0; j < 4; ++j) { const int n = (lane >> 2) + 16 * j; const LAS float* p = scr + (8 * c) * 68 + n;
        v4u o; o.x = pk2(p[0 * 68], p[1 * 68]); o.y = pk2(p[2 * 68], p[3 * 68]); o.z = pk2(p[4 * 68], p[5 * 68]); o.w = pk2(p[6 * 68], p[7 * 68]);
        *(GAS v4u*)(WT + (size_t)(n0 + n) * w.K + k0 + 8 * c) = o; }
    LDS_WAIT(); asm volatile("" ::: "memory");
}
__device__ __forceinline__ float row_to_bf16(const float* xrow, bf16* orow, int lane) {
    const GAS f32x4* xr = (const GAS f32x4*)xrow + lane; f32x4 v[4]; float s = 0.f;
#pragma unroll
    for (int j = 0; j < 4; ++j) { v[j] = __builtin_nontemporal_load(xr + 64 * j); s += (v[j].x * v[j].x + v[j].y * v[j].y) + (v[j].z * v[j].z + v[j].w * v[j].w); }
    GAS unsigned long long* o8 = (GAS unsigned long long*)orow + lane;
#pragma unroll
    for (int j = 0; j < 4; ++j) o8[64 * j] = (unsigned long long)pk2(v[j].x, v[j].y) | ((unsigned long long)pk2(v[j].z, v[j].w) << 32);
    return wave_sum(s);
}
struct Frame { LAS unsigned char* lds; int tid, lane, wave, vcu, G; };
__device__ __forceinline__ void p0_prologue(const Frame& F, const float* const* in, unsigned char* ws) {
    LAS float* scr = (LAS float*)(F.lds + RING_OFF + F.wave * 16384);
    const int NGW = F.G * NWAVES, gw = F.wave * F.G + F.vcu, gwr = ((F.wave + 4) & (NWAVES - 1)) * F.G + F.vcu;
    const bool defer = F.G == 256; const int lim = defer ? 8576 : W_ITEMS;
    for (int q = gw; q < lim; q += 2 * NGW) { WRegs A, B; const int q2 = q + NGW; const bool two = q2 < lim;
        const int g = !defer || q < 2816 ? q : q < 4736 ? q + 1408 : q < 5760 ? q + 2432 : q + 2944, g2 = !defer || q2 < 2816 ? q2 : q2 < 4736 ? q2 + 1408 : q2 < 5760 ? q2 + 2432 : q2 + 2944;
        witem_load(A, in, g, F.lane); if (two) witem_load(B, in, g2, F.lane);
        witem_store(A, in, ws, scr, g, F.lane); if (two) witem_store(B, in, ws, scr, g2, F.lane); }
    bf16* XB = (bf16*)(ws + WSO.xb); float* SSQ = (float*)(ws + WSO.ssq);
    for (int m0 = gwr; m0 < MROWS; m0 += 2 * NGW) { const int m1 = m0 + NGW;
        const float* s0p = m0 < PROWS ? in[nv::I_XP] + (size_t)m0 * DM : in[nv::I_XS] + (size_t)(m0 - PROWS) * DM; const bool two = m1 < MROWS; const int m1c = two ? m1 : m0;
        const float* s1p = m1c < PROWS ? in[nv::I_XP] + (size_t)m1c * DM : in[nv::I_XS] + (size_t)(m1c - PROWS) * DM;
        f32x4 va[4], vb[4];
#pragma unroll
        for (int j = 0; j < 4; ++j) { va[j] = __builtin_nontemporal_load((const GAS f32x4*)s0p + F.lane + 64 * j); vb[j] = __builtin_nontemporal_load((const GAS f32x4*)s1p + F.lane + 64 * j); }
        float sa = 0.f, sb = 0.f; GAS unsigned long long* oa = (GAS unsigned long long*)(XB + (size_t)m0 * DM) + F.lane; GAS unsigned long long* ob = (GAS unsigned long long*)(XB + (size_t)m1c * DM) + F.lane;
#pragma unroll
        for (int j = 0; j < 4; ++j) { sa += (va[j].x * va[j].x + va[j].y * va[j].y) + (va[j].z * va[j].z + va[j].w * va[j].w); sb += (vb[j].x * vb[j].x + vb[j].y * vb[j].y) + (vb[j].z * vb[j].z + vb[j].w * vb[j].w);
            oa[64 * j] = (unsigned long long)pk2(va[j].x, va[j].y) | ((unsigned long long)pk2(va[j].z, va[j].w) << 32); if (two) ob[64 * j] = (unsigned long long)pk2(vb[j].x, vb[j].y) | ((unsigned long long)pk2(vb[j].z, vb[j].w) << 32); }
        sa = wave_sum(sa); sb = wave_sum(sb);
        if (F.lane < 16) { SSQ[(size_t)m0 * 16 + F.lane] = F.lane == 0 ? sa : 0.f; if (two) SSQ[(size_t)m1 * 16 + F.lane] = F.lane == 0 ? sb : 0.f; } }
    bf16* MEMB = (bf16*)(ws + WSO.memb); float* MSSQ = (float*)(ws + WSO.mssq);
    for (int m = gw; m < MEMROWS; m += NGW) { const float s = row_to_bf16(in[nv::I_MEM] + (size_t)m * DM, MEMB + (size_t)m * DM, F.lane); if (F.lane == 0) MSSQ[m] = s; }
}
__device__ __forceinline__ void convert_range(const Frame& F, const float* const* in, unsigned char* ws, int lo, int hi, int widx, int nw) {
    LAS float* scr = (LAS float*)(F.lds + RING_OFF + F.wave * 16384);
    for (int g = lo + widx; g < hi; g += 2 * nw) { WRegs A, B; const bool two = g + nw < hi; witem_load(A, in, g, F.lane); if (two) witem_load(B, in, g + nw, F.lane);
        witem_store(A, in, ws, scr, g, F.lane); if (two) witem_store(B, in, ws, scr, g + nw, F.lane); }
}
__device__ __forceinline__ void kv_out_pass(const Frame& F, unsigned char* ws, float* out, int widx, int nw) {
    LAS unsigned char* scr = F.lds + RING_OFF + F.wave * 16384; const int c8 = F.lane & 7, r0 = F.lane >> 3;
    for (int it = widx; it < 1024; it += nw) { v4u v[8];
        if (it < 512) { const int rb = it >> 4, cb = it & 15; const size_t e0 = (size_t)(rb * 64 + r0) * DM + cb * 64 + 8 * c8; const bf16* src = (const bf16*)(ws + WSO.kb) + e0; float* dst = out + OUTO.mk + e0;
#pragma unroll
            for (int j = 0; j < 8; ++j) v[j] = __builtin_nontemporal_load((const GAS v4u*)(src + (size_t)(8 * j) * DM));
#pragma unroll
            for (int j = 0; j < 8; ++j) { const f32x4 a = {__uint_as_float(v[j].x << 16), __uint_as_float(v[j].x & 0xffff0000u), __uint_as_float(v[j].y << 16), __uint_as_float(v[j].y & 0xffff0000u)};
                const f32x4 b = {__uint_as_float(v[j].z << 16), __uint_as_float(v[j].z & 0xffff0000u), __uint_as_float(v[j].w << 16), __uint_as_float(v[j].w & 0xffff0000u)};
                __builtin_nontemporal_store(a, (GAS f32x4*)(dst + (size_t)(8 * j) * DM)); __builtin_nontemporal_store(b, (GAS f32x4*)(dst + (size_t)(8 * j) * DM + 4)); }
        } else { const int q = it - 512, plane = q >> 4, dvb = (q >> 2) & 3, mmb = q & 3; const bf16* src = (const bf16*)(ws + WSO.vt) + ((size_t)plane * 256 + dvb * 64 + r0) * 256 + mmb * 64 + 8 * c8;
#pragma unroll
            for (int j = 0; j < 8; ++j) v[j] = __builtin_nontemporal_load((const GAS v4u*)(src + (size_t)(8 * j) * 256));
#pragma unroll
            for (int j = 0; j < 8; ++j) { LAS unsigned long long* wp = (LAS unsigned long long*)(scr + (r0 + 8 * j) * 136 + 16 * c8);
                wp[0] = (unsigned long long)v[j].x | ((unsigned long long)v[j].y << 32); wp[1] = (unsigned long long)v[j].z | ((unsigned long long)v[j].w << 32); }
            LDS_WAIT(); asm volatile("" ::: "memory");
            float* dst = out + OUTO.mv + (size_t)((plane >> 2) * 256 + mmb * 64 + r0) * DM + (plane & 3) * 256 + dvb * 64 + 8 * c8;
#pragma unroll
            for (int jj = 0; jj < 8; ++jj) { const LAS unsigned short* rp = (const LAS unsigned short*)(scr + (8 * c8) * 136 + 2 * (r0 + 8 * jj)); f32x4 a, b;
#pragma unroll
                for (int i = 0; i < 4; ++i) { a[i] = __uint_as_float((unsigned)rp[i * 68] << 16); b[i] = __uint_as_float((unsigned)rp[(i + 4) * 68] << 16); }
                __builtin_nontemporal_store(a, (GAS f32x4*)(dst + (size_t)(8 * jj) * DM)); __builtin_nontemporal_store(b, (GAS f32x4*)(dst + (size_t)(8 * jj) * DM + 4)); }
            LDS_WAIT(); asm volatile("" ::: "memory"); }
    }
}
__device__ __forceinline__ void p_final(const Frame& F, const float* const* in, float* out, unsigned char* ws) {
    const int gw = F.wave * F.G + F.vcu, NGW = F.G * NWAVES; const bf16* XB = (const bf16*)(ws + WSO.xb); const float* SSQ = (const float*)(ws + WSO.ssq); const float* g = in[nv::I_FING];
    f32x4 gv[4];
#pragma unroll
    for (int j = 0; j < 4; ++j) gv[j] = ((const GAS f32x4*)g)[F.lane + 64 * j];
    for (int m0 = gw; m0 < MROWS; m0 += 2 * NGW) { const int m1 = m0 + NGW < MROWS ? m0 + NGW : m0; unsigned long long xw[2][4]; f32x4 sv[2][4];
#pragma unroll
        for (int q = 0; q < 2; ++q) { const int m = q ? m1 : m0; const GAS f32x4* sp = (const GAS f32x4*)(SSQ + (size_t)m * 16); const GAS unsigned long long* xr = (const GAS unsigned long long*)(XB + (size_t)m * DM) + F.lane;
#pragma unroll
            for (int j = 0; j < 4; ++j) { sv[q][j] = sp[j]; xw[q][j] = __builtin_nontemporal_load(xr + 64 * j); } }
#pragma unroll
        for (int q = 0; q < 2; ++q) { const int m = q ? m1 : m0; if (q == 1 && m1 == m0) break;
        const f32x4 s0 = sv[q][0], s1 = sv[q][1], s2 = sv[q][2], s3 = sv[q][3];
        const float ss = ((s0.x + s0.y) + (s0.z + s0.w)) + ((s1.x + s1.y) + (s1.z + s1.w)) + ((s2.x + s2.y) + (s2.z + s2.w)) + ((s3.x + s3.y) + (s3.z + s3.w));
        const float rs = rsqrtf(ss * (1.0f / DM) + 1e-6f); GAS f32x4* yo = (GAS f32x4*)(out + OUTO.yp + (size_t)m * DM) + F.lane;
#pragma unroll
        for (int j = 0; j < 4; ++j) { const unsigned long long w = xw[q][j]; const unsigned lo = (unsigned)w, hi = (unsigned)(w >> 32);
            const f32x4 x = {__uint_as_float(lo << 16), __uint_as_float(lo & 0xffff0000u), __uint_as_float(hi << 16), __uint_as_float(hi & 0xffff0000u)}; __builtin_nontemporal_store(x * rs * gv[j], yo + 64 * j); } } }
}
namespace mx {
typedef short bf16x8 __attribute__((ext_vector_type(8)));
typedef short s16x4 __attribute__((ext_vector_type(4)));
typedef float f32x4 __attribute__((ext_vector_type(4)));
typedef unsigned u32x4 __attribute__((ext_vector_type(4)));
typedef unsigned u32x2 __attribute__((ext_vector_type(2)));
typedef LAS unsigned char* ldsp;
constexpr int ZQ = 0, ZK = 512, ZV = 1024, ZO = 1536, GQ = 2048, GK = 2304, GV = 2560, GG = 3072, ZWD = 3584, ZGP = 32;
constexpr int KP = 272, VP = 304, GP = 144, HP = 132;
constexpr int NITEM = 1024;
__device__ __forceinline__ float bf2f(unsigned short v) { return __uint_as_float((unsigned)v << 16); }
__device__ __forceinline__ float lsig(float x) { return fminf(x, 0.f) - __logf(1.f + __expf(-fabsf(x))); }
template <int CTRL, int ROW_MASK> __device__ __forceinline__ float dpp_get(float old, float x) { return __builtin_bit_cast(float, __builtin_amdgcn_update_dpp(__builtin_bit_cast(int, old), __builtin_bit_cast(int, x), CTRL, ROW_MASK, 0xF, false)); }
__device__ __forceinline__ float wscan_add(float v, int) {
    v += dpp_get<0x111, 0xF>(0.f, v); v += dpp_get<0x112, 0xF>(0.f, v); v += dpp_get<0x114, 0xF>(0.f, v); v += dpp_get<0x118, 0xF>(0.f, v);
    v += dpp_get<0x142, 0xA>(0.f, v); v += dpp_get<0x143, 0xC>(0.f, v); return v; }
__device__ __forceinline__ float wscan_max(float v, int) { const float ni = -INFINITY;
    v = fmaxf(v, dpp_get<0x111, 0xF>(ni, v)); v = fmaxf(v, dpp_get<0x112, 0xF>(ni, v)); v = fmaxf(v, dpp_get<0x114, 0xF>(ni, v)); v = fmaxf(v, dpp_get<0x118, 0xF>(ni, v));
    v = fmaxf(v, dpp_get<0x142, 0xA>(ni, v)); v = fmaxf(v, dpp_get<0x143, 0xC>(ni, v)); return v; }
__device__ __forceinline__ float wlast(float v) { return __builtin_bit_cast(float, __builtin_amdgcn_readlane(__builtin_bit_cast(int, v), 63)); }
__device__ __forceinline__ float wmax(float v) { return wlast(wscan_max(v, 0)); }
__device__ __forceinline__ float wsum(float v) { return wlast(wscan_add(v, 0)); }
__device__ __forceinline__ f32x4 mma(bf16x8 a, bf16x8 b, f32x4 c) { return __builtin_amdgcn_mfma_f32_16x16x32_bf16(a, b, c, 0, 0, 0); }
__device__ __forceinline__ bf16x8 frag_row(ldsp base, int pitchB, int row0, int k0, int lane) { return *(const LAS bf16x8*)(base + (row0 + (lane & 15)) * pitchB + (k0 + 8 * (lane >> 4)) * 2); }
__device__ __forceinline__ bf16x8 frag_tr(ldsp base, int pitchB, int k0, int col0, int lane) {
    ldsp p = base + (k0 + 8 * (lane >> 4) + ((lane & 15) >> 2)) * pitchB + (col0 + 4 * (lane & 3)) * 2;
    const s16x4 lo = __builtin_bit_cast(s16x4, __builtin_amdgcn_ds_read_tr16_b64_v4i16((LAS s16x4*)p));
    const s16x4 hi = __builtin_bit_cast(s16x4, __builtin_amdgcn_ds_read_tr16_b64_v4i16((LAS s16x4*)(p + 4 * pitchB)));
    return (bf16x8){lo[0], lo[1], lo[2], lo[3], hi[0], hi[1], hi[2], hi[3]}; }
__device__ __forceinline__ unsigned pkbf(float lo, float hi) { return pk2(lo, hi); }
template <int NCH> __device__ __forceinline__ void stage_tile(ldsp dst, int pb, const bf16* src, size_t gp, int rows, int tid) {
    for (int id = tid; id < rows * NCH; id += 512) { const int s = id / NCH, ch = id % NCH; *(LAS u32x4*)(dst + s * pb + ch * 16) = *(const GAS u32x4*)(src + (size_t)s * gp + ch * 8); } }
struct Ctx { const bf16* Z; const float* ZG; unsigned char* ws; const float* const* in; float* out; ldsp L; int tid, lane, wave, pad; };

__device__ __forceinline__ void scan_phase(const Ctx& c, int gtid, int nthreads) {
    const float* ML = (const float*)(c.ws + WSO.mloc);
    for (int q = gtid; q < 32 * 4096; q += nthreads) { const int bh = q >> 12, e = (q & 4095) * 4, e2 = (q & 4095) * 2, d2 = e2 >> 7;
        const bf16* CL = (const bf16*)(c.ws + WSO.cloc) + (size_t)bh * 32 * 16384 + e; bf16* CS = (bf16*)(c.ws + WSO.cst) + (size_t)bh * 32 * 16384 + e;
        const bf16* SL = (const bf16*)(c.ws + WSO.sloc) + (size_t)bh * 32 * 8192 + e2; bf16* SS = (bf16*)(c.ws + WSO.sst) + (size_t)bh * 32 * 8192 + e2; const float* GD = (const float*)(c.ws + WSO.gdec) + (size_t)bh * 32 * 64 + d2;
        f32x4 C = {0.f, 0.f, 0.f, 0.f}; float m = 0.f, S0 = 0.f, S1 = 0.f;
        for (int c0 = 0; c0 < 32; c0 += 8) { u32x2 lw[8]; unsigned sw[8]; float mlv[8], blv[8], gd[8];
#pragma unroll
            for (int j = 0; j < 8; ++j) { lw[j] = __builtin_nontemporal_load((const GAS u32x2*)(CL + (size_t)(c0 + j) * 16384)); sw[j] = __builtin_nontemporal_load((const GAS unsigned*)(SL + (size_t)(c0 + j) * 8192)); mlv[j] = ML[(bh * 32 + c0 + j) * 2]; blv[j] = ML[(bh * 32 + c0 + j) * 2 + 1]; gd[j] = GD[(c0 + j) * 64]; }
#pragma unroll
            for (int j = 0; j < 8; ++j) { u32x2 o; o.x = pkbf(C[0], C[1]); o.y = pkbf(C[2], C[3]); *(GAS u32x2*)(CS + (size_t)(c0 + j) * 16384) = o; *(GAS unsigned*)(SS + (size_t)(c0 + j) * 8192) = pkbf(S0, S1);
                const float mn = fmaxf(blv[j] + m, mlv[j]), fC = __expf(blv[j] + m - mn), fL = __expf(mlv[j] - mn);
                const f32x4 l = {__uint_as_float(lw[j][0] << 16), __uint_as_float(lw[j][0] & 0xffff0000u), __uint_as_float(lw[j][1] << 16), __uint_as_float(lw[j][1] & 0xffff0000u)}; C = C * fC + l * fL; m = mn;
                S0 = S0 * gd[j] + __uint_as_float(sw[j] << 16); S1 = S1 * gd[j] + __uint_as_float(sw[j] & 0xffff0000u); } }
        *(GAS f32x4*)(c.out + OUTO.cp + (size_t)bh * 16384 + e) = C; float* so = c.out + OUTO.sp + (size_t)bh * 8192 + e2; so[0] = S0; so[1] = S1; }
    for (int q = nthreads - 1 - gtid; q < 32 * 128; q += nthreads) { const int bh = q >> 7, d = q & 127; const float* NL = (const float*)(c.ws + WSO.nloc) + (size_t)bh * 32 * 128 + d; float* NS = (float*)(c.ws + WSO.nst) + (size_t)bh * 32 * 128 + d; float* MS = (float*)(c.ws + WSO.mst) + bh * 32;
        float n = 0.f, m = 0.f;
        for (int c0 = 0; c0 < 32; c0 += 8) { float nl[8], mlv[8], blv[8];
#pragma unroll
            for (int j = 0; j < 8; ++j) { nl[j] = NL[(c0 + j) * 128]; mlv[j] = ML[(bh * 32 + c0 + j) * 2]; blv[j] = ML[(bh * 32 + c0 + j) * 2 + 1]; }
#pragma unroll
            for (int j = 0; j < 8; ++j) { NS[(c0 + j) * 128] = n; if (d == 0) MS[c0 + j] = m; const float mn = fmaxf(blv[j] + m, mlv[j]); n = n * __expf(blv[j] + m - mn) + nl[j] * __expf(mlv[j] - mn); m = mn; } }
        c.out[OUTO.np + bh * 128 + d] = n; if (d == 0) c.out[OUTO.mp + bh] = m; }
}
}
namespace mx {
#define MX_BAR_LDS() do { asm volatile("s_waitcnt lgkmcnt(0)" ::: "memory"); __builtin_amdgcn_s_barrier(); asm volatile("" ::: "memory"); } while (0)
__device__ __forceinline__ void sample_mlstm(const Ctx& c, int item) {
    const int b = item >> 2, h = item & 3, r0 = 16384 + 4 * b;
    LAS float* SQ = (LAS float*)(c.L); LAS float *SK = SQ + 512, *SV = SQ + 1024, *GS = SQ + 1536  , *QK = SQ + 1600  , *PS = SQ + 1632, *RED = SQ + 2048  ;
    const float* C0 = c.in[nv::I_SC] + (size_t)item * 16384; const float* n0 = c.in[nv::I_SN] + item * 128;
    f32x4 cst[8];
#pragma unroll
    for (int j = 0; j < 8; ++j) cst[j] = __builtin_nontemporal_load((const GAS f32x4*)(C0 + ((c.tid >> 5) * 8 + j) * 128 + 4 * (c.tid & 31)));
    { const int t = c.tid >> 7, d = c.tid & 127; const bf16* zr = c.Z + (size_t)(r0 + t) * ZWD + h * 128 + d; SQ[c.tid] = bf2f(zr[ZQ]); SK[c.tid] = bf2f(zr[ZK]); SV[c.tid] = bf2f(zr[ZV]); }
    if (c.tid == 0) { float ip[4], bb[4], a[4]; const float m0 = c.in[nv::I_SM][item]; float run = 0.f;
#pragma unroll
        for (int t = 0; t < 4; ++t) { ip[t] = c.ZG[(r0 + t) * ZGP + h] + c.in[nv::I_BI][h]; run += lsig(c.ZG[(r0 + t) * ZGP + 4 + h] + c.in[nv::I_BF][h]); bb[t] = run; a[t] = run + m0; }
#pragma unroll
        for (int t = 0; t < 4; ++t) { float mt = a[t];
#pragma unroll
            for (int s = 0; s < 4; ++s) if (s <= t) mt = fmaxf(mt, bb[t] - bb[s] + ip[s]);
            GS[t] = __expf(a[t] - mt); GS[4 + t] = mt;
#pragma unroll
            for (int s = 0; s < 4; ++s) GS[8 + t * 4 + s] = (s <= t) ? __expf(bb[t] - bb[s] + ip[s] - mt) : 0.f; } }
    MX_BAR_LDS();
    {
#pragma unroll
        for (int q = 0; q < 2; ++q) { const int p = 2 * c.wave + q, t = p >> 2, s = p & 3; const float v = wsum(SQ[t * 128 + c.lane] * SK[s * 128 + c.lane] + SQ[t * 128 + 64 + c.lane] * SK[s * 128 + 64 + c.lane]); if (c.lane == 0) QK[p] = v; }
        if (c.wave < 4) { const float v = wsum(SQ[c.wave * 128 + c.lane] * n0[c.lane] + SQ[c.wave * 128 + 64 + c.lane] * n0[64 + c.lane]); if (c.lane == 0) QK[16 + c.wave] = v; } }
    {
        const int v4 = c.tid & 31, dg = c.tid >> 5; const float iL = GS[3]; const float wl0 = GS[8 + 12], wl1 = GS[8 + 13], wl2 = GS[8 + 14], wl3 = GS[8 + 15];
        f32x4 p0 = {0.f, 0.f, 0.f, 0.f}, p1 = p0, p2 = p0, p3 = p0; const f32x4 v0 = *(const LAS f32x4*)(SV + 4 * v4), v1 = *(const LAS f32x4*)(SV + 128 + 4 * v4), v2 = *(const LAS f32x4*)(SV + 256 + 4 * v4), v3 = *(const LAS f32x4*)(SV + 384 + 4 * v4);
        float* Co = c.out + OUTO.cs + (size_t)item * 16384;
#pragma unroll
        for (int j = 0; j < 8; ++j) { const int d = dg * 8 + j; const f32x4 cv = cst[j];
            p0 += cv * SQ[d]; p1 += cv * SQ[128 + d]; p2 += cv * SQ[256 + d]; p3 += cv * SQ[384 + d];
            __builtin_nontemporal_store(cv * iL + v0 * (wl0 * SK[d]) + v1 * (wl1 * SK[128 + d]) + v2 * (wl2 * SK[256 + d]) + v3 * (wl3 * SK[384 + d]), (GAS f32x4*)(Co + d * 128 + 4 * v4)); }
        *(LAS f32x4*)(RED + (dg * 4 + 0) * 128 + 4 * v4) = p0; *(LAS f32x4*)(RED + (dg * 4 + 1) * 128 + 4 * v4) = p1; *(LAS f32x4*)(RED + (dg * 4 + 2) * 128 + 4 * v4) = p2; *(LAS f32x4*)(RED + (dg * 4 + 3) * 128 + 4 * v4) = p3;
        if (c.tid < 128) { const int d = c.tid; c.out[OUTO.ns + item * 128 + d] = iL * n0[d] + wl0 * SK[d] + wl1 * SK[128 + d] + wl2 * SK[256 + d] + wl3 * SK[384 + d]; }
        if (c.tid == 0) c.out[OUTO.ms + item] = GS[7]; }
    MX_BAR_LDS();
    float hval;
    { const int t = c.tid >> 7, v = c.tid & 127; float qc = 0.f;
#pragma unroll
      for (int dg = 0; dg < 16; ++dg) qc += RED[(dg * 4 + t) * 128 + v];
      const float wi = GS[t]; float num = wi * qc, den = wi * QK[16 + t];
#pragma unroll
      for (int s = 0; s < 4; ++s) { const float st = QK[t * 4 + s] * GS[8 + t * 4 + s]; num += st * SV[s * 128 + v]; den += st; }
      hval = num / fmaxf(fabsf(den), __expf(-GS[4 + t]));
      const float ss = wsum(hval * hval); if (c.lane == 0) PS[c.wave] = ss; }
    MX_BAR_LDS();
    { const int t = c.tid >> 7, v = c.tid & 127; const float rs = rsqrtf((PS[2 * t] + PS[2 * t + 1]) * (1.0f / 128.0f) + 1e-6f); const float g = bf2f(c.Z[(size_t)(r0 + t) * ZWD + ZO + h * 128 + v]);
      ((bf16*)(c.ws + WSO.ymix))[(size_t)(r0 + t) * 1024 + h * 128 + v] = (bf16)f2bf(hval * rs * c.in[nv::I_MLOG][h * 128 + v] / (1.f + __expf(-g))); }
    MX_BAR_LDS();
}
__device__ __forceinline__ void sample_gla(const Ctx& c, int item) {
    const int b = item >> 2, h = item & 3, r0 = 16384 + 4 * b;
    LAS float* SQ = (LAS float*)(c.L); LAS float *SKH = SQ + 256  , *SKM = SQ + 512  , *BC = SQ + 768, *SV = SQ + 1024  , *AQ = SQ + 1536, *PS = SQ + 1568, *RED = SQ + 2048  ;
    const float* S0 = c.in[nv::I_SS] + (size_t)item * 8192;
    f32x4 sst[4];
#pragma unroll
    for (int j = 0; j < 4; ++j) sst[j] = __builtin_nontemporal_load((const GAS f32x4*)(S0 + ((c.tid >> 5) * 4 + j) * 128 + 4 * (c.tid & 31)));
    if (c.tid < 256) { const int t = c.tid >> 6, d = c.tid & 63; float a = c.in[nv::I_BA][h * 64 + d];
#pragma unroll
        for (int r = 0; r < 16; ++r) a += c.ZG[(r0 + t) * ZGP + 8 + r] * c.in[nv::I_WA2][r * 256 + h * 64 + d];
        BC[c.tid] = lsig(a) * 0.0625f; }
    { const int t = c.tid >> 7, v = c.tid & 127; SV[c.tid] = bf2f(c.Z[(size_t)(r0 + t) * ZWD + GV + h * 128 + v]); }
    MX_BAR_LDS();
    if (c.tid < 64) { float run = 0.f;
#pragma unroll
        for (int t = 0; t < 4; ++t) { run += BC[t * 64 + c.tid]; BC[t * 64 + c.tid] = run; } }
    MX_BAR_LDS();
    if (c.tid < 256) { const int t = c.tid >> 6, d = c.tid & 63; const bf16* zr = c.Z + (size_t)(r0 + t) * ZWD + h * 64 + d; const float bc = BC[c.tid], bl = BC[192 + d], k = bf2f(zr[GK]);
        SQ[c.tid] = bf2f(zr[GQ]) * __expf(bc); SKH[c.tid] = k * __expf(bl - bc); SKM[c.tid] = k * __expf(-bc); }
    MX_BAR_LDS();
#pragma unroll
    for (int q = 0; q < 2; ++q) { const int p = 2 * c.wave + q, t = p >> 2, s = p & 3; const float v = wsum(SQ[t * 64 + c.lane] * SKM[s * 64 + c.lane]); if (c.lane == 0) AQ[p] = (s <= t) ? v : 0.f; }
    { const int v4 = c.tid & 31, dg = c.tid >> 5; f32x4 p0 = {0.f, 0.f, 0.f, 0.f}, p1 = p0, p2 = p0, p3 = p0;
      const f32x4 v0 = *(const LAS f32x4*)(SV + 4 * v4), v1 = *(const LAS f32x4*)(SV + 128 + 4 * v4), v2 = *(const LAS f32x4*)(SV + 256 + 4 * v4), v3 = *(const LAS f32x4*)(SV + 384 + 4 * v4);
      float* So = c.out + OUTO.ss + (size_t)item * 8192;
#pragma unroll
      for (int j = 0; j < 4; ++j) { const int d = dg * 4 + j; const f32x4 sv = sst[j];
          p0 += sv * SQ[d]; p1 += sv * SQ[64 + d]; p2 += sv * SQ[128 + d]; p3 += sv * SQ[192 + d];
          __builtin_nontemporal_store(sv * __expf(BC[192 + d]) + v0 * SKH[d] + v1 * SKH[64 + d] + v2 * SKH[128 + d] + v3 * SKH[192 + d], (GAS f32x4*)(So + d * 128 + 4 * v4)); }
      *(LAS f32x4*)(RED + (dg * 4 + 0) * 128 + 4 * v4) = p0; *(LAS f32x4*)(RED + (dg * 4 + 1) * 128 + 4 * v4) = p1; *(LAS f32x4*)(RED + (dg * 4 + 2) * 128 + 4 * v4) = p2; *(LAS f32x4*)(RED + (dg * 4 + 3) * 128 + 4 * v4) = p3; }
    MX_BAR_LDS();
    float hval;
    { const int t = c.tid >> 7, v = c.tid & 127; float o = 0.f;
#pragma unroll
      for (int dg = 0; dg < 16; ++dg) o += RED[(dg * 4 + t) * 128 + v];
#pragma unroll
      for (int s = 0; s < 4; ++s) o += AQ[t * 4 + s] * SV[s * 128 + v];
      hval = o; const float ss = wsum(hval * hval); if (c.lane == 0) PS[c.wave] = ss; }
    MX_BAR_LDS();
    { const int t = c.tid >> 7, v = c.tid & 127; const float rs = rsqrtf((PS[2 * t] + PS[2 * t + 1]) * (1.0f / 128.0f) + 1e-6f); const float g = bf2f(c.Z[(size_t)(r0 + t) * ZWD + GG + h * 128 + v]);
      ((bf16*)(c.ws + WSO.ymix))[(size_t)(r0 + t) * 1024 + 512 + h * 128 + v] = (bf16)f2bf(hval * rs * c.in[nv::I_GLOG][h * 128 + v] * g / (1.f + __expf(-g))); }
    MX_BAR_LDS();
}
}
namespace m2 {
using namespace mx;
#define BAR_LDS() do { asm volatile("s_waitcnt lgkmcnt(0)" ::: "memory"); __builtin_amdgcn_s_barrier(); asm volatile("" ::: "memory"); } while (0)
constexpr int WA_OFF = 110592;
constexpr int GN_OFF = 131584;
constexpr int PRIV_OFF = 75776, PRIV_BYTES = 4224, PSQ_OFF = 109568;
__device__ __forceinline__ void load_wa(const Ctx& c) {
    LAS float* WA = (LAS float*)(c.L + WA_OFF);
    for (int i = c.tid; i < 1024; i += 512) *(LAS f32x4*)(WA + 4 * i) = *(const GAS f32x4*)(c.in[nv::I_WA2] + 4 * i);
    if (c.tid < 64) *(LAS f32x4*)(WA + 4096 + 4 * c.tid) = *(const GAS f32x4*)(c.in[nv::I_BA] + 4 * c.tid);
    LAS float* GN = (LAS float*)(c.L + GN_OFF);
    if (c.tid < 128) *(LAS f32x4*)(GN + 4 * c.tid) = *(const GAS f32x4*)(c.in[nv::I_MLOG] + 4 * c.tid); else if (c.tid < 256) *(LAS f32x4*)(GN + 4 * c.tid) = *(const GAS f32x4*)(c.in[nv::I_GLOG] + 4 * (c.tid - 128));
    else if (c.tid < 260) GN[1024 + (c.tid - 256)] = c.in[nv::I_BI][c.tid - 256]; else if (c.tid < 264) GN[1028 + (c.tid - 260)] = c.in[nv::I_BF][c.tid - 260];
    BAR_LDS();
}
struct Item { int b, h, ch, r0; };
__device__ __forceinline__ Item decode(int item) { Item it; const int bh = item >> 5; it.ch = item & 31; it.b = bh >> 2; it.h = bh & 3; it.r0 = it.b * 2048 + it.ch * 64; return it; }
struct LmRegs { float zi, zf; u32x4 k[2], v[2]; };
__device__ __forceinline__ void lm_load(LmRegs& R, const Ctx& c, int item) { const Item it = decode(item);
    R.zi = c.ZG[(size_t)(it.r0 + c.lane) * ZGP + it.h]; R.zf = c.ZG[(size_t)(it.r0 + c.lane) * ZGP + 4 + it.h];
#pragma unroll
    for (int j = 0; j < 2; ++j) { const int id = c.tid + 512 * j, s = id >> 4, cc = id & 15; const bf16* zr = c.Z + (size_t)(it.r0 + s) * ZWD + it.h * 128 + cc * 8; R.k[j] = *(const GAS u32x4*)(zr + ZK); R.v[j] = *(const GAS u32x4*)(zr + ZV); } }
__device__ __forceinline__ void lm_stage(const LmRegs& R, const Ctx& c, int item, ldsp Ks, ldsp Vs) { const Item it = decode(item);
    const LAS float* GB = (const LAS float*)(c.L + GN_OFF) + 1024; const float ip = R.zi + GB[it.h], lf = lsig(R.zf + GB[4 + it.h]); const float bc = wscan_add(lf, c.lane), bL = wlast(bc), g = bL - bc + ip, ml = wmax(g), w = __expf(g - ml);
    if (c.tid == 0) { float* M = (float*)(c.ws + WSO.mloc); M[item * 2] = ml; M[item * 2 + 1] = bL; }
#pragma unroll
    for (int j = 0; j < 2; ++j) { const int id = c.tid + 512 * j, s = id >> 4, cc = id & 15; const float wv = shl(w, s); *(LAS u32x4*)(Ks + s * KP + cc * 16) = R.k[j]; u32x4 o;
#pragma unroll
        for (int q = 0; q < 4; ++q) o[q] = pkbf(bf2f((unsigned short)(R.v[j][q] & 0xffffu)) * wv, bf2f((unsigned short)(R.v[j][q] >> 16)) * wv);
        *(LAS u32x4*)(Vs + s * VP + cc * 16) = o; }
    { const int s = (c.tid >> 1) & 63; const float wv = shl(w, s); if (c.tid < 128) { u32x4 o = {0u, 0u, 0u, 0u}; if ((c.tid & 1) == 0) o[0] = pkbf(wv, 0.f); *(LAS u32x4*)(Vs + s * VP + 256 + (c.tid & 1) * 16) = o; } } }
__device__ __forceinline__ void lm_compute(const Ctx& c, int item, ldsp Ks, ldsp Vs) {
    const int d0 = 16 * c.wave; const bf16x8 b0 = frag_tr(Ks, KP, 0, d0, c.lane), b1 = frag_tr(Ks, KP, 32, d0, c.lane);
    bf16* CL = (bf16*)(c.ws + WSO.cloc) + (size_t)item * 16384; float* NL = (float*)(c.ws + WSO.nloc) + (size_t)item * 128;
#pragma unroll
    for (int vt = 0; vt < 9; ++vt) { f32x4 acc = {0.f, 0.f, 0.f, 0.f}; acc = mma(frag_tr(Vs, VP, 0, 16 * vt, c.lane), b0, acc); acc = mma(frag_tr(Vs, VP, 32, 16 * vt, c.lane), b1, acc);
        if (vt < 8) { u32x2 o; o[0] = pkbf(acc[0], acc[1]); o[1] = pkbf(acc[2], acc[3]); *(GAS u32x2*)(CL + (d0 + (c.lane & 15)) * 128 + 16 * vt + 4 * (c.lane >> 4)) = o; }
        else if ((c.lane >> 4) == 0) NL[d0 + (c.lane & 15)] = acc[0]; } }
__device__ __forceinline__ void run_local_mlstm(const Ctx& c, int cu, int G) {
    int item = cu; LmRegs R; if (item < NITEM) lm_load(R, c, item); int set = 0;
    for (; item < NITEM; item += G) { ldsp Ks = c.L + set * 36864, Vs = Ks + 17408; lm_stage(R, c, item, Ks, Vs); if (item + G < NITEM) lm_load(R, c, item + G); BAR_LDS(); lm_compute(c, item, Ks, Vs); set ^= 1; }
    BAR_LDS(); }
__device__ __forceinline__ void gla_bc_wave(const Ctx& c, const f32x4 (&ga)[4], int h, float (&bc)[8]) {
    const LAS float* WA = (const LAS float*)(c.L + WA_OFF) + h * 64 + c.wave * 8; const LAS float* BA = (const LAS float*)(c.L + WA_OFF) + 4096 + h * 64 + c.wave * 8;
#pragma unroll
    for (int j = 0; j < 8; ++j) { float a = BA[j];
#pragma unroll
        for (int q = 0; q < 4; ++q) { a += ga[q][0] * WA[(4 * q) * 256 + j]; a += ga[q][1] * WA[(4 * q + 1) * 256 + j]; a += ga[q][2] * WA[(4 * q + 2) * 256 + j]; a += ga[q][3] * WA[(4 * q + 3) * 256 + j]; }
        bc[j] = wscan_add(lsig(a) * 0.0625f, c.lane); } }
struct LgRegs { f32x4 ga[4]; u32x4 k; u32x4 v[2]; };
__device__ __forceinline__ void lg_load(LgRegs& R, const Ctx& c, int item) { const Item it = decode(item);
#pragma unroll
    for (int q = 0; q < 4; ++q) R.ga[q] = *(const GAS f32x4*)(c.ZG + (size_t)(it.r0 + c.lane) * ZGP + 8 + 4 * q);
    R.k = *(const GAS u32x4*)(c.Z + (size_t)(it.r0 + c.lane) * ZWD + GK + it.h * 64 + c.wave * 8);
#pragma unroll
    for (int j = 0; j < 2; ++j) { const int id = c.tid + 512 * j, s = id >> 4, cc = id & 15; R.v[j] = *(const GAS u32x4*)(c.Z + (size_t)(it.r0 + s) * ZWD + GV + it.h * 128 + cc * 8); } }
__device__ __forceinline__ void lg_stage(const LgRegs& R, const Ctx& c, int item, ldsp Gk, ldsp Gv) { const Item it = decode(item); float bc[8]; gla_bc_wave(c, R.ga, it.h, bc); u32x4 o;
#pragma unroll
    for (int q = 0; q < 4; ++q) { const float bl0 = wlast(bc[2 * q]), bl1 = wlast(bc[2 * q + 1]);
        o[q] = pkbf(bf2f((unsigned short)(R.k[q] & 0xffffu)) * __expf(bl0 - bc[2 * q]), bf2f((unsigned short)(R.k[q] >> 16)) * __expf(bl1 - bc[2 * q + 1]));
        if (c.lane == 63) { float* GD = (float*)(c.ws + WSO.gdec) + item * 64 + c.wave * 8 + 2 * q; GD[0] = __expf(bl0); GD[1] = __expf(bl1); } }
    *(LAS u32x4*)(Gk + c.lane * GP + c.wave * 16) = o;
#pragma unroll
    for (int j = 0; j < 2; ++j) { const int id = c.tid + 512 * j, s = id >> 4, cc = id & 15; *(LAS u32x4*)(Gv + s * KP + cc * 16) = R.v[j]; } }
__device__ __forceinline__ void lg_compute(const Ctx& c, int item, ldsp Gk, ldsp Gv) {
    const int d0 = 16 * (c.wave & 3), vt0 = (c.wave >> 2) * 4; const bf16x8 b0 = frag_tr(Gk, GP, 0, d0, c.lane), b1 = frag_tr(Gk, GP, 32, d0, c.lane); bf16* SL = (bf16*)(c.ws + WSO.sloc) + (size_t)item * 8192;
#pragma unroll
    for (int q = 0; q < 4; ++q) { const int vt = vt0 + q; f32x4 acc = {0.f, 0.f, 0.f, 0.f}; acc = mma(frag_tr(Gv, KP, 0, 16 * vt, c.lane), b0, acc); acc = mma(frag_tr(Gv, KP, 32, 16 * vt, c.lane), b1, acc);
        u32x2 o; o[0] = pkbf(acc[0], acc[1]); o[1] = pkbf(acc[2], acc[3]); *(GAS u32x2*)(SL + (d0 + (c.lane & 15)) * 128 + 16 * vt + 4 * (c.lane >> 4)) = o; } }
__device__ __forceinline__ void run_local_gla(const Ctx& c, int cu, int G) {
    int item = cu; LgRegs R; if (item < NITEM) lg_load(R, c, item); int set = 0;
    for (; item < NITEM; item += G) { ldsp Gk = c.L + set * 26624, Gv = Gk + 9216; lg_stage(R, c, item, Gk, Gv); if (item + G < NITEM) lg_load(R, c, item + G); BAR_LDS(); lg_compute(c, item, Gk, Gv); set ^= 1; }
    BAR_LDS(); }
template <bool ML> __device__ __forceinline__ void tail_out(const Ctx& c, const LAS float* Hp, int r0, int h, int tt, int vh, u32x4 g0, u32x4 g1) {
    LAS float* PSQ = (LAS float*)(c.L + PSQ_OFF); const int t = c.lane >> 2, c0 = (c.lane & 3) * 16; float hv[16]; float ss = 0.f;
#pragma unroll
    for (int j = 0; j < 16; ++j) { hv[j] = Hp[t * 66 + c0 + j]; ss += hv[j] * hv[j]; }
    ss += shx(ss, 1); ss += shx(ss, 2); if ((c.lane & 3) == 0) PSQ[c.wave * 16 + t] = ss;
    const int row = r0 + 16 * tt + t, col = h * 128 + 64 * vh + c0;
    const LAS float* gn = (const LAS float*)(c.L + GN_OFF) + (ML ? 0 : 512) + col; const f32x4 n0 = *(const LAS f32x4*)gn, n1 = *(const LAS f32x4*)(gn + 4), n2 = *(const LAS f32x4*)(gn + 8), n3 = *(const LAS f32x4*)(gn + 12);
    const float gnv[16] = {n0[0], n0[1], n0[2], n0[3], n1[0], n1[1], n1[2], n1[3], n2[0], n2[1], n2[2], n2[3], n3[0], n3[1], n3[2], n3[3]};
    BAR_LDS();
    const float rs = rsqrtf((PSQ[c.wave * 16 + t] + PSQ[(c.wave ^ 4) * 16 + t]) * (1.0f / 128.0f) + 1e-6f);
    bf16* yo = (bf16*)(c.ws + WSO.ymix) + (size_t)row * 1024 + (ML ? 0 : 512) + col; u32x4 o[2];
#pragma unroll
    for (int q = 0; q < 2; ++q)
#pragma unroll
        for (int j = 0; j < 4; ++j) { const unsigned gw = q ? g1[j] : g0[j]; const float ga = bf2f((unsigned short)(gw & 0xffffu)), gb = bf2f((unsigned short)(gw >> 16));
            const float a0 = ML ? 1.f / (1.f + __expf(-ga)) : ga / (1.f + __expf(-ga)), a1 = ML ? 1.f / (1.f + __expf(-gb)) : gb / (1.f + __expf(-gb));
            o[q][j] = pkbf(a0 * hv[8 * q + 2 * j] * rs * gnv[8 * q + 2 * j], a1 * hv[8 * q + 2 * j + 1] * rs * gnv[8 * q + 2 * j + 1]); }
    *(GAS u32x4*)yo = o[0]; *(GAS u32x4*)(yo + 8) = o[1];
}
template <bool ML> __device__ __forceinline__ void gate_load(u32x4 (&gt)[2], const Ctx& c, const Item& it) { const int tt = c.wave & 3, vh = c.wave >> 2, t = c.lane >> 2, c0 = (c.lane & 3) * 16;
    const bf16* gp = c.Z + (size_t)(it.r0 + 16 * tt + t) * ZWD + (ML ? ZO : GG) + it.h * 128 + 64 * vh + c0; gt[0] = *(const GAS u32x4*)gp; gt[1] = *(const GAS u32x4*)(gp + 8); }
struct OmRegs { float zi, zf, mprev, nst; bf16x8 q[4]; u32x4 k[2], v[2], cc[4], gt[2]; };
__device__ __forceinline__ void om_load(OmRegs& R, const Ctx& c, int item) { const Item it = decode(item);
    R.zi = c.ZG[(size_t)(it.r0 + c.lane) * ZGP + it.h]; R.zf = c.ZG[(size_t)(it.r0 + c.lane) * ZGP + 4 + it.h]; R.mprev = ((const float*)(c.ws + WSO.mst))[item]; R.nst = ((const float*)(c.ws + WSO.nst))[item * 128 + (c.tid & 127)];
    const bf16* zr = c.Z + (size_t)it.r0 * ZWD + it.h * 128;
#pragma unroll
    for (int ks = 0; ks < 4; ++ks) R.q[ks] = *(const GAS bf16x8*)(zr + (size_t)(16 * (c.wave & 3) + (c.lane & 15)) * ZWD + ZQ + 32 * ks + 8 * (c.lane >> 4));
#pragma unroll
    for (int j = 0; j < 2; ++j) { const int id = c.tid + 512 * j, s = id >> 4, cc = id & 15; R.k[j] = *(const GAS u32x4*)(zr + (size_t)s * ZWD + ZK + cc * 8); R.v[j] = *(const GAS u32x4*)(zr + (size_t)s * ZWD + ZV + cc * 8); }
    gate_load<true>(R.gt, c, it);
    const bf16* cs = (const bf16*)(c.ws + WSO.cst) + (size_t)item * 16384;
#pragma unroll
    for (int j = 0; j < 4; ++j) { const int id = c.tid + 512 * j; R.cc[j] = __builtin_nontemporal_load((const GAS u32x4*)(cs + id * 8)); } }
__device__ __forceinline__ void om_stage(const OmRegs& R, const Ctx& c, ldsp Ks, ldsp Vs, ldsp Cs) {
#pragma unroll
    for (int j = 0; j < 2; ++j) { const int id = c.tid + 512 * j, s = id >> 4, cc = id & 15; *(LAS u32x4*)(Ks + s * KP + cc * 16) = R.k[j]; *(LAS u32x4*)(Vs + s * VP + cc * 16) = R.v[j]; }
#pragma unroll
    for (int j = 0; j < 4; ++j) { const int id = c.tid + 512 * j, d = id >> 4, cc = id & 15; *(LAS u32x4*)(Cs + d * VP + cc * 16) = R.cc[j]; }
    if (c.tid < 128) { const int s = c.tid >> 1; unsigned zz = 0u; asm volatile("" : "+v"(zz));
        u32x4 o = {zz, zz, zz, zz}; if ((c.tid & 1) == 0) o[0] = zz + 0x3f80u; *(LAS u32x4*)(Vs + s * VP + 256 + (c.tid & 1) * 16) = o;
        u32x4 o2 = {pkbf(R.nst, 0.f), zz, zz, zz}; *(LAS u32x4*)(Cs + c.tid * VP + 256) = o2; u32x4 z = {zz, zz, zz, zz}; *(LAS u32x4*)(Cs + c.tid * VP + 272) = z; } }
__device__ __forceinline__ void om_compute(const OmRegs& R, const Ctx& c, int item, ldsp Ks, ldsp Vs, ldsp Cs) { const Item it = decode(item);
    const int tt = c.wave & 3, vh = c.wave >> 2, g = c.lane >> 4, li = c.lane & 15; ldsp Sp = c.L + PRIV_OFF + c.wave * PRIV_BYTES; LAS float* Hp = (LAS float*)Sp;
    const LAS float* GB = (const LAS float*)(c.L + GN_OFF) + 1024; const float ip = R.zi + GB[it.h], lf = lsig(R.zf + GB[4 + it.h]); const float bc = wscan_add(lf, c.lane), a = bc + R.mprev, u = ip - bc, pm = wscan_max(u, c.lane), mt = fmaxf(a, bc + pm), rt = bc - mt, wi = __expf(a - mt), emt = __expf(-mt);
    float rtv[4], wiv[4], emv[4];
#pragma unroll
    for (int r = 0; r < 4; ++r) { const int t = 16 * tt + 4 * g + r; rtv[r] = shl(rt, t); wiv[r] = shl(wi, t); emv[r] = shl(emt, t); }
#pragma unroll
    for (int st = 0; st < 4; ++st) { const float us = shl(u, 16 * st + li); f32x4 acc = {0.f, 0.f, 0.f, 0.f};
        if (st <= tt) {
#pragma unroll
            for (int ks = 0; ks < 4; ++ks) acc = mma(R.q[ks], frag_row(Ks, KP, 16 * st, 32 * ks, c.lane), acc); }
#pragma unroll
        for (int r = 0; r < 4; ++r) { const int t = 16 * tt + 4 * g + r, s = 16 * st + li; const float v = (s <= t) ? acc[r] * __expf(rtv[r] + us) : 0.f; *(LAS unsigned short*)(Sp + (4 * g + r) * GP + s * 2) = (unsigned short)f2bf(v); } }
    LDS_WAIT();
    const bf16x8 s0 = frag_row(Sp, GP, 0, 0, c.lane), s1 = frag_row(Sp, GP, 0, 32, c.lane);
    f32x4 hv[5];
#pragma unroll
    for (int q = 0; q < 5; ++q) { const int vt = q < 4 ? 4 * vh + q : 8; f32x4 a1 = {0.f, 0.f, 0.f, 0.f}, a2 = {0.f, 0.f, 0.f, 0.f};
        a1 = mma(s0, frag_tr(Vs, VP, 0, 16 * vt, c.lane), a1); a1 = mma(s1, frag_tr(Vs, VP, 32, 16 * vt, c.lane), a1);
#pragma unroll
        for (int ks = 0; ks < 4; ++ks) a2 = mma(R.q[ks], frag_tr(Cs, VP, 32 * ks, 16 * vt, c.lane), a2);
#pragma unroll
        for (int r = 0; r < 4; ++r) hv[q][r] = a1[r] + wiv[r] * a2[r]; }
    LDS_WAIT();
#pragma unroll
    for (int r = 0; r < 4; ++r) { const float den = shl(hv[4][r], 16 * g); const float sc = 1.f / fmaxf(fabsf(den), emv[r]);
#pragma unroll
        for (int q = 0; q < 4; ++q) Hp[(4 * g + r) * 66 + 16 * q + li] = hv[q][r] * sc; }
    LDS_WAIT();
    tail_out<true>(c, Hp, it.r0, it.h, tt, vh, R.gt[0], R.gt[1]);
}
__device__ __forceinline__ void run_out_mlstm(const Ctx& c, int cu, int G) {
    int item = cu; OmRegs R; if (item < NITEM) om_load(R, c, item); ldsp Ks = c.L, Vs = c.L + 17408, Cs = c.L + 36864;
    for (; item < NITEM; item += G) { BAR_LDS(); om_stage(R, c, Ks, Vs, Cs); OmRegs R2 = R; if (item + G < NITEM) om_load(R, c, item + G); BAR_LDS(); om_compute(R2, c, item, Ks, Vs, Cs); }
    BAR_LDS(); }
struct OgRegs { f32x4 ga[4]; u32x4 q, k; u32x4 v[2], s[2], gt[2]; };
__device__ __forceinline__ void og_load(OgRegs& R, const Ctx& c, int item) { const Item it = decode(item);
#pragma unroll
    for (int q = 0; q < 4; ++q) R.ga[q] = *(const GAS f32x4*)(c.ZG + (size_t)(it.r0 + c.lane) * ZGP + 8 + 4 * q);
    const bf16* zr = c.Z + (size_t)(it.r0 + c.lane) * ZWD + it.h * 64 + c.wave * 8; R.q = *(const GAS u32x4*)(zr + GQ); R.k = *(const GAS u32x4*)(zr + GK);
    gate_load<false>(R.gt, c, it);
    const bf16* ss = (const bf16*)(c.ws + WSO.sst) + (size_t)item * 8192;
#pragma unroll
    for (int j = 0; j < 2; ++j) { const int id = c.tid + 512 * j, s = id >> 4, cc = id & 15; R.v[j] = *(const GAS u32x4*)(c.Z + (size_t)(it.r0 + s) * ZWD + GV + it.h * 128 + cc * 8); R.s[j] = __builtin_nontemporal_load((const GAS u32x4*)(ss + id * 8)); } }
__device__ __forceinline__ void og_stage(const OgRegs& R, const Ctx& c, int item, ldsp Gq, ldsp Gk, ldsp Gv, ldsp Gs) { const Item it = decode(item); float bc[8]; gla_bc_wave(c, R.ga, it.h, bc); u32x4 oq, ok;
#pragma unroll
    for (int q = 0; q < 4; ++q) { const float e0 = bc[2 * q], e1 = bc[2 * q + 1];
        oq[q] = pkbf(bf2f((unsigned short)(R.q[q] & 0xffffu)) * __expf(e0), bf2f((unsigned short)(R.q[q] >> 16)) * __expf(e1));
        ok[q] = pkbf(bf2f((unsigned short)(R.k[q] & 0xffffu)) * __expf(-e0), bf2f((unsigned short)(R.k[q] >> 16)) * __expf(-e1)); }
    *(LAS u32x4*)(Gq + c.lane * GP + c.wave * 16) = oq; *(LAS u32x4*)(Gk + c.lane * GP + c.wave * 16) = ok;
#pragma unroll
    for (int j = 0; j < 2; ++j) { const int id = c.tid + 512 * j, s = id >> 4, cc = id & 15; *(LAS u32x4*)(Gv + s * KP + cc * 16) = R.v[j]; *(LAS u32x4*)(Gs + s * KP + cc * 16) = R.s[j]; } }
__device__ __forceinline__ void og_compute(const Ctx& c, int item, ldsp Gq, ldsp Gk, ldsp Gv, ldsp Gs, u32x4 g0, u32x4 g1) { const Item it = decode(item);
    const int tt = c.wave & 3, vh = c.wave >> 2, g = c.lane >> 4, li = c.lane & 15; ldsp Ap = c.L + PRIV_OFF + c.wave * PRIV_BYTES; LAS float* Hp = (LAS float*)Ap;
    const bf16x8 q0 = frag_row(Gq, GP, 16 * tt, 0, c.lane), q1 = frag_row(Gq, GP, 16 * tt, 32, c.lane);
#pragma unroll
    for (int st = 0; st < 4; ++st) { f32x4 acc = {0.f, 0.f, 0.f, 0.f};
        if (st <= tt) { acc = mma(q0, frag_row(Gk, GP, 16 * st, 0, c.lane), acc); acc = mma(q1, frag_row(Gk, GP, 16 * st, 32, c.lane), acc); }
#pragma unroll
        for (int r = 0; r < 4; ++r) { const int t = 16 * tt + 4 * g + r, s = 16 * st + li; *(LAS unsigned short*)(Ap + (4 * g + r) * GP + s * 2) = (unsigned short)f2bf((s <= t) ? acc[r] : 0.f); } }
    LDS_WAIT();
    const bf16x8 a0 = frag_row(Ap, GP, 0, 0, c.lane), a1 = frag_row(Ap, GP, 0, 32, c.lane); f32x4 hv[4];
#pragma unroll
    for (int q = 0; q < 4; ++q) { const int vt = 4 * vh + q; f32x4 acc = {0.f, 0.f, 0.f, 0.f};
        acc = mma(a0, frag_tr(Gv, KP, 0, 16 * vt, c.lane), acc); acc = mma(a1, frag_tr(Gv, KP, 32, 16 * vt, c.lane), acc);
        acc = mma(q0, frag_tr(Gs, KP, 0, 16 * vt, c.lane), acc); acc = mma(q1, frag_tr(Gs, KP, 32, 16 * vt, c.lane), acc); hv[q] = acc; }
    LDS_WAIT();
#pragma unroll
    for (int q = 0; q < 4; ++q)
#pragma unroll
        for (int r = 0; r < 4; ++r) Hp[(4 * g + r) * 66 + 16 * q + li] = hv[q][r];
    LDS_WAIT();
    tail_out<false>(c, Hp, it.r0, it.h, tt, vh, g0, g1);
}
__device__ __forceinline__ void run_out_gla(const Ctx& c, int cu, int G) {
    int item = cu; OgRegs R; if (item < NITEM) og_load(R, c, item); ldsp Gq = c.L, Gk = c.L + 9216, Gv = c.L + 18432, Gs = c.L + 35840;
    for (; item < NITEM; item += G) { BAR_LDS(); og_stage(R, c, item, Gq, Gk, Gv, Gs); const u32x4 g0 = R.gt[0], g1 = R.gt[1]; if (item + G < NITEM) og_load(R, c, item + G); BAR_LDS(); og_compute(c, item, Gq, Gk, Gv, Gs, g0, g1); }
    BAR_LDS(); }
__device__ __forceinline__ void phase_local(const Ctx& c, int cu, int G) {
    load_wa(c);
    if (cu & 1) { run_local_mlstm(c, cu, G); run_local_gla(c, cu, G); }
    for (int it = cu; it < 512; it += G) sample_mlstm(c, it);
    for (int it = cu; it < 512; it += G) sample_gla(c, it);
    if (!(cu & 1)) { BAR_LDS(); run_local_mlstm(c, cu, G); run_local_gla(c, cu, G); }
}
__device__ __forceinline__ void phase_out(const Ctx& c, int cu, int G) { load_wa(c); run_out_mlstm(c, cu, G); run_out_gla(c, cu, G);
#ifdef MK_X2_OM
    run_out_mlstm(c, cu, G);
#endif
#ifdef MK_X2_OG
    run_out_gla(c, cu, G);
#endif
}
}
#undef BAR_LDS
namespace xa {
using mx::bf16x8; using mx::f32x4; using mx::u32x4; using mx::u32x2; using mx::ldsp; using mx::mma; using mx::frag_row; using mx::frag_tr; using mx::bf2f;
#define BAR_LDS() do { asm volatile("s_waitcnt lgkmcnt(0)" ::: "memory"); __builtin_amdgcn_s_barrier(); asm volatile("" ::: "memory"); } while (0)
constexpr int CP = 528;
constexpr int CB_BYTES = 64 * CP;
constexpr int SC_OFF = 2 * CB_BYTES, PL_OFF = SC_OFF + 4096, PLP = 528;
__device__ __forceinline__ void pa_load(u32x4 (&pre)[4], const mx::Ctx& c, int item, int i, int tid) {
    const int b = item >> 5, h = (item >> 3) & 3; const bf16* p; int pitch;
    if (i < 4) { p = (const bf16*)(c.ws + WSO.kb) + (size_t)(b * 256 + 64 * i) * 1024 + h * 256; pitch = 1024; } else { p = (const bf16*)(c.ws + WSO.vt) + (size_t)((b * 4 + h) * 256 + 64 * (i - 4)) * 256; pitch = 256; }
#pragma unroll
    for (int j = 0; j < 4; ++j) { const int id = tid + 512 * j, s = id >> 5, ch = id & 31; pre[j] = *(const GAS u32x4*)(p + (size_t)s * pitch + ch * 8); }
}
__device__ __forceinline__ void pa_store(ldsp buf, const u32x4 (&pre)[4], int tid) {
#pragma unroll
    for (int j = 0; j < 4; ++j) { const int id = tid + 512 * j, s = id >> 5, ch = id & 31; *(LAS u32x4*)(buf + s * CP + ch * 16) = pre[j]; }
}
__device__ __forceinline__ void prompt_stream(const mx::Ctx& c, int cu, int G) {
    ldsp B0 = c.L, B1 = c.L + CB_BYTES; int item = cu; if (item >= 256) return;
    u32x4 pre[4]; pa_load(pre, c, item, 0, c.tid); pa_store(B0, pre, c.tid); BAR_LDS();
    const bf16* Q = (const bf16*)(c.ws + WSO.q); bf16* O = (bf16*)(c.ws + WSO.o); const int g = c.lane >> 4, li = c.lane & 15;
    for (; item < 256; item += G) {
        const int b = item >> 5, h = (item >> 3) & 3, qb = item & 7, row0 = b * 2048 + qb * 256 + c.wave * 32, nxt = item + G;
        bf16x8 qf[2][8];
#pragma unroll
        for (int mt = 0; mt < 2; ++mt)
#pragma unroll
            for (int ks = 0; ks < 8; ++ks) qf[mt][ks] = __builtin_nontemporal_load((const GAS bf16x8*)(Q + (size_t)(row0 + 16 * mt + li) * 1024 + h * 256 + 32 * ks + 8 * g));
        f32x4 sc[2][16]; u32x4 pf[2][8]; float rinv[2] = {0.f, 0.f};
#pragma unroll
        for (int i = 0; i < 8; ++i) {
            ldsp cur = (i & 1) ? B1 : B0; ldsp oth = (i & 1) ? B0 : B1; const bool have_next = (i < 7) || (nxt < 256);
            if (have_next) pa_load(pre, c, i < 7 ? item : nxt, i < 7 ? i + 1 : 0, c.tid);
            if (i < 4) {
#pragma unroll
                for (int nt = 0; nt < 4; ++nt) { f32x4 a0 = {0.f, 0.f, 0.f, 0.f}, a1 = {0.f, 0.f, 0.f, 0.f};
#pragma unroll
                    for (int ks = 0; ks < 8; ++ks) { const bf16x8 kf = frag_row(cur, CP, 16 * nt, 32 * ks, c.lane); a0 = mma(kf, qf[0][ks], a0); a1 = mma(kf, qf[1][ks], a1); }
                    sc[0][i * 4 + nt] = a0; sc[1][i * 4 + nt] = a1; }
                if (i == 3) {
#pragma unroll
                    for (int mt = 0; mt < 2; ++mt) { float m = sc[mt][0][0];
#pragma unroll
                        for (int tl = 0; tl < 16; ++tl)
#pragma unroll
                            for (int r = 0; r < 4; ++r) m = fmaxf(m, sc[mt][tl][r]);
                        m = fmaxf(m, shx(m, 16)); m = fmaxf(m, shx(m, 32)); float s = 0.f;
#pragma unroll
                        for (int tl = 0; tl < 16; ++tl)
#pragma unroll
                            for (int r = 0; r < 4; ++r) { sc[mt][tl][r] = __expf(sc[mt][tl][r] - m); s += sc[mt][tl][r]; }
                        s += shx(s, 16); s += shx(s, 32); rinv[mt] = 1.f / s;
#pragma unroll
                        for (int ks = 0; ks < 8; ++ks) { pf[mt][ks][0] = pk2(sc[mt][2 * ks][0], sc[mt][2 * ks][1]); pf[mt][ks][1] = pk2(sc[mt][2 * ks][2], sc[mt][2 * ks][3]); pf[mt][ks][2] = pk2(sc[mt][2 * ks + 1][0], sc[mt][2 * ks + 1][1]); pf[mt][ks][3] = pk2(sc[mt][2 * ks + 1][2], sc[mt][2 * ks + 1][3]); } }
                }
            } else {
                const int dc = i - 4;
#pragma unroll
                for (int nt = 0; nt < 4; ++nt) { f32x4 a0 = {0.f, 0.f, 0.f, 0.f}, a1 = {0.f, 0.f, 0.f, 0.f}; ldsp ar = cur + (16 * nt + li) * CP + 8 * g;
#pragma unroll
                    for (int ks = 0; ks < 8; ++ks) { const u32x2 lo = *(const LAS u32x2*)(ar + 64 * ks), hi = *(const LAS u32x2*)(ar + 64 * ks + 32); const u32x4 av = {lo[0], lo[1], hi[0], hi[1]};
                        a0 = mma(__builtin_bit_cast(bf16x8, av), __builtin_bit_cast(bf16x8, pf[0][ks]), a0); a1 = mma(__builtin_bit_cast(bf16x8, av), __builtin_bit_cast(bf16x8, pf[1][ks]), a1); }
                    u32x2 o; o[0] = pk2(a0[0] * rinv[0], a0[1] * rinv[0]); o[1] = pk2(a0[2] * rinv[0], a0[3] * rinv[0]);
                    *(GAS u32x2*)(O + (size_t)(row0 + li) * 1024 + h * 256 + 64 * dc + 16 * nt + 4 * g) = o;
                    o[0] = pk2(a1[0] * rinv[1], a1[1] * rinv[1]); o[1] = pk2(a1[2] * rinv[1], a1[3] * rinv[1]);
                    *(GAS u32x2*)(O + (size_t)(row0 + 16 + li) * 1024 + h * 256 + 64 * dc + 16 * nt + 4 * g) = o; }
            }
            if (have_next) pa_store(oth, pre, c.tid);
            BAR_LDS();
        }
    }
}
__device__ __forceinline__ void sa_load(f32x4 (&pre)[8], const mx::Ctx& c, int item, int i, int tid) {
    const int b = item >> 2, h = item & 3; const float* p = (i < 4 ? c.in[nv::I_CK] : c.in[nv::I_CV]) + ((size_t)(b * 256 + 64 * (i & 3)) * 4 + h) * 256;
#pragma unroll
    for (int j = 0; j < 8; ++j) { const int id = tid + 512 * j, key = id >> 6, c4 = id & 63; pre[j] = __builtin_nontemporal_load((const GAS f32x4*)(p + (size_t)key * 1024 + 4 * c4)); }
}
__device__ __forceinline__ void sa_store(ldsp buf, const f32x4 (&pre)[8], int tid) {
#pragma unroll
    for (int j = 0; j < 8; ++j) { const int id = tid + 512 * j, key = id >> 6, c4 = id & 63; u32x2 o; o[0] = pk2(pre[j][0], pre[j][1]); o[1] = pk2(pre[j][2], pre[j][3]); *(LAS u32x2*)(buf + key * CP + c4 * 8) = o; }
}
__device__ __forceinline__ void sample_stream(const mx::Ctx& c, int cu, int G) {
    ldsp B0 = c.L, B1 = c.L + CB_BYTES; LAS float* SCs = (LAS float*)(c.L + SC_OFF); ldsp Pl = c.L + PL_OFF; int item = cu; if (item >= 512) return;
    for (int i = c.tid; i < 16 * PLP / 4; i += 512) ((LAS unsigned*)Pl)[i] = 0u;
    f32x4 preA[8], preB[8];
    sa_load(preA, c, item, 0, c.tid); sa_load(preB, c, item, 1, c.tid); sa_store(B0, preA, c.tid); BAR_LDS();
    const bf16* Q = (const bf16*)(c.ws + WSO.q); bf16* O = (bf16*)(c.ws + WSO.o); const int g = c.lane >> 4, li = c.lane & 15;
    for (; item < 512; item += G) {
        const int b = item >> 2, h = item & 3, r0 = 16384 + 4 * b, nxt = item + G;
        bf16x8 qf[8];
#pragma unroll
        for (int ks = 0; ks < 8; ++ks) { u32x4 v = {0u, 0u, 0u, 0u}; if (li < 4) v = *(const GAS u32x4*)(Q + (size_t)(r0 + li) * 1024 + h * 256 + 32 * ks + 8 * g); qf[ks] = __builtin_bit_cast(bf16x8, v); }
        f32x4 oacc[2] = {{0.f, 0.f, 0.f, 0.f}, {0.f, 0.f, 0.f, 0.f}};
#pragma unroll
        for (int i = 0; i < 8; ++i) {
            ldsp cur = (i & 1) ? B1 : B0; ldsp oth = (i & 1) ? B0 : B1;
            const bool have1 = (i < 7) || (nxt < 512), have2 = (i < 6) || (nxt < 512);
            if (have2) { if (i & 1) sa_load(preB, c, i < 6 ? item : nxt, i < 6 ? i + 2 : i - 6, c.tid); else sa_load(preA, c, i < 6 ? item : nxt, i < 6 ? i + 2 : i - 6, c.tid); }
            if (i < 4) {
                if (c.wave < 4) { f32x4 acc = {0.f, 0.f, 0.f, 0.f};
#pragma unroll
                    for (int ks = 0; ks < 8; ++ks) acc = mma(frag_row(cur, CP, 16 * c.wave, 32 * ks, c.lane), qf[ks], acc);
                    if (li < 4) *(LAS f32x4*)(SCs + li * 256 + 64 * i + 16 * c.wave + 4 * g) = acc; }
            } else {
                if (i == 4) {
                    if (c.wave < 4) { const f32x4 s = *(const LAS f32x4*)(SCs + c.wave * 256 + 4 * c.lane); const float m = mx::wmax(fmaxf(fmaxf(s[0], s[1]), fmaxf(s[2], s[3])));
                        const float p0 = __expf(s[0] - m), p1 = __expf(s[1] - m), p2 = __expf(s[2] - m), p3 = __expf(s[3] - m); const float inv = 1.f / mx::wsum((p0 + p1) + (p2 + p3));
                        u32x2 o; o[0] = pk2(p0 * inv, p1 * inv); o[1] = pk2(p2 * inv, p3 * inv); *(LAS u32x2*)(Pl + c.wave * PLP + c.lane * 8) = o; }
                    BAR_LDS();
                }
                const int vc = i - 4;
#pragma unroll
                for (int q = 0; q < 2; ++q)
#pragma unroll
                    for (int ks = 0; ks < 2; ++ks) oacc[q] = mma(frag_row(Pl, PLP, 0, 64 * vc + 32 * ks, c.lane), frag_tr(cur, CP, 32 * ks, 16 * (2 * c.wave + q), c.lane), oacc[q]);
                if (i == 7 && g == 0) {
#pragma unroll
                    for (int q = 0; q < 2; ++q)
#pragma unroll
                        for (int r = 0; r < 4; ++r) O[(size_t)(r0 + r) * 1024 + h * 256 + 16 * (2 * c.wave + q) + li] = (bf16)f2bf(oacc[q][r]); }
            }
            if (have1) { if (i & 1) sa_store(oth, preA, c.tid); else sa_store(oth, preB, c.tid); }
            BAR_LDS();
        }
    }
}
__device__ __forceinline__ void phase_attn(const mx::Ctx& c, int cu, int G) {
#ifdef MK_X2_PROMPT
    prompt_stream(c, cu, G); __syncthreads();
#endif
#ifdef MK_X2_SAMPLE
    sample_stream(c, cu, G); __syncthreads();
#endif
    if ((G & 1) == 0) { if (cu & 1) prompt_stream(c, cu >> 1, G >> 1); else sample_stream(c, cu >> 1, G >> 1); }
    else { prompt_stream(c, cu, G); __syncthreads(); sample_stream(c, cu, G); }
}
}
namespace sg {
using mx::bf16x8; using mx::f32x4; using mx::u32x2; using mx::ldsp; using mx::mma;
template <int MODE, int K> __device__ __forceinline__ void small_gemm(ldsp L, unsigned char* ws, const bf16* A, const bf16* Bt, float alpha, const float* base0, int tile, int tid, int lane, int wave, float* yout = nullptr) {
    constexpr int kw = K >> 3, nks = kw >> 5, UB = nks <= 4 ? nks : 6;
    const int rt = tile >> 4, ct = tile & 15, row0 = PROWS + 32 * rt, col0 = 64 * ct, kbeg = wave * kw;
    const int er = tid >> 4, ec4 = (tid & 15) * 4; u32x2 ew = {0u, 0u}; f32x4 es0 = {0.f, 0.f, 0.f, 0.f}, es1 = es0, es2 = es0, es3 = es0;
    if (MODE == 0 && !base0) ew = *(const GAS u32x2*)((const bf16*)(ws + WSO.xb) + (size_t)(row0 + er) * DM + col0 + ec4);
    if (MODE == 1) { const GAS f32x4* sp = (const GAS f32x4*)((const float*)(ws + WSO.ssq) + (size_t)(row0 + er) * 16); es0 = sp[0]; es1 = sp[1]; es2 = sp[2]; es3 = sp[3]; }
    f32x4 acc[2][4];
#pragma unroll
    for (int m = 0; m < 2; ++m)
#pragma unroll
        for (int n = 0; n < 4; ++n) acc[m][n] = (f32x4){0.f, 0.f, 0.f, 0.f};
    const bf16* ap = A + (size_t)(row0 + (lane & 15)) * K + kbeg + 8 * (lane >> 4); const bf16* bp = Bt + (size_t)(col0 + (lane & 15)) * K + kbeg + 8 * (lane >> 4);
#pragma unroll
    for (int kb = 0; kb < nks; kb += UB) { bf16x8 a[UB][2], b[UB][4];
#pragma unroll
        for (int j = 0; j < UB; ++j) if (kb + j < nks) {
#pragma unroll
            for (int m = 0; m < 2; ++m) a[j][m] = *(const GAS bf16x8*)(ap + (size_t)(16 * m) * K + 32 * (kb + j));
#pragma unroll
            for (int n = 0; n < 4; ++n) b[j][n] = *(const GAS bf16x8*)(bp + (size_t)(16 * n) * K + 32 * (kb + j)); }
#pragma unroll
        for (int j = 0; j < UB; ++j) if (kb + j < nks) {
#pragma unroll
            for (int m = 0; m < 2; ++m)
#pragma unroll
                for (int n = 0; n < 4; ++n) acc[m][n] = mma(a[j][m], b[j][n], acc[m][n]); } }
    LAS float* P = (LAS float*)L + wave * 2048;
#pragma unroll
    for (int m = 0; m < 2; ++m)
#pragma unroll
        for (int n = 0; n < 4; ++n)
#pragma unroll
            for (int r = 0; r < 4; ++r) P[(16 * m + 4 * (lane >> 4) + r) * 64 + 16 * n + (lane & 15)] = acc[m][n][r];
    __syncthreads();
    { const int r = tid >> 4, c4 = (tid & 15) * 4; f32x4 s = {0.f, 0.f, 0.f, 0.f};
#pragma unroll
      for (int w = 0; w < 8; ++w) s += *(const LAS f32x4*)((LAS float*)L + w * 2048 + r * 64 + c4);
      const int row = row0 + r, col = col0 + c4;
      if (MODE == 0) { bf16* XBp = (bf16*)(ws + WSO.xb) + (size_t)row * DM + col; f32x4 bs;
          if (base0) bs = *(const GAS f32x4*)(base0 + (size_t)(row - PROWS) * DM + col);
          else { const u32x2 w = ew; bs[0] = __uint_as_float(w[0] << 16); bs[1] = __uint_as_float(w[0] & 0xffff0000u); bs[2] = __uint_as_float(w[1] << 16); bs[3] = __uint_as_float(w[1] & 0xffff0000u); }
          const f32x4 o = bs + s * alpha; u32x2 pk; pk.x = pk2(o[0], o[1]); pk.y = pk2(o[2], o[3]); *(GAS u32x2*)XBp = pk;
          float q = (o[0] * o[0] + o[1] * o[1]) + (o[2] * o[2] + o[3] * o[3]); q += shx(q, 1); q += shx(q, 2); q += shx(q, 4); q += shx(q, 8);
          if ((tid & 15) == 0) ((float*)(ws + WSO.ssq))[(size_t)row * 16 + ct] = q; }
      else if (MODE == 2) { const bf16* XBp = (const bf16*)(ws + WSO.xb) + (size_t)row * DM + col; const u32x2 w = *(const GAS u32x2*)XBp;
          const f32x4 bs = {__uint_as_float(w[0] << 16), __uint_as_float(w[0] & 0xffff0000u), __uint_as_float(w[1] << 16), __uint_as_float(w[1] & 0xffff0000u)}; const f32x4 o = bs + s * alpha;
          float q = (o[0] * o[0] + o[1] * o[1]) + (o[2] * o[2] + o[3] * o[3]); q += shx(q, 1); q += shx(q, 2); q += shx(q, 4); q += shx(q, 8);
          float* SSQ = (float*)(ws + WSO.ssq); if ((tid & 15) == 0) __hip_atomic_store((unsigned*)(SSQ + (size_t)row * 16 + ct), __float_as_uint(q), __ATOMIC_RELAXED, __HIP_MEMORY_SCOPE_AGENT);
          asm volatile("s_waitcnt vmcnt(0)" ::: "memory"); unsigned* cnt = (unsigned*)(ws + WSO.ctl) + pg8::CW_PANEL + 64 * (64 + rt);
          if (lane == 0) __hip_atomic_fetch_add(cnt, 1u, __ATOMIC_RELAXED, __HIP_MEMORY_SCOPE_AGENT);
          pg8::panel_wait(cnt, 128u, wave, lane);
          float ss = 0.f; { const unsigned long long* sp = (const unsigned long long*)(SSQ + (size_t)row * 16);
#pragma unroll
              for (int j = 0; j < 8; ++j) { const unsigned long long v = __hip_atomic_load(sp + j, __ATOMIC_RELAXED, __HIP_MEMORY_SCOPE_AGENT); ss += __uint_as_float((unsigned)v) + __uint_as_float((unsigned)(v >> 32)); } }
          const float rs = rsqrtf(ss * (1.0f / DM) + 1e-6f); const f32x4 gv = *(const GAS f32x4*)(base0 + col);
          *(GAS f32x4*)(yout + (size_t)row * DM + col) = o * rs * gv; }
      else { const f32x4 s0 = es0, s1 = es1, s2 = es2, s3 = es3;
          const float ss = ((s0[0] + s0[1]) + (s0[2] + s0[3])) + ((s1[0] + s1[1]) + (s1[2] + s1[3])) + ((s2[0] + s2[1]) + (s2[2] + s2[3])) + ((s3[0] + s3[1]) + (s3[2] + s3[3]));
          const float rs = rsqrtf(ss * (1.0f / DM) + 1e-6f); u32x2 pk; pk.x = pk2(s[0] * rs, s[1] * rs); pk.y = pk2(s[2] * rs, s[3] * rs); *(GAS u32x2*)((bf16*)(ws + WSO.q) + (size_t)row * DM + col) = pk; } }
    __syncthreads();
}
}
#define MK_PROGRAM launch_mk(hs, 0, MK_NSTEPS, li, stream);
#ifndef MK_SP2_SINGLE
#define MK_SP2_SINGLE true
#endif
#ifndef MK_STAGGER
#define MK_STAGGER 1
#endif
#ifndef MK_SEQ0
#define MK_SEQ0 0x00DCBA9876543210ull
#define MK_SEQ1 0ull
#define MK_REPBITS 0u
#define MK_NSTEPS 14
#endif

#ifdef MK_PT_ID
#define PT_SEC_BEGIN(base) do { if (F.tid == 0 && ph + (base) == MK_PT_ID) *(volatile LAS unsigned*)((LAS unsigned char*)lds + MISC_OFF + 76) = (unsigned)rt(); } while (0)
#define PT_SEC_END(base) do { if (F.tid == 0 && ph + (base) == MK_PT_ID) { volatile LAS unsigned* pm_ = (volatile LAS unsigned*)((LAS unsigned char*)lds + MISC_OFF + 64); pm_[0] += (unsigned)rt() - pm_[3]; } } while (0)
#else
#define PT_SEC_BEGIN(base) do { } while (0)
#define PT_SEC_END(base) do { } while (0)
#endif
__global__ void __launch_bounds__(NWAVES * 64, 2) mk_fwd(Args args) {
    extern __shared__ __attribute__((aligned(16))) unsigned char lds[];
    volatile LAS unsigned* MISC = (volatile LAS unsigned*)((LAS unsigned char*)lds + MISC_OFF);
    gu32* ctl = (gu32*)(args.ws + WSO.ctl);
    for (int u = threadIdx.x; u < (LDS_BYTES - LDSCTL_OFF) / 4; u += NWAVES * 64) ((LAS unsigned*)((LAS unsigned char*)lds + LDSCTL_OFF))[u] = 0u;
    __syncthreads();
#ifndef MK_INKERNEL_INIT
    (void)xcd_barrier_post((unsigned*)(ctl + CW_BAR) + args.li * XCD_BAR_WORDS, MISC + 8);
#else
    if (blockIdx.x == 0 && (threadIdx.x >> 6) == NWAVES - 1) {
        const int l = (int)threadIdx.x & 63; unsigned* bar = (unsigned*)(ctl + CW_BAR) + args.li * XCD_BAR_WORDS;
        if (l < 16) { __hip_atomic_store(bar + XB_XCNT(l), 0u, RLX_AGENT); __hip_atomic_store(bar + XB_XSUB(l), 0u, RLX_AGENT); __hip_atomic_store(bar + XB_XGEN(l), 0u, RLX_AGENT); }
        else if (l == 16) { __hip_atomic_store(bar + XB_TMO, 0u, RLX_AGENT); __hip_atomic_store(bar + XB_TOP, 0u, RLX_AGENT); __hip_atomic_store(bar + XB_TOPGEN, 0u, RLX_AGENT); }
        else if (l == 17) { __hip_atomic_store((unsigned*)ctl + CW_TMO, 0u, RLX_AGENT); __hip_atomic_store((unsigned*)ctl + CW_CODE, 0u, RLX_AGENT); __hip_atomic_store((unsigned*)ctl + CW_DONE, 0u, RLX_AGENT); __hip_atomic_store((unsigned*)ctl + 64, 0u, RLX_AGENT); }
        asm volatile("s_waitcnt vmcnt(0)" ::: "memory");
        if (l == 0) { __builtin_amdgcn_fence(__ATOMIC_RELEASE, "agent"); __hip_atomic_store((unsigned*)ctl + CW_FLAG, CTL_MAGIC, __ATOMIC_RELEASE, __HIP_MEMORY_SCOPE_AGENT); }
    }
#endif
    constexpr nv::Ws w = WSO; const int wave_s = __builtin_amdgcn_readfirstlane((int)threadIdx.x >> 6);
    for (int pi = args.ph_lo; pi < args.ph_hi; ++pi) {
        const int ph = (int)(((pi < 16 ? MK_SEQ0 : MK_SEQ1) >> (4 * (pi & 15))) & 15ull); const int rep = (int)((MK_REPBITS >> pi) & 1u);
        int tid_ = wave_s * 64 + (int)__builtin_amdgcn_mbcnt_hi(~0u, __builtin_amdgcn_mbcnt_lo(~0u, 0u)); asm volatile("" : "+v"(tid_));     unsigned char* ws = args.ws; asm volatile("" : "+s"(ws)); int zoff_ = 0; asm volatile("" : "+s"(zoff_)); const float* const* inp = args.in + zoff_;     float* outp = args.out; asm volatile("" : "+s"(outp));
        Frame F; F.lds = (LAS unsigned char*)lds; F.tid = tid_; F.lane = F.tid & 63; F.wave = __builtin_amdgcn_readfirstlane(F.tid >> 6);
        F.G = gridDim.x; { const int bx = blockIdx.x; F.vcu = (F.G % 8 == 0) ? (bx % 8) * (F.G / 8) + bx / 8 : bx; }
        const float* SSQ = (const float*)(ws + w.ssq);
#ifdef MK_PT_ID
        if (F.tid == 0) *(volatile LAS unsigned*)((LAS unsigned char*)lds + MISC_OFF + 68) = (unsigned)rt();
#endif
        switch (ph) {
#ifndef MK_NO_PRO
        case PH_PROLOGUE: p0_prologue(F, inp, ws);
            break;
#endif
#ifndef MK_NO_UP
        case PH_UP1: case PH_UP2: {
            pg8::Gemm g{(const pg8::bf16_t*)(ws + w.xb), (const pg8::bf16_t*)(ws + (ph == PH_UP1 ? w.wgu1 : w.wgu2)), MROWS, 2 * DFF, DM};
            PG8_LAS float* rsl = (PG8_LAS float*)(F.lds + RSL_OFF);
            if (ph == PH_UP1) {
                pg8::MergedOrder S; S.a.init(MROWS, 2 * DFF, F.G, (int)blockIdx.x); S.b.init(MEMROWS, 2 * DM, F.G, 0); S.A2 = (const char*)(ws + w.memb); S.B2 = (const char*)(ws + w.wkv);
                pg8::rstd_to_lds(rsl, SSQ, S, F.tid, (const float*)(ws + w.mssq));
                pg8::EpiUpKV E{pg8::EpiSwigluL{(pg8::bf16_t*)(ws + w.r1), rsl, DFF, 0}, pg8::EpiKV{outp + OUTO.mk, outp + OUTO.mv, (pg8::bf16_t*)(ws + w.kb), (pg8::bf16_t*)(ws + w.vt), rsl}};
                pg8::gemm_phase<pg8::EpiUpKV, pg8::MergedOrder, true, true>(F.lds + RING_OFF, g, S, E, F.tid);
                PT_SEC_END(140);
            } else { pg8::StaticOrder S; S.init(MROWS, 2 * DFF, F.G, (int)blockIdx.x);
            pg8::rstd_to_lds(rsl, SSQ, S, F.tid);
            pg8::EpiSwigluL E{(pg8::bf16_t*)(ws + w.r1), rsl, DFF, 0};
            pg8::gemm_phase<pg8::EpiSwigluL, pg8::StaticOrder, true, true>(F.lds + RING_OFF, g, S, E, F.tid);
            PT_SEC_END(140);
            }
            {
                const int used = ph == PH_UP1 ? ((MROWS / 256) * (2 * DFF / 256) + (MEMROWS / 256) * (2 * DM / 256)) % F.G : ((MROWS / 256) * (2 * DFF / 256)) % F.G;
                if (F.G == 256 && (int)blockIdx.x >= used && !rep) { const int nw = (F.G - used) * NWAVES, widx = F.wave * (F.G - used) + ((int)blockIdx.x - used);
                    if (ph == PH_UP1) convert_range(F, inp, ws, 2816, 4224, widx, nw); else { convert_range(F, inp, ws, 11520, 12928, widx, nw);
#ifndef MK_KV_F32
                        kv_out_pass(F, ws, outp, widx, nw);
#endif
                    } }
#ifndef MK_KV_F32
                if (F.G != 256 && ph == PH_UP2 && !rep) kv_out_pass(F, ws, outp, (int)blockIdx.x * NWAVES + F.wave, F.G * NWAVES);
#endif
                }
            break; }
#endif
#ifndef MK_NO_RES
        case PH_DOWN1: case PH_WOUT: case PH_WO: case PH_DOWN2: {
            const bool down = (ph == PH_DOWN1 || ph == PH_DOWN2);
            const size_t aoff = down ? w.r1 : (ph == PH_WOUT ? w.ymix : w.o), boff = ph == PH_DOWN1 ? w.wd1 : ph == PH_DOWN2 ? w.wd2 : ph == PH_WOUT ? w.wout : w.wo;
            const int KK = down ? DFF : DM; const float alpha = (rep && ph != PH_DOWN1) ? 0.f : (down ? 0.5f : 1.0f);
            pg8::Gemm g{(const pg8::bf16_t*)(ws + aoff), (const pg8::bf16_t*)(ws + boff), PROWS, DM, KK}; pg8::StaticOrder S; S.init(PROWS, DM, F.G, (int)blockIdx.x);
#ifdef MK_FUSED_FINAL
            if (ph == PH_DOWN2 && !rep && F.G == 256) {
                pg8::EpiResidFinal EF{(const pg8::bf16_t*)(ws + w.xb), (float*)(ws + w.ssq), outp + OUTO.yp, inp[nv::I_FING], (unsigned*)(ws + w.ctl) + pg8::CW_PANEL, alpha, 0};
                pg8::gemm_phase<pg8::EpiResidFinal, pg8::StaticOrder, false, true>(F.lds + RING_OFF, g, S, EF, F.tid);
                sg::small_gemm<2, DFF>(F.lds, ws, (const bf16*)(ws + aoff), (const bf16*)(ws + boff), alpha, inp[nv::I_FING], (int)blockIdx.x, F.tid, F.lane, F.wave, outp + OUTO.yp);
                break; }
#endif
            pg8::EpiResid E{inp[nv::I_XP], inp[nv::I_XS], (float*)(ws + w.xf), (pg8::bf16_t*)(ws + w.xb), (float*)(ws + w.ssq), alpha, ph == PH_DOWN1 ? 1 : 0};
            const bool sf = MK_STAGGER && F.G == 256 && (((int)blockIdx.x >> 3) & 1);
#define MK_SMALL_R() do { for (int tl = (int)blockIdx.x; tl < 256; tl += F.G) { if (down) sg::small_gemm<0, DFF>(F.lds, ws, (const bf16*)(ws + aoff), (const bf16*)(ws + boff), alpha, nullptr, tl, F.tid, F.lane, F.wave); \
                else sg::small_gemm<0, DM>(F.lds, ws, (const bf16*)(ws + aoff), (const bf16*)(ws + boff), alpha, nullptr, tl, F.tid, F.lane, F.wave); } } while (0)
            if (sf) MK_SMALL_R();
            pg8::gemm_phase<pg8::EpiResid, pg8::StaticOrder, true, MK_SP2_SINGLE>(F.lds + RING_OFF, g, S, E, F.tid); PT_SEC_END(140);
            PT_SEC_BEGIN(120);
            if (!sf) MK_SMALL_R();
            PT_SEC_END(120);
#ifdef MK_X2_SMALL
            for (int tl = (int)blockIdx.x; tl < 256; tl += F.G) sg::small_gemm<0, DM>(F.lds, ws, (const bf16*)(ws + aoff), (const bf16*)(ws + boff), 0.f, nullptr, tl, F.tid, F.lane, F.wave);
#endif
            break; }
#endif
#ifndef MK_NO_WIN
        case PH_WIN: {
            pg8::Gemm g{(const pg8::bf16_t*)(ws + w.xb), (const pg8::bf16_t*)(ws + w.win), MROWS, WIN_N, DM}; pg8::StaticOrder S; S.init(MROWS, WIN_N, F.G, (int)blockIdx.x);
            PG8_LAS float* rsl = (PG8_LAS float*)(F.lds + RSL_OFF); pg8::rstd_to_lds(rsl, SSQ, S, F.tid);
            pg8::EpiZL E{(pg8::bf16_t*)(ws + w.r1), (float*)(ws + w.zg), rsl};
            pg8::gemm_phase<pg8::EpiZL, pg8::StaticOrder, true, true>(F.lds + RING_OFF, g, S, E, F.tid);
            {
                const int used = ((MROWS / 256) * (WIN_N / 256)) % F.G;
                if (F.G == 256 && (int)blockIdx.x >= used && !rep) { const int nw = (F.G - used) * NWAVES, widx = F.wave * (F.G - used) + ((int)blockIdx.x - used);
                    convert_range(F, inp, ws, 6144, 7168, widx, nw); convert_range(F, inp, ws, 8192, 8704, widx, nw); } }
            break; }
#endif
#ifndef MK_NO_Q
        case PH_Q: {
            pg8::Gemm g{(const pg8::bf16_t*)(ws + w.xb), (const pg8::bf16_t*)(ws + w.wq), PROWS, DM, DM}; pg8::StaticOrder S; S.init(PROWS, DM, F.G, (int)blockIdx.x);
            PG8_LAS float* rsl = (PG8_LAS float*)(F.lds + RSL_OFF); pg8::rstd_to_lds(rsl, SSQ, S, F.tid);
            pg8::EpiQ E{(pg8::bf16_t*)(ws + w.q), rsl};
            const bool sf = MK_STAGGER && F.G == 256 && (((int)blockIdx.x >> 3) & 1);
#define MK_SMALL_Q() do { for (int tl = (int)blockIdx.x; tl < 256; tl += F.G) sg::small_gemm<1, DM>(F.lds, ws, (const bf16*)(ws + w.xb), (const bf16*)(ws + w.wq), 1.f, nullptr, tl, F.tid, F.lane, F.wave); } while (0)
            if (sf) MK_SMALL_Q();
            pg8::gemm_phase<pg8::EpiQ, pg8::StaticOrder, true, MK_SP2_SINGLE>(F.lds + RING_OFF, g, S, E, F.tid); PT_SEC_END(140);
            PT_SEC_BEGIN(120);
            if (!sf) MK_SMALL_Q();
            PT_SEC_END(120);
            break; }
#endif
#ifndef MK_NO_MIX
        case PH_MIX_LOCAL: case PH_MIX_SCAN: case PH_MIX_OUT: {
            mx::Ctx c{(const bf16*)(ws + w.r1), (const float*)(ws + w.zg), ws, inp, outp, F.lds, F.tid, F.lane, F.wave, 0};
            if (ph == PH_MIX_LOCAL) m2::phase_local(c, (int)blockIdx.x, F.G); else if (ph == PH_MIX_SCAN) mx::scan_phase(c, (int)blockIdx.x * 512 + F.tid, F.G * 512); else m2::phase_out(c, (int)blockIdx.x, F.G);
            break; }
#endif
#ifndef MK_NO_ATTN
        case PH_ATTN: {
            mx::Ctx c{(const bf16*)(ws + w.r1), (const float*)(ws + w.zg), ws, inp, outp, F.lds, F.tid, F.lane, F.wave, 0};
            xa::phase_attn(c, (int)blockIdx.x, F.G);
            break; }
#endif
#ifndef MK_NO_FIN
        case PH_FINAL: p_final(F, inp, outp, ws); break;
#endif
        default: break;
        }
#ifdef MK_PT_ID
        if (F.tid == 0) { volatile LAS unsigned* pm_ = (volatile LAS unsigned*)((LAS unsigned char*)lds + MISC_OFF + 64); const unsigned t1_ = (unsigned)rt(); if (ph == MK_PT_ID) pm_[0] += t1_ - pm_[1]; pm_[1] = t1_;
            if (ph + 80 == MK_PT_ID || ph + 100 == MK_PT_ID) { pm_[2] = t1_ & 0xFFFFFFu; __hip_atomic_fetch_max((unsigned*)(ws + WSO.ctl) + 64, ((t1_ & 0xFFFFFFu) << 8) | (unsigned)blockIdx.x, __ATOMIC_RELAXED, __HIP_MEMORY_SCOPE_AGENT); } }
#endif
#ifdef MK_INKERNEL_INIT
        if (pi == args.ph_lo && pi + 1 < args.ph_hi && threadIdx.x == 0) {
            unsigned sp_ = 0u; while (__hip_atomic_load((unsigned*)(ws + WSO.ctl) + CW_FLAG, __ATOMIC_ACQUIRE, __HIP_MEMORY_SCOPE_AGENT) != CTL_MAGIC && ++sp_ < (1u << 22)) __builtin_amdgcn_s_sleep(2);
            (void)xcd_barrier_post((unsigned*)((gu32*)(ws + WSO.ctl) + CW_BAR) + args.li * XCD_BAR_WORDS, MISC + 8); }
#endif
        if (pi + 1 < args.ph_hi) { XcdBarrier b2; b2.bar = (unsigned*)((gu32*)(ws + WSO.ctl) + CW_BAR) + args.li * XCD_BAR_WORDS; b2.x = xb_xcc_id(); b2.st = (volatile LAS unsigned*)((LAS unsigned char*)lds + MISC_OFF) + 8;
            asm volatile("" : "+s"(b2.bar), "+s"(b2.x)); xcd_barrier(b2);
#ifdef MK_X2_BARRIER
            xcd_barrier(b2);
#endif
#ifdef MK_PT_ID
            if (F.tid == 0 && ph + 20 == MK_PT_ID) { volatile LAS unsigned* pm_ = (volatile LAS unsigned*)((LAS unsigned char*)lds + MISC_OFF + 64); pm_[0] += (unsigned)rt() - pm_[1]; }
#endif
        }
    }
#ifdef MK_INKERNEL_INIT
    if (wave_s == 0 && __builtin_amdgcn_mbcnt_hi(~0u, __builtin_amdgcn_mbcnt_lo(~0u, 0u)) == 0u) {
        const unsigned old_ = __hip_atomic_fetch_add((unsigned*)(args.ws + WSO.ctl) + CW_DONE, 1u, __ATOMIC_RELAXED, __HIP_MEMORY_SCOPE_AGENT);
        if (old_ + 1u == gridDim.x) __hip_atomic_store((unsigned*)(args.ws + WSO.ctl) + CW_FLAG, 0u, __ATOMIC_RELAXED, __HIP_MEMORY_SCOPE_AGENT); }
#endif
#ifdef MK_PT_ID
    if ((int)blockIdx.x == MK_PT_BLOCK && wave_s == 0 && __builtin_amdgcn_mbcnt_hi(~0u, __builtin_amdgcn_mbcnt_lo(~0u, 0u)) == 0u) { unsigned acc_ = *(volatile LAS unsigned*)((LAS unsigned char*)lds + MISC_OFF + 64);
        if (MK_PT_ID >= 80 && MK_PT_ID < 120) { const unsigned v_ = __hip_atomic_load((unsigned*)(args.ws + WSO.ctl) + 64, __ATOMIC_RELAXED, __HIP_MEMORY_SCOPE_AGENT); acc_ = MK_PT_ID >= 100 ? (v_ >> 8) - *(volatile LAS unsigned*)((LAS unsigned char*)lds + MISC_OFF + 72) : (v_ & 255u) * 100u; }
        const unsigned long long tend = rt() + (unsigned long long)acc_ * MK_PT_AMP; while (rt() < tend) __builtin_amdgcn_s_sleep(8); }
#endif
}

struct HostState { int grid; Args a; };
static void launch_mk(HostState& hs, int lo, int hi, int& li, hipStream_t stream) {
    hs.a.ph_lo = lo; hs.a.ph_hi = hi; hs.a.li = li++;
    hipLaunchKernelGGL(mk_fwd, dim3(hs.grid), dim3(NWAVES * 64), LDS_BYTES, stream, hs.a);
    const hipError_t le = hipPeekAtLastError(); if (le != hipSuccess) fprintf(stderr, "kernel_launch: launch [%d,%d) failed: %s\n", lo, hi, hipGetErrorName(le));
}
extern "C" void kernel_launch(void* const* d_in, const int* in_sizes, int n_in, void* d_out, int out_size, void* d_ws, size_t ws_size, hipStream_t stream) {
    static HostState hs; static int ready = 0;
    if (ready == 0) {
        if (n_in != 33 || (long)out_size != OUTO.total || ws_size < WSO.total) { fprintf(stderr, "kernel_launch: unexpected n_in %d / out_size %d / ws %zu (need %zu)\n", n_in, out_size, ws_size, (size_t)WSO.total); ready = -1; return; }
        int dev = 0, cus = 0;
        if (hipGetDevice(&dev) != hipSuccess || hipDeviceGetAttribute(&cus, hipDeviceAttributeMultiprocessorCount, dev) != hipSuccess) { ready = -1; return; }
        if (hipFuncSetAttribute((const void*)mk_fwd, hipFuncAttributeMaxDynamicSharedMemorySize, LDS_BYTES) != hipSuccess) { fprintf(stderr, "kernel_launch: hipFuncSetAttribute failed\n"); ready = -1; return; }
        (void)hipGetLastError();
        hs.grid = cus; ready = 1;
    }
    if (ready < 0) return;
    memset(&hs.a, 0, sizeof(hs.a));
    for (int i = 0; i < 33; ++i) hs.a.in[i] = (const float*)d_in[i];
    hs.a.out = (float*)d_out; hs.a.ws = (unsigned char*)d_ws;
#ifndef MK_INKERNEL_INIT
    if (hipMemsetAsync((char*)d_ws + WSO.ctl, 0, CTL_ZERO_BYTES, stream) != hipSuccess) { fprintf(stderr, "kernel_launch: memset failed\n"); return; }
#endif
    int li = 0;
    MK_PROGRAM
}
```
